# Optimizing an MI355X kernel written in HIP

```python
import math
import jax
import jax.numpy as jnp
from jax import lax
import numpy as np


D_MODEL = 4096
BATCH = 8
SEQ = 2048
DEPTH = 2
DEC_BATCH = 1
DEC_SEQ = 8192
PAST_LEN = 128

EPS = 1e-6
NEG = -1e30
ROPE_THETA = 10000.0
MIX = D_MODEL
GROUP_W = (3 * MIX) // 8
HY_CH = MIX - 2 * GROUP_W
HY_EMB = 33
HY_BANDS = (HY_EMB - 1) // 2
HY_FFN = 64
HY_FAST_DECAY = 0.3
HY_SLOW_DECAY = 1.5
HY_TARGET = 1e-2
Q_LORA = 1536
KV_LORA = 512
NOPE_DIM = 128
ROPE_DIM = 64
V_DIM = 128
QK_DIM = NOPE_DIM + ROPE_DIM
MLA_HEADS = GROUP_W // V_DIM
ATT_BLOCK = 128
DIL_DIM = 128
DIL_PAIRS = ((128, 1), (512, 4), (2048, 16))
DIL_HEADS = GROUP_W // DIL_DIM
DIL_SLOTS = DIL_HEADS // len(DIL_PAIRS)
DIL_BLOCK = 64
D_FF = 4 * D_MODEL
HY_COLS = 3 * HY_CH
MLA_COLS = Q_LORA + KV_LORA + ROPE_DIM
DIL_COLS = 3 * DIL_HEADS * DIL_DIM
IN_COLS = HY_COLS + MLA_COLS + DIL_COLS

kernel_name = 'hybrid_hyena_mla_dilated_encoder'


def rmsnorm(x, g):
    xf = x.astype(jnp.float32)
    y = xf * lax.rsqrt(jnp.mean(xf * xf, axis=-1, keepdims=True) + EPS)
    return (y * g.astype(jnp.float32)).astype(x.dtype)


def rope_tables(L, dim):
    inv = 1.0 / (ROPE_THETA ** (jnp.arange(0, dim, 2, dtype=jnp.float32) / dim))
    ang = jnp.arange(L, dtype=jnp.float32)[:, None] * inv[None, :]
    return jnp.cos(ang), jnp.sin(ang)


def apply_rope(x, cos, sin):
    x1, x2 = jnp.split(x.astype(jnp.float32), 2, axis=-1)
    c = cos[None, :, None, :]
    s = sin[None, :, None, :]
    return jnp.concatenate([x1 * c - x2 * s, x2 * c + x1 * s], axis=-1).astype(x.dtype)


def hyena_filter(L, w1, b1, w2, b2, w3, b3, w4, b4, freq):
    t = jnp.linspace(0.0, 1.0, L, dtype=jnp.float32)[:, None]
    w = 2.0 * math.pi * jnp.arange(L, dtype=jnp.float32)[:, None] / L
    f = jnp.linspace(1e-4, HY_BANDS - 1, HY_BANDS, dtype=jnp.float32)[None, :]
    z = jnp.concatenate([t, jnp.cos(f * w), -jnp.sin(f * w)], axis=-1)
    fq = freq.astype(jnp.float32)
    h = jnp.sin(fq * (z @ w1.astype(jnp.float32) + b1.astype(jnp.float32)))
    h = jnp.sin(fq * (h @ w2.astype(jnp.float32) + b2.astype(jnp.float32)))
    h = jnp.sin(fq * (h @ w3.astype(jnp.float32) + b3.astype(jnp.float32)))
    h = h @ w4.astype(jnp.float32) + b4.astype(jnp.float32)
    max_decay = math.log(HY_TARGET) / HY_FAST_DECAY
    min_decay = math.log(HY_TARGET) / HY_SLOW_DECAY
    deltas = jnp.abs(jnp.linspace(min_decay, max_decay, HY_CH, dtype=jnp.float32))
    decay = jnp.exp(-t * deltas[None, :])
    return h * jnp.concatenate([decay, decay], axis=-1)


def hyena_mixer(z, conv_w, conv_b, w1, b1, w2, b2, w3, b3, w4, b4, freq, skip):
    B, L, _ = z.shape
    zp = jnp.pad(z, ((0, 0), (1, 1), (0, 0)))
    zc = zp[:, :-2] * conv_w[0] + zp[:, 1:-1] * conv_w[1] + zp[:, 2:] * conv_w[2] + conv_b
    x0, x1, v = jnp.split(zc, 3, axis=-1)
    u = (x1 * v).astype(jnp.float32)
    h = hyena_filter(L, w1, b1, w2, b2, w3, b3, w4, b4, freq)
    h_f, h_b = h[:, :HY_CH], h[:, HY_CH:]
    k_circ = jnp.concatenate([h_f, jnp.zeros((1, HY_CH), jnp.float32), h_b[:0:-1]], axis=0)
    uf = jnp.fft.rfft(u, n=2 * L, axis=1)
    kf = jnp.fft.rfft(k_circ, n=2 * L, axis=0)
    y = jnp.fft.irfft(uf * kf[None], n=2 * L, axis=1)[:, :L]
    y = y + u * skip.astype(jnp.float32)
    return x0 * y.astype(z.dtype)


def mla_mixer(cols, q_a_norm, w_q_b, kv_a_norm, w_kv_b, qn_nope, qn_rope, kn_nope, kn_rope):
    B, L, _ = cols.shape
    c_q = rmsnorm(cols[..., :Q_LORA], q_a_norm)
    c_kv = rmsnorm(cols[..., Q_LORA:Q_LORA + KV_LORA], kv_a_norm)
    k_rope = rmsnorm(cols[..., Q_LORA + KV_LORA:], kn_rope)[:, :, None, :]
    q = jnp.einsum('blr,rf->blf', c_q, w_q_b).reshape(B, L, MLA_HEADS, QK_DIM)
    kv = jnp.einsum('blr,rf->blf', c_kv, w_kv_b).reshape(B, L, MLA_HEADS, NOPE_DIM + V_DIM)
    q_nope = rmsnorm(q[..., :NOPE_DIM], qn_nope)
    q_rope = rmsnorm(q[..., NOPE_DIM:], qn_rope)
    k_nope = rmsnorm(kv[..., :NOPE_DIM], kn_nope)
    v = kv[..., NOPE_DIM:]
    cos, sin = rope_tables(L, ROPE_DIM)
    q_rope = apply_rope(q_rope, cos, sin)
    k_rope = apply_rope(k_rope, cos, sin)[:, :, 0, :]
    nq = L // ATT_BLOCK
    scale = QK_DIM ** -0.5

    def blocks(t):
        return jnp.moveaxis(t.reshape(B, nq, ATT_BLOCK, *t.shape[2:]), 1, 0)

    def one_block(args):
        qn, qr = args
        s = (jnp.einsum('bqhd,bkhd->bhqk', qn, k_nope, preferred_element_type=jnp.float32)
             + jnp.einsum('bqhd,bkd->bhqk', qr, k_rope, preferred_element_type=jnp.float32)) * scale
        p = jax.nn.softmax(s, axis=-1)
        return jnp.einsum('bhqk,bkhd->bqhd', p.astype(v.dtype), v)

    o = lax.map(one_block, (blocks(q_nope), blocks(q_rope)))
    return jnp.moveaxis(o, 0, 1).reshape(B, L, MLA_HEADS * V_DIM)


def dilated_branch(q, k, v, dil, radius):
    B, L, h, dh = q.shape
    n = L // dil
    nblk = -(-n // DIL_BLOCK)
    npad = nblk * DIL_BLOCK
    BD = B * dil

    def by_stride(t):
        t = t.reshape(B, n, dil, h, dh).transpose(0, 2, 1, 3, 4).reshape(BD, n, h, dh)
        return jnp.pad(t, ((0, 0), (0, npad - n), (0, 0), (0, 0)))

    def band(t):
        tp = jnp.pad(t, ((0, 0), (DIL_BLOCK, DIL_BLOCK), (0, 0), (0, 0))).reshape(BD, nblk + 2, DIL_BLOCK, h, dh)
        return jnp.concatenate([tp[:, :-2], tp[:, 1:-1], tp[:, 2:]], axis=2)

    qb = by_stride(q).reshape(BD, nblk, DIL_BLOCK, h, dh)
    kb = band(by_stride(k))
    vb = band(by_stride(v))
    s = jnp.einsum('bnqhd,bnkhd->bnhqk', qb, kb, preferred_element_type=jnp.float32) * (dh ** -0.5)
    qpos = jnp.arange(nblk)[:, None, None] * DIL_BLOCK + jnp.arange(DIL_BLOCK)[None, :, None]
    kpos = (jnp.arange(nblk)[:, None, None] - 1) * DIL_BLOCK + jnp.arange(3 * DIL_BLOCK)[None, None, :]
    valid = (jnp.abs(qpos - kpos) <= radius) & (kpos >= 0) & (kpos < n)
    s = jnp.where(valid[None, :, None], s, NEG)
    m = jnp.max(s, axis=-1, keepdims=True)
    p = jnp.exp(s - m)
    l = jnp.sum(p, axis=-1, keepdims=True)
    o = jnp.einsum('bnhqk,bnkhd->bnqhd', (p / l).astype(v.dtype), vb)
    lse = (m + jnp.log(l))[..., 0]
    o = o.reshape(B, dil, npad, h, dh)[:, :, :n].transpose(0, 2, 1, 3, 4).reshape(B, L, h, dh)
    lse = lse.transpose(0, 1, 3, 2).reshape(B, dil, npad, h)[:, :, :n].transpose(0, 2, 1, 3).reshape(B, L, h)
    return o, lse


def dilated_mixer(cols, q_norm, k_norm):
    B, L, _ = cols.shape
    q, k, v = [t.reshape(B, L, DIL_HEADS, DIL_DIM) for t in jnp.split(cols, 3, axis=-1)]
    q = rmsnorm(q, q_norm)
    k = rmsnorm(k, k_norm)
    cos, sin = rope_tables(L, DIL_DIM)
    q = apply_rope(q, cos, sin)
    k = apply_rope(k, cos, sin)
    outs, lses = [], []
    for g, (window, dil) in enumerate(DIL_PAIRS):
        sl = slice(g * DIL_SLOTS, (g + 1) * DIL_SLOTS)
        o, lse = dilated_branch(q[:, :, sl], k[:, :, sl], v[:, :, sl], dil, window // (2 * dil))
        outs.append(o)
        lses.append(lse)
    o = jnp.stack(outs, axis=2)
    alpha = jax.nn.softmax(jnp.stack(lses, axis=2), axis=2)
    o = o * alpha[..., None].astype(o.dtype)
    return o.reshape(B, L, DIL_HEADS * DIL_DIM)


def setup_inputs(seed: int = 0):
    key = jax.random.key(seed)
    ks = iter(jax.random.split(key, 40))

    def nrm(shape, scale):
        return jax.random.normal(next(ks), shape, jnp.float32) * scale

    def gain(shape):
        return 1.0 + 0.05 * jax.random.normal(next(ks), shape, jnp.float32)

    Ld = DEPTH
    return {
        'x_prompt': nrm((BATCH, SEQ, D_MODEL), 1.0),
        'x_sample': nrm((DEC_BATCH, DEC_SEQ, D_MODEL), 1.0),
        'norm_mix': gain((Ld, D_MODEL)),
        'w_in': nrm((Ld, D_MODEL, IN_COLS), D_MODEL ** -0.5),
        'hy_conv_w': nrm((Ld, 3, HY_COLS), 3 ** -0.5),
        'hy_conv_b': nrm((Ld, HY_COLS), 0.02),
        'hy_f_w1': nrm((Ld, HY_EMB, HY_FFN), HY_EMB ** -0.5),
        'hy_f_b1': nrm((Ld, HY_FFN), 0.02),
        'hy_f_w2': nrm((Ld, HY_FFN, HY_FFN), HY_FFN ** -0.5),
        'hy_f_b2': nrm((Ld, HY_FFN), 0.02),
        'hy_f_w3': nrm((Ld, HY_FFN, HY_FFN), HY_FFN ** -0.5),
        'hy_f_b3': nrm((Ld, HY_FFN), 0.02),
        'hy_f_w4': nrm((Ld, HY_FFN, 2 * HY_CH), HY_FFN ** -0.5),
        'hy_f_b4': nrm((Ld, 2 * HY_CH), 0.02),
        'hy_f_freq': gain((Ld, HY_FFN)),
        'hy_skip': nrm((Ld, HY_CH), 0.1),
        'mla_q_a_norm': gain((Ld, Q_LORA)),
        'mla_w_q_b': nrm((Ld, Q_LORA, MLA_HEADS * QK_DIM), Q_LORA ** -0.5),
        'mla_kv_a_norm': gain((Ld, KV_LORA)),
        'mla_w_kv_b': nrm((Ld, KV_LORA, MLA_HEADS * (NOPE_DIM + V_DIM)), KV_LORA ** -0.5),
        'mla_qn_nope': gain((Ld, NOPE_DIM)),
        'mla_qn_rope': gain((Ld, ROPE_DIM)),
        'mla_kn_nope': gain((Ld, NOPE_DIM)),
        'mla_kn_rope': gain((Ld, ROPE_DIM)),
        'dil_q_norm': gain((Ld, DIL_DIM)),
        'dil_k_norm': gain((Ld, DIL_DIM)),
        'out_norm': gain((Ld, MIX)),
        'w_out': nrm((Ld, MIX, D_MODEL), MIX ** -0.5),
        'norm_ffn': gain((Ld, D_MODEL)),
        'w_up': nrm((Ld, D_MODEL, D_FF), D_MODEL ** -0.5),
        'w_down': nrm((Ld, D_FF, D_MODEL), D_FF ** -0.5),
    }


def reference(x_prompt, x_sample, norm_mix, w_in, hy_conv_w, hy_conv_b, hy_f_w1, hy_f_b1, hy_f_w2, hy_f_b2,
              hy_f_w3, hy_f_b3, hy_f_w4, hy_f_b4, hy_f_freq, hy_skip, mla_q_a_norm, mla_w_q_b, mla_kv_a_norm,
              mla_w_kv_b, mla_qn_nope, mla_qn_rope, mla_kn_nope, mla_kn_rope, dil_q_norm, dil_k_norm,
              out_norm, w_out, norm_ffn, w_up, w_down):
    def trunk(x):
        for l in range(DEPTH):
            h = rmsnorm(x, norm_mix[l])
            z = jnp.einsum('bld,df->blf', h, w_in[l])
            y_hy = hyena_mixer(z[..., :HY_COLS], hy_conv_w[l], hy_conv_b[l], hy_f_w1[l], hy_f_b1[l],
                               hy_f_w2[l], hy_f_b2[l], hy_f_w3[l], hy_f_b3[l], hy_f_w4[l], hy_f_b4[l],
                               hy_f_freq[l], hy_skip[l])
            y_mla = mla_mixer(z[..., HY_COLS:HY_COLS + MLA_COLS], mla_q_a_norm[l], mla_w_q_b[l],
                              mla_kv_a_norm[l], mla_w_kv_b[l], mla_qn_nope[l], mla_qn_rope[l],
                              mla_kn_nope[l], mla_kn_rope[l])
            y_dil = dilated_mixer(z[..., HY_COLS + MLA_COLS:], dil_q_norm[l], dil_k_norm[l])
            g = out_norm[l]
            mixed = jnp.concatenate([rmsnorm(y_hy, g[:HY_CH]),
                                     rmsnorm(y_mla, g[HY_CH:HY_CH + GROUP_W]),
                                     rmsnorm(y_dil, g[HY_CH + GROUP_W:])], axis=-1)
            x = x + jnp.einsum('blm,md->bld', mixed, w_out[l])
            h = rmsnorm(x, norm_ffn[l])
            a = jax.nn.relu(jnp.einsum('bld,df->blf', h, w_up[l]))
            x = x + jnp.einsum('blf,fd->bld', a * a, w_down[l])
        return x

    y_prompt = trunk(x_prompt)
    y_sample = trunk(x_sample)
    return (y_prompt, y_sample)
```

```cpp
#include <hip/hip_runtime.h>
#include <cstdio>
#include <cstdint>
#define MK_N_LAUNCHES 26
namespace pg8 {
#define PG8_LAS __attribute__((address_space(3)))
typedef unsigned short bf16_t;
typedef short bf16x8 __attribute__((ext_vector_type(8)));
typedef float f32x4 __attribute__((ext_vector_type(4)));
typedef unsigned u32x4 __attribute__((ext_vector_type(4)));
constexpr int BM = 256, BK = 64, HALF = 128, HTB = HALF * BK * 2  , STAGE_BYTES = 8 * HTB, NXCD = 8, WGM = 8;

__host__ __device__ __forceinline__ int lds_byte(int r, int c) { const int st = (r >> 4) * 2 + (c >> 5), rr = r & 15, cc = c & 31, ob = rr * 64 + cc * 2; return st * 1024 + (ob ^ (((ob >> 9) & 1) << 5)); }
__host__ __device__ __forceinline__ void stage_rc(int b, int& R, int& C) { const int st = b / 1024, sb = b % 1024, swz = sb ^ (((sb >> 9) & 1) << 5); R = (st >> 1) * 16 + swz / 64; C = (st & 1) * 32 + (swz % 64) / 2; }
__host__ __device__ __forceinline__ int perm32(int rho) { const int n = rho >> 4, i = rho & 15; return 8 * (i >> 2) + 4 * n + (i & 3); }

struct Unit { int pm, pn; };
struct Gemm { const bf16_t* A; const bf16_t* Bt; int M, N, K; };

struct StaticOrder {
    int nM, nN, nwg, G, c;
    __host__ __device__ void init(int M, int N, int G_, int c_) { nM = M / BM; nN = N / BM; nwg = nM * nN; G = G_; c = c_; }
    __host__ __device__ bool next(int i, Unit& u) const {
        const long L = (long)i * G + c; if (L >= nwg) return false;
        int wgid = (int)L; { const int q = nwg / NXCD, r = nwg % NXCD, xcd = wgid % NXCD, off = wgid / NXCD; wgid = (xcd < r ? xcd * (q + 1) : r * (q + 1) + (xcd - r) * q) + off; }
        const int nig = WGM * nN, gid = wgid / nig, fm = gid * WGM, gsz = (nM - fm) < WGM ? (nM - fm) : WGM;
        u.pm = fm + ((wgid % nig) % gsz); u.pn = (wgid % nig) / gsz; return true;
    }
    __device__ __forceinline__ void a_ready(const Unit&) const {}
    __device__ __forceinline__ void done(const Unit&) const {}
};

__device__ __forceinline__ unsigned cvt_pk_bf16(float lo, float hi) { unsigned r; asm volatile("v_cvt_pk_bf16_f32 %0, %1, %2" : "=v"(r) : "v"(lo), "v"(hi)); return r; }
typedef float f32x2 __attribute__((ext_vector_type(2)));
template <int ACT  > struct EpiBf16 {
    static constexpr bool PERM = true, AFTER_DRAIN = false;
    bf16_t* O; int ldc;
    __device__ __forceinline__ void operator()(const f32x4 (&acc)[2][2][4][2], const Unit& u, int wr, int wc, int fr, int fq) const {
        const int row0 = u.pm * BM + wr * 64 + fr, col0 = u.pn * BM + wc * 32 + 8 * fq;
#pragma unroll
        for (int ai = 0; ai < 2; ++ai)
#pragma unroll
            for (int m = 0; m < 4; ++m) { bf16_t* rowp = O + (size_t)(row0 + ai * HALF + m * 16) * ldc + col0;
#pragma unroll
                for (int bj = 0; bj < 2; ++bj) { f32x4 v0 = acc[ai][bj][m][0], v1 = acc[ai][bj][m][1];
                    if (ACT == 1) {
#pragma unroll
                        for (int j = 0; j < 4; ++j) { const float a = fmaxf(v0[j], 0.f), b = fmaxf(v1[j], 0.f); v0[j] = a * a; v1[j] = b * b; } }
                    u32x4 w; w.x = cvt_pk_bf16(v0[0], v0[1]); w.y = cvt_pk_bf16(v0[2], v0[3]); w.z = cvt_pk_bf16(v1[0], v1[1]); w.w = cvt_pk_bf16(v1[2], v1[3]);
                    *(u32x4*)(rowp + bj * HALF) = w; } }
    }
};
struct EpiRes {
    static constexpr bool PERM = false, AFTER_DRAIN = false;
    const float* r0; const float* r1; float* out; int pm_split;
    __device__ __forceinline__ void operator()(const f32x4 (&acc)[2][2][4][2], const Unit& u, int wr, int wc, int fr, int fq) const {
        const int row0 = u.pm * BM + wr * 64 + fr, col0 = u.pn * BM + wc * 32 + 4 * fq;
        const float* rb = (u.pm < pm_split) ? r0 : r1;
#pragma unroll
        for (int ai = 0; ai < 2; ++ai)
#pragma unroll
            for (int m = 0; m < 4; ++m) { const size_t off = (size_t)(row0 + ai * HALF + m * 16) * 4096 + col0;
#pragma unroll
                for (int bj = 0; bj < 2; ++bj)
#pragma unroll
                    for (int n = 0; n < 2; ++n) { const f32x4 r = *(const f32x4*)(rb + off + bj * HALF + n * 16); *(f32x4*)(out + off + bj * HALF + n * 16) = r + acc[ai][bj][m][n]; }
                asm volatile("" ::: "memory"); }
    }
};
template <class Epi, class Sched, bool ALIGN_EPI = false, bool SP2 = false>
__device__ __forceinline__ void gemm_phase(PG8_LAS unsigned char* lds, const Gemm g, const Sched& S, const Epi& E) {
    int tid_o = threadIdx.x; asm volatile("" : "+v"(tid_o));
    const int tid = tid_o & 511, wid = __builtin_amdgcn_readfirstlane(tid >> 6), lane = tid & 63, wr = wid >> 2, wc = wid & 3, fr = lane & 15, fq = lane >> 4;
    const int K = g.K, nt = K / BK;
    unsigned voffA[2], voffB[2];
#pragma unroll
    for (int i = 0; i < 2; ++i) { int R, C; stage_rc(tid * 16 + i * 8192, R, C); const int Rb = Epi::PERM ? ((R & ~31) + perm32(R & 31)) : R;
        voffA[i] = (unsigned)(R * K + C) * 2u; voffB[i] = (unsigned)(Rb * K + C) * 2u; }
    const size_t kstep = (size_t)(BK * 2);
    const size_t hstep = (size_t)HALF * K * 2;
    const size_t tstep = 2 * hstep;
    const unsigned ldsw = (unsigned)wid * 1024u;
    const int aoff = lds_byte(wr * 64 + fr, fq * 8), boff = lds_byte(wc * 32 + fr, fq * 8);
#define PG8_SA(b, h) (((b) * 2 + (h)) * HTB)
#define PG8_SB(b, h) ((4 + (b) * 2 + (h)) * HTB)
#define PG8_STAGE(bufoff, gbase, voff) do { _Pragma("unroll") for (int _i = 0; _i < 2; ++_i) \
        __builtin_amdgcn_global_load_lds((const unsigned*)((const char*)(gbase) + (voff)[_i]), (PG8_LAS unsigned*)(lds + (bufoff) + ldsw + _i * 8192), 16, 0, 0); } while (0)
#define PG8_LDA(dst, b, h) do { _Pragma("unroll") for (int m = 0; m < 4; ++m) _Pragma("unroll") for (int k = 0; k < 2; ++k) dst[m][k] = *(const PG8_LAS bf16x8*)(lds + PG8_SA(b, h) + aoff + m * 2048 + k * 1024); } while (0)
#define PG8_LDB(dst, b, h) do { _Pragma("unroll") for (int n = 0; n < 2; ++n) _Pragma("unroll") for (int k = 0; k < 2; ++k) dst[n][k] = *(const PG8_LAS bf16x8*)(lds + PG8_SB(b, h) + boff + n * 2048 + k * 1024); } while (0)
#define PG8_MMA(ai, bj, At, Bt) do { __builtin_amdgcn_s_setprio(1); _Pragma("unroll") for (int m = 0; m < 4; ++m) _Pragma("unroll") for (int n = 0; n < 2; ++n) _Pragma("unroll") for (int k = 0; k < 2; ++k) \
        acc[ai][bj][m][n] = __builtin_amdgcn_mfma_f32_16x16x32_bf16(Bt[n][k], At[m][k], acc[ai][bj][m][n], 0, 0, 0); __builtin_amdgcn_s_setprio(0); } while (0)
#define PG8_WAIT_V(n) asm volatile("s_waitcnt vmcnt(" #n ")" ::: "memory")
#define PG8_WAIT_L(n) asm volatile("s_waitcnt lgkmcnt(" #n ")" ::: "memory")
#define PG8_BAR __builtin_amdgcn_s_barrier()
#define PG8_SCHED __builtin_amdgcn_sched_barrier(0)
    Unit cur, nxt; int ui = 0;
    if (!S.next(0, cur)) return;
    f32x4 acc[2][2][4][2];
#pragma unroll
    for (int a = 0; a < 2; ++a)
#pragma unroll
        for (int b = 0; b < 2; ++b)
#pragma unroll
            for (int m = 0; m < 4; ++m)
#pragma unroll
                for (int n = 0; n < 2; ++n) acc[a][b][m][n] = (f32x4){0.f, 0.f, 0.f, 0.f};
    bf16x8 At[4][2], B0[2][2], B1[2][2];
    const char* cA = (const char*)g.A + (size_t)cur.pm * tstep; const char* cB = (const char*)g.Bt + (size_t)cur.pn * tstep;
    S.a_ready(cur);
    if constexpr (SP2) {
        PG8_STAGE(PG8_SB(0, 0), cB, voffB); PG8_STAGE(PG8_SB(0, 1), cB + hstep, voffB); PG8_STAGE(PG8_SA(0, 0), cA, voffA); PG8_STAGE(PG8_SA(0, 1), cA + hstep, voffA);
        if (wr == 1) PG8_BAR;
        PG8_WAIT_V(2); PG8_BAR;
        PG8_STAGE(PG8_SB(1, 0), cB + kstep, voffB); PG8_STAGE(PG8_SA(1, 0), cA + kstep, voffA); PG8_STAGE(PG8_SB(1, 1), cB + hstep + kstep, voffB);
        PG8_WAIT_V(6); PG8_BAR;
    } else {
        PG8_STAGE(PG8_SB(0, 0), cB, voffB); PG8_STAGE(PG8_SA(0, 0), cA, voffA); PG8_STAGE(PG8_SB(0, 1), cB + hstep, voffB); PG8_STAGE(PG8_SA(0, 1), cA + hstep, voffA);
        if (wr == 1) PG8_BAR;
        PG8_WAIT_V(4); PG8_BAR;
        PG8_STAGE(PG8_SB(1, 0), cB + kstep, voffB); PG8_STAGE(PG8_SA(1, 0), cA + kstep, voffA); PG8_STAGE(PG8_SB(1, 1), cB + hstep + kstep, voffB);
        PG8_WAIT_V(6); PG8_BAR;
    }
    for (;;) {
        const bool has_next = S.next(ui + 1, nxt);
        const char* nA = has_next ? (const char*)g.A + (size_t)nxt.pm * tstep : cA; const char* nB = has_next ? (const char*)g.Bt + (size_t)nxt.pn * tstep : cB;
        for (int t = 0; t < nt; t += 2) {
            const bool last = (t == nt - 2);
            const char* a1 = cA + (size_t)(t + 1) * kstep;
            const char* a2 = last ? nA : cA + (size_t)(t + 2) * kstep; const char* b2 = last ? nB : cB + (size_t)(t + 2) * kstep;
            const char* a3 = a2 + kstep; const char* b3 = b2 + kstep;
            if (last && has_next) S.a_ready(nxt);
            if constexpr (SP2) {
            PG8_LDB(B0, 0, 0); PG8_LDB(B1, 0, 1); PG8_SCHED; PG8_LDA(At, 0, 0); PG8_STAGE(PG8_SA(1, 1), a1 + hstep, voffA);
            PG8_WAIT_V(8); PG8_WAIT_L(0); PG8_BAR; PG8_MMA(0, 0, At, B0); PG8_MMA(0, 1, At, B1); PG8_BAR; PG8_SCHED;
            PG8_LDA(At, 0, 1); PG8_STAGE(PG8_SB(0, 0), b2, voffB); PG8_STAGE(PG8_SB(0, 1), b2 + hstep, voffB); PG8_STAGE(PG8_SA(0, 0), a2, voffA);
            PG8_WAIT_V(8); PG8_WAIT_L(0); PG8_BAR; PG8_MMA(1, 0, At, B0); PG8_MMA(1, 1, At, B1); PG8_BAR; PG8_SCHED;
            PG8_LDB(B0, 1, 0); PG8_LDB(B1, 1, 1); PG8_SCHED; PG8_LDA(At, 1, 0); PG8_STAGE(PG8_SA(0, 1), a2 + hstep, voffA);
            PG8_WAIT_V(8); PG8_WAIT_L(0); PG8_BAR; PG8_MMA(0, 0, At, B0); PG8_MMA(0, 1, At, B1); PG8_BAR; PG8_SCHED;
            PG8_LDA(At, 1, 1); PG8_STAGE(PG8_SB(1, 0), b3, voffB); PG8_STAGE(PG8_SB(1, 1), b3 + hstep, voffB); PG8_STAGE(PG8_SA(1, 0), a3, voffA);
            PG8_WAIT_V(8); PG8_WAIT_L(0); PG8_BAR; PG8_MMA(1, 0, At, B0); PG8_MMA(1, 1, At, B1); PG8_BAR; PG8_SCHED;
            } else {
            PG8_LDB(B0, 0, 0); PG8_SCHED; PG8_LDA(At, 0, 0); PG8_STAGE(PG8_SA(1, 1), a1 + hstep, voffA);
            PG8_WAIT_L(8); PG8_BAR; PG8_WAIT_L(0); PG8_MMA(0, 0, At, B0); PG8_BAR; PG8_SCHED;
            PG8_LDB(B1, 0, 1); PG8_STAGE(PG8_SB(0, 0), b2, voffB);
            PG8_BAR; PG8_WAIT_L(0); PG8_MMA(0, 1, At, B1); PG8_BAR;
            PG8_LDA(At, 0, 1); PG8_STAGE(PG8_SA(0, 0), a2, voffA);
            PG8_BAR; PG8_WAIT_L(0); PG8_MMA(1, 0, At, B0); PG8_BAR; PG8_SCHED;
            PG8_STAGE(PG8_SB(0, 1), b2 + hstep, voffB);
            PG8_WAIT_V(6); PG8_BAR; PG8_MMA(1, 1, At, B1); PG8_BAR;
            PG8_LDB(B0, 1, 0); PG8_SCHED; PG8_LDA(At, 1, 0); PG8_STAGE(PG8_SA(0, 1), a2 + hstep, voffA);
            PG8_WAIT_L(8); PG8_BAR; PG8_WAIT_L(0); PG8_MMA(0, 0, At, B0); PG8_BAR; PG8_SCHED;
            PG8_LDB(B1, 1, 1); PG8_STAGE(PG8_SB(1, 0), b3, voffB);
            PG8_BAR; PG8_WAIT_L(0); PG8_MMA(0, 1, At, B1); PG8_BAR;
            PG8_LDA(At, 1, 1); PG8_STAGE(PG8_SA(1, 0), a3, voffA);
            PG8_BAR; PG8_WAIT_L(0); PG8_MMA(1, 0, At, B0); PG8_BAR; PG8_SCHED;
            PG8_STAGE(PG8_SB(1, 1), b3 + hstep, voffB);
            PG8_WAIT_V(6); PG8_BAR; PG8_MMA(1, 1, At, B1); PG8_BAR;
            }
        }
        if constexpr (ALIGN_EPI) { if (wr == 0) PG8_BAR; }
        if constexpr (!Epi::AFTER_DRAIN) { E(acc, cur, wr, wc, fr, fq); S.done(cur); }
        if (!has_next) break;
#pragma unroll
        for (int a = 0; a < 2; ++a)
#pragma unroll
            for (int b = 0; b < 2; ++b)
#pragma unroll
                for (int m = 0; m < 4; ++m)
#pragma unroll
                    for (int n = 0; n < 2; ++n) acc[a][b][m][n] = (f32x4){0.f, 0.f, 0.f, 0.f};
        cur = nxt; cA = nA; cB = nB; ++ui;
        if constexpr (ALIGN_EPI) { if (wr == 1) PG8_BAR; }
    }
    PG8_WAIT_V(0);
    if constexpr (!ALIGN_EPI) { if (wr == 0) PG8_BAR; }
    PG8_BAR;
    if constexpr (Epi::AFTER_DRAIN) { E.fused(acc, cur, wr, wc, fr, fq, lds, wid, lane); S.done(cur); }
#undef PG8_SA
#undef PG8_SB
#undef PG8_STAGE
#undef PG8_LDA
#undef PG8_LDB
#undef PG8_MMA
#undef PG8_WAIT_V
#undef PG8_WAIT_L
#undef PG8_BAR
#undef PG8_SCHED
}
}
#define GAS __attribute__((address_space(1)))
#define LAS __attribute__((address_space(3)))
typedef unsigned short bf16;
typedef unsigned v4u __attribute__((ext_vector_type(4)));
typedef float f32x4 __attribute__((ext_vector_type(4)));
typedef short bf16x8 __attribute__((ext_vector_type(8)));
typedef GAS unsigned gu32;
typedef GAS unsigned long long gu64;
#define RLX_AGENT __ATOMIC_RELAXED, __HIP_MEMORY_SCOPE_AGENT
#define LDS_WAIT() asm volatile("s_waitcnt lgkmcnt(0)" ::: "memory")
#define VM_WAIT() asm volatile("s_waitcnt vmcnt(0)" ::: "memory")
__device__ __forceinline__ unsigned long long rt() { return __builtin_amdgcn_s_memrealtime(); }
__device__ __forceinline__ unsigned f2bf(float f) { unsigned u = __builtin_bit_cast(unsigned, f); return (u + 0x7fffu + ((u >> 16) & 1u)) >> 16; }
typedef float f32x2_t __attribute__((ext_vector_type(2)));
typedef __bf16 bf16x2_t __attribute__((ext_vector_type(2)));
__device__ __forceinline__ unsigned pk2(float lo, float hi) { f32x2_t v = {lo, hi}; bf16x2_t b = __builtin_convertvector(v, bf16x2_t); return __builtin_bit_cast(unsigned, b); }
#define XB_TMO      128
#define XB_XCNT(j)  (256  + 64 * (j))
#define XB_XSUB(j)  (1280 + 64 * (j))
#define XB_XGEN(j)  (2304 + 64 * (j))
#define XB_TOP      3328
#define XB_TOPGEN   3392
#define XCD_BAR_WORDS 3456
#define XB_SPIN_CAP (1u << 18)

__device__ __forceinline__ unsigned xb_ld(unsigned* p)              { return __hip_atomic_load(p, __ATOMIC_RELAXED, __HIP_MEMORY_SCOPE_AGENT); }
__device__ __forceinline__ unsigned xb_add(unsigned* p, unsigned v) { return __hip_atomic_fetch_add(p, v, __ATOMIC_RELAXED, __HIP_MEMORY_SCOPE_AGENT); }
__device__ __forceinline__ unsigned xb_xcc_id() { return (unsigned)__builtin_amdgcn_s_getreg((3 << 11) | 20) & 0xFu; }
#define XB_SPIN(cond, bar) do { unsigned _sp = 0; while (cond) { __builtin_amdgcn_s_sleep(1); \
    if ((++_sp & 255u) == 0u) { if (xb_ld(&(bar)[XB_TMO])) break; if (_sp > XB_SPIN_CAP) { atomicAdd(&(bar)[XB_TMO], 1u); break; } } } } while (0)

struct XcdBarrier {
    unsigned* bar; unsigned x;
    volatile LAS unsigned* st;
};

__device__ __forceinline__ XcdBarrier xcd_barrier_post(unsigned* bar, volatile LAS unsigned* st) {
    XcdBarrier b; b.bar = bar; b.x = xb_xcc_id(); b.st = st;
    if (threadIdx.x == 0) (void)xb_add(&bar[XB_XCNT(b.x)], 1u);
    return b;
}
__device__ __forceinline__ void xcd_barrier_complete(unsigned* bar, unsigned x, unsigned& nloc, unsigned& nx) {
    const unsigned G = gridDim.x * gridDim.y * gridDim.z;
    unsigned sum, cnt, mine, sp = 0u;
    for (;;) {
        sum = 0u; cnt = 0u; mine = 0u;
#pragma unroll
        for (unsigned j = 0; j < 16; ++j) { const unsigned c = xb_ld(&bar[XB_XCNT(j)]); sum += c; cnt += (c > 0u) ? 1u : 0u; mine = (j == x) ? c : mine; }
        if (sum == G) break;
        __builtin_amdgcn_s_sleep(1);
        if ((++sp & 255u) == 0u) { if (xb_ld(&bar[XB_TMO])) break; if (sp > XB_SPIN_CAP) { atomicAdd(&bar[XB_TMO], 1u); break; } }
    }
    nloc = mine > 0u ? mine : 1u; nx = cnt > 0u ? cnt : 1u;
}

__device__ __forceinline__ void xcd_barrier(const XcdBarrier& b) {
    asm volatile("s_waitcnt vmcnt(0)" ::: "memory");
    __syncthreads();
    if (threadIdx.x == 0) {
        unsigned* bar = b.bar;
        __builtin_amdgcn_s_waitcnt(0);
        unsigned nloc = b.st[0], nx = b.st[1];
        if (nloc == 0u) { xcd_barrier_complete(bar, b.x, nloc, nx); b.st[0] = nloc; b.st[1] = nx; }
        const unsigned old = xb_add(&bar[XB_XSUB(b.x)], 1u);
        const unsigned gen = old / nloc;
        if (old + 1u == (gen + 1u) * nloc) {
            __builtin_amdgcn_fence(__ATOMIC_RELEASE, "agent");
            asm volatile("s_waitcnt vmcnt(0)" ::: "memory");
            const unsigned og = xb_add(&bar[XB_TOP], 1u);
            const unsigned tg = og / nx;
            if (og + 1u == (tg + 1u) * nx) xb_add(&bar[XB_TOPGEN], 1u);
            else XB_SPIN(xb_ld(&bar[XB_TOPGEN]) == tg, bar);
            __builtin_amdgcn_fence(__ATOMIC_ACQUIRE, "agent");
            xb_add(&bar[XB_XGEN(b.x)], 1u);
            asm volatile("s_waitcnt vmcnt(0)" ::: "memory");
        } else {
            XB_SPIN(xb_ld(&bar[XB_XGEN(b.x)]) == gen, bar);
            __builtin_amdgcn_fence(__ATOMIC_ACQUIRE, "agent");
            asm volatile("s_waitcnt vmcnt(0)" ::: "memory");
        }
    }
    __syncthreads();
}
constexpr int NWAVES = 8;
constexpr int DM = 4096, TP = 16384, TS = 8192, TT = 24576, NLAYER = 2;
constexpr int INC = 9792, ZC = 9984;
constexpr int Z_CQ = 3072, Z_CKV = 4608, Z_KR = 5120, Z_DQ = 5376, Z_DK = 6912, Z_DV = 8448;
constexpr int QC = 2304, KVC = 3072, DFF = 16384;
constexpr float EPS = 1e-6f;
constexpr int NPH_LAYER = 13, NPHASES = 1 + NLAYER * NPH_LAYER;

constexpr size_t MiB = 1u << 20;
constexpr size_t WS_CTL = 0, CTL_ZERO_BYTES = 1 * MiB;
constexpr size_t WS_R64 = 1 * MiB, WS_R128 = 3 * MiB;
constexpr size_t WS_FILT = 7 * MiB, FILT_LAYER = 40 * MiB, FILT_S_OFF = 8 * MiB;
constexpr size_t WS_WT = 87 * MiB;
constexpr size_t WT_IN = 0, WT_OUT = 78 * MiB, WT_UP = 110 * MiB, WT_DN = 238 * MiB, WT_QB = 366 * MiB, WT_KVB = WT_QB + 7077888, WT_LAYER = WT_KVB + 3 * MiB;
constexpr size_t WS_H = WS_WT + 2 * WT_LAYER;
constexpr size_t WS_A2 = WS_H + 192 * MiB;
constexpr size_t WS_Z = WS_A2, WS_Q = WS_Z + 468 * MiB, WS_KV = WS_Q + 108 * MiB, WS_UT = WS_KV + 144 * MiB;
constexpr size_t WS_CQ = WS_A2 + 768 * MiB, WS_CKV = WS_CQ + 72 * MiB, WS_KR = WS_CKV + 24 * MiB, WS_X0T = WS_KR + 3 * MiB, WS_YT = WS_X0T + 48 * MiB, WS_DLSE = WS_YT + 48 * MiB;
constexpr size_t WS_END = WS_DLSE + 2 * MiB;
static_assert(WS_END <= 2048 * MiB, "workspace map fits 2 GiB");

constexpr int CW_TMO = 0, CW_BAR = 4096;
constexpr int RING_BYTES = 131072, LDSCTL_OFF = RING_BYTES, MISC_OFF = LDSCTL_OFF + 320, WSCR_OFF = RING_BYTES + 1024, PTAB_OFF = RING_BYTES + 2048, LDS_BYTES = 147456;

typedef unsigned short bf16;
typedef unsigned v4u __attribute__((ext_vector_type(4)));
typedef unsigned v2u __attribute__((ext_vector_type(2)));
typedef float f32x4 __attribute__((ext_vector_type(4)));
typedef float f32x2v __attribute__((ext_vector_type(2)));
typedef float f32x16 __attribute__((ext_vector_type(16)));
typedef short bf16x8 __attribute__((ext_vector_type(8)));
typedef short s16x4 __attribute__((ext_vector_type(4)));
#define SBAR() __builtin_amdgcn_sched_barrier(0)
struct InTab { const float* const (&t)[31]; __device__ __forceinline__ const float* operator[](int k) const { return t[k]; } };

__device__ __forceinline__ float bf2f(unsigned v) { return __uint_as_float(v << 16); }
__device__ __forceinline__ float bflo(unsigned w) { return __uint_as_float(w << 16); }
__device__ __forceinline__ float bfhi(unsigned w) { return __uint_as_float(w & 0xffff0000u); }
__device__ __forceinline__ float wave_sum(float v) {
#pragma unroll
    for (int o = 1; o < 64; o <<= 1) v += __shfl_xor(v, o);
    return v;
}
__device__ __forceinline__ void unpack8(const v4u w, float (&f)[8]) { f[0] = bflo(w.x); f[1] = bfhi(w.x); f[2] = bflo(w.y); f[3] = bfhi(w.y); f[4] = bflo(w.z); f[5] = bfhi(w.z); f[6] = bflo(w.w); f[7] = bfhi(w.w); }
__device__ __forceinline__ v4u pack8(const float (&f)[8]) { v4u w; w.x = pk2(f[0], f[1]); w.y = pk2(f[2], f[3]); w.z = pk2(f[4], f[5]); w.w = pk2(f[6], f[7]); return w; }
__device__ __forceinline__ int seq_pos(int m) { return m < TP ? (m & 2047) : (m - TP); }
__device__ __forceinline__ int seq_len(int m) { return m < TP ? 2048 : 8192; }

__device__ __forceinline__ void transpose_item(const float* W, int ldw, bf16* WT, int K, int k0, int nsrc, int ndst, LAS float* scr, int lane) {
#pragma unroll 8
    for (int i = 0; i < 32; ++i) { const int kk = 2 * i + (lane >> 5); scr[kk * 33 + (lane & 31)] = W[(size_t)(k0 + kk) * ldw + nsrc + (lane & 31)]; }
    LDS_WAIT(); asm volatile("" ::: "memory");
    const int c = lane & 7;
#pragma unroll
    for (int j = 0; j < 4; ++j) { const int n = (lane >> 3) + 8 * j; const LAS float* s = scr + (8 * c) * 33 + n;
        v4u o; o.x = pk2(s[0 * 33], s[1 * 33]); o.y = pk2(s[2 * 33], s[3 * 33]); o.z = pk2(s[4 * 33], s[5 * 33]); o.w = pk2(s[6 * 33], s[7 * 33]);
        *(GAS v4u*)(WT + (size_t)(ndst + n) * K + k0 + 8 * c) = o; }
    LDS_WAIT(); asm volatile("" ::: "memory");
}
constexpr int I_IN = 64 * 306, I_OUT = 64 * 128, I_UP = 64 * 512, I_DN = 256 * 128, I_QB = 24 * 72, I_KVB = 8 * 96, I_LAYER = I_IN + I_OUT + I_UP + I_DN + I_QB + I_KVB;
__device__ __forceinline__ void p0_weights(const InTab in, unsigned char* ws, LAS float* scr, int gw, int NGW, int lane) {
    for (int it = gw; it < NLAYER * I_LAYER; it += NGW) {
        const int l = it / I_LAYER; int r = it % I_LAYER; unsigned char* wl = ws + WS_WT + (size_t)l * WT_LAYER;
        if (r < I_IN) { const int kb = r / 306, nb = r % 306, n0 = 32 * nb; transpose_item(in[3] + (size_t)l * DM * INC, INC, (bf16*)(wl + WT_IN), DM, 64 * kb, n0, n0 < 5184 ? n0 : n0 + 192, scr, lane); continue; } r -= I_IN;
        if (r < I_OUT) { const int kb = r / 128, nb = r % 128; transpose_item(in[27] + (size_t)l * DM * DM, DM, (bf16*)(wl + WT_OUT), DM, 64 * kb, 32 * nb, 32 * nb, scr, lane); continue; } r -= I_OUT;
        if (r < I_UP) { const int kb = r / 512, nb = r % 512; transpose_item(in[29] + (size_t)l * DM * DFF, DFF, (bf16*)(wl + WT_UP), DM, 64 * kb, 32 * nb, 32 * nb, scr, lane); continue; } r -= I_UP;
        if (r < I_DN) { const int kb = r / 128, nb = r % 128; transpose_item(in[30] + (size_t)l * DFF * DM, DM, (bf16*)(wl + WT_DN), DFF, 64 * kb, 32 * nb, 32 * nb, scr, lane); continue; } r -= I_DN;
        if (r < I_QB) { const int kb = r / 72, nb = r % 72, n0 = 32 * nb, h = n0 / 192, j = n0 % 192;
            transpose_item(in[17] + (size_t)l * 1536 * QC, QC, (bf16*)(wl + WT_QB), 1536, 64 * kb, n0, j < 128 ? h * 128 + j : 1536 + h * 64 + (j - 128), scr, lane); continue; } r -= I_QB;
        { const int kb = r / 96, nb = r % 96; transpose_item(in[19] + (size_t)l * 512 * KVC, KVC, (bf16*)(wl + WT_KVB), 512, 64 * kb, 32 * nb, 32 * nb, scr, lane); }
    }
}
__device__ __forceinline__ void p0_misc(unsigned char* ws, int gt, int NGT) {
    for (int i = gt; i < NLAYER * 98304; i += NGT) { const int l = i / 98304, r = i % 98304; *(GAS v4u*)(ws + WS_WT + (size_t)l * WT_LAYER + WT_IN + (size_t)5184 * DM * 2 + (size_t)r * 16) = (v4u){0u, 0u, 0u, 0u}; }
    for (int i = gt; i < 8192 * 96; i += NGT) { const int pos = i / 96, j = i % 96; float sv, cv;
        if (j < 32) { const float inv = 1.0f / powf(10000.0f, (float)(2 * j) / 64.0f); sincosf((float)pos * inv, &sv, &cv); ((GAS f32x2v*)(ws + WS_R64))[pos * 32 + j] = (f32x2v){cv, sv}; }
        else { const int jj = j - 32; const float inv = 1.0f / powf(10000.0f, (float)(2 * jj) / 128.0f); sincosf((float)pos * inv, &sv, &cv); ((GAS f32x2v*)(ws + WS_R128))[pos * 64 + jj] = (f32x2v){cv, sv}; } }
}
__device__ __forceinline__ void filter_item(const InTab in, unsigned char* ws, int layer, int trunk, int pblk, LAS unsigned char* lds, int tid, int lane, int wave) {
    const int L = trunk ? 8192 : 2048, p0 = pblk * 64;
    const float *w1 = in[6] + layer * 33 * 64, *b1 = in[7] + layer * 64, *w2 = in[8] + layer * 4096, *b2 = in[9] + layer * 64, *w3 = in[10] + layer * 4096, *b3 = in[11] + layer * 64;
    const float *w4 = in[12] + (size_t)layer * 64 * 2048, *b4 = in[13] + layer * 2048; const float fq = in[14][layer * 64 + lane];
    bf16* Rg = (bf16*)(ws + WS_FILT + (size_t)layer * FILT_LAYER + (trunk ? FILT_S_OFF : 0));
    float tpos[8], hv[8], acc[8];
#pragma unroll
    for (int i = 0; i < 8; ++i) { const int p = p0 + 8 * wave + i; tpos[i] = (float)p / (float)(L - 1); const float w = 6.283185307179586f * (float)p / (float)L;
        float e = 0.f;
        if (lane == 0) e = tpos[i];
        else if (lane <= 16) { const float f = 1e-4f + (float)(lane - 1) * ((15.0f - 1e-4f) / 15.0f); e = cosf(f * w); }
        else if (lane <= 32) { const float f = 1e-4f + (float)(lane - 17) * ((15.0f - 1e-4f) / 15.0f); e = -sinf(f * w); }
        hv[i] = e; acc[i] = b1[lane]; }
    for (int j = 0; j < 33; ++j) { const float wj = w1[j * 64 + lane];
#pragma unroll
        for (int i = 0; i < 8; ++i) acc[i] += __shfl(hv[i], j) * wj; }
#pragma unroll
    for (int i = 0; i < 8; ++i) { hv[i] = sinf(fq * acc[i]); acc[i] = b2[lane]; }
    for (int j = 0; j < 64; ++j) { const float wj = w2[j * 64 + lane];
#pragma unroll
        for (int i = 0; i < 8; ++i) acc[i] += __shfl(hv[i], j) * wj; }
#pragma unroll
    for (int i = 0; i < 8; ++i) { hv[i] = sinf(fq * acc[i]); acc[i] = b3[lane]; }
    for (int j = 0; j < 64; ++j) { const float wj = w3[j * 64 + lane];
#pragma unroll
        for (int i = 0; i < 8; ++i) acc[i] += __shfl(hv[i], j) * wj; }
#pragma unroll
    for (int i = 0; i < 8; ++i) hv[i] = sinf(fq * acc[i]);
    LAS bf16* tile = (LAS bf16*)lds;
    for (int m = 0; m < 32; ++m) {
        const int col = 64 * m + lane, ch = col & 1023;
        const float bb = b4[col];
#pragma unroll
        for (int i = 0; i < 8; ++i) acc[i] = bb;
        for (int j = 0; j < 64; ++j) { const float wj = w4[j * 2048 + col];
#pragma unroll
            for (int i = 0; i < 8; ++i) acc[i] += __shfl(hv[i], j) * wj; }
        const float delta = fabsf(-3.0701134573253944f + (float)ch * ((-15.350567286626972f + 3.0701134573253944f) / 1023.0f));
#pragma unroll
        for (int i = 0; i < 8; ++i) tile[lane * 66 + 8 * wave + i] = (bf16)f2bf(acc[i] * expf(-tpos[i] * delta));
        __syncthreads();
        { const int row = tid >> 3, g8 = tid & 7, cc = 64 * m + row; const bool fwd = cc < 1024; bf16* Rc = Rg + (size_t)(cc & 1023) * (2 * L);
#pragma unroll
          for (int e = 0; e < 8; ++e) { const int pl = 8 * g8 + e, p = p0 + pl; const bf16 v = tile[row * 66 + pl];
              if (fwd) Rc[L - p] = v; else { if (p == 0) Rc[0] = 0; else Rc[L + p] = v; } } }
        __syncthreads();
    }
}
__device__ __forceinline__ void rms_rows(const float* x0, const float* x1, const float* g, bf16* H, int gw, int NGW, int lane) {
    for (int m = gw; m < TT; m += NGW) {
        const GAS f32x4* xr = (const GAS f32x4*)((m < TP ? x0 : x1) + (size_t)m * DM) + lane;
        f32x4 v[16]; float s = 0.f;
#pragma unroll
        for (int j = 0; j < 16; ++j) { v[j] = xr[64 * j]; s += (v[j].x * v[j].x + v[j].y * v[j].y) + (v[j].z * v[j].z + v[j].w * v[j].w); }
        const float rs = 1.0f / sqrtf(wave_sum(s) * (1.0f / DM) + EPS);
        GAS v2u* o8 = (GAS v2u*)(H + (size_t)m * DM) + lane; const GAS f32x4* gr = (const GAS f32x4*)g + lane;
#pragma unroll
        for (int j = 0; j < 16; ++j) { const f32x4 gg = gr[64 * j]; v2u w; w.x = pk2(v[j].x * rs * gg.x, v[j].y * rs * gg.y); w.y = pk2(v[j].z * rs * gg.z, v[j].w * rs * gg.w); o8[64 * j] = w; }
    }
}
__device__ __forceinline__ void prep_hyena(const bf16* Z, const float* cw, const float* cb, bf16* UT, bf16* X0T, LAS unsigned char* lds, int tid, int bid, int G) {
    LAS bf16* TU = (LAS bf16*)lds; LAS bf16* TX = (LAS bf16*)(lds + 64 * 132);
    for (int tile = bid; tile < 384 * 16; tile += G) {
        const int tb = tile >> 4, cbk = tile & 15, row = tid >> 3, c8 = (tid & 7) * 8, m = tb * 64 + row, c0 = cbk * 64 + c8;
        const int pos = seq_pos(m), L = seq_len(m); const bool hasm = pos > 0, hasp = pos < L - 1;
        float xc[3][8];
#pragma unroll
        for (int gI = 0; gI < 3; ++gI) {
            const bf16* zp = Z + (size_t)m * ZC + gI * 1024 + c0; const v4u z0 = *(const GAS v4u*)zp;
            const v4u zm = hasm ? *(const GAS v4u*)(zp - ZC) : (v4u){0u, 0u, 0u, 0u}; const v4u zq = hasp ? *(const GAS v4u*)(zp + ZC) : (v4u){0u, 0u, 0u, 0u};
            float a[8], b[8], c[8]; unpack8(zm, a); unpack8(z0, b); unpack8(zq, c);
            const float* wp = cw + gI * 1024 + c0;
#pragma unroll
            for (int e = 0; e < 8; ++e) xc[gI][e] = a[e] * wp[e] + b[e] * wp[3072 + e] + c[e] * wp[6144 + e] + cb[gI * 1024 + c0 + e];
        }
#pragma unroll
        for (int e = 0; e < 8; ++e) { TU[(c8 + e) * 66 + row] = (bf16)f2bf(xc[1][e] * xc[2][e]); TX[(c8 + e) * 66 + row] = (bf16)f2bf(xc[0][e]); }
        __syncthreads();
        { const int c = tid >> 3, t8 = (tid & 7) * 8; const LAS unsigned* su = (const LAS unsigned*)(TU + c * 66 + t8); const LAS unsigned* sx = (const LAS unsigned*)(TX + c * 66 + t8);
          const v4u wu = {su[0], su[1], su[2], su[3]}, wx = {sx[0], sx[1], sx[2], sx[3]};
          const size_t o = (size_t)(cbk * 64 + c) * TT + tb * 64 + t8; *(GAS v4u*)(UT + o) = wu; *(GAS v4u*)(X0T + o) = wx; }
        __syncthreads();
    }
}
__device__ __forceinline__ void prep_tokens(bf16* Z, const InTab in, int l, unsigned char* ws, int gw, int NGW, int lane) {
    bf16* CQ = (bf16*)(ws + WS_CQ); bf16* CKV = (bf16*)(ws + WS_CKV); bf16* KR = (bf16*)(ws + WS_KR);
    const GAS f32x2v* R64 = (const GAS f32x2v*)(ws + WS_R64); const GAS f32x2v* R128 = (const GAS f32x2v*)(ws + WS_R128);
    const float* gq = in[16] + l * 1536; const float* gkv = in[18] + l * 512; const float* gkr = in[23] + l * 64; const float* gdq = in[24] + l * 128; const float* gdk = in[25] + l * 128;
    for (int m = gw; m < TT; m += NGW) {
        const int pos = seq_pos(m); bf16* zr = Z + (size_t)m * ZC;
        {
            float x[3][8]; float s = 0.f;
#pragma unroll
            for (int j = 0; j < 3; ++j) { unpack8(*(const GAS v4u*)(zr + Z_CQ + lane * 8 + 512 * j), x[j]);
#pragma unroll
                for (int e = 0; e < 8; ++e) s += x[j][e] * x[j][e]; }
            const float rs = 1.0f / sqrtf(wave_sum(s) * (1.0f / 1536.0f) + EPS);
#pragma unroll
            for (int j = 0; j < 3; ++j) { const int c = lane * 8 + 512 * j; float y[8];
#pragma unroll
                for (int e = 0; e < 8; ++e) y[e] = x[j][e] * rs * gq[c + e];
                *(GAS v4u*)(CQ + (size_t)m * 1536 + c) = pack8(y); }
        }
        {
            float x[8], y[8]; float s = 0.f; unpack8(*(const GAS v4u*)(zr + Z_CKV + lane * 8), x);
#pragma unroll
            for (int e = 0; e < 8; ++e) s += x[e] * x[e];
            const float rs = 1.0f / sqrtf(wave_sum(s) * (1.0f / 512.0f) + EPS);
#pragma unroll
            for (int e = 0; e < 8; ++e) y[e] = x[e] * rs * gkv[lane * 8 + e];
            *(GAS v4u*)(CKV + (size_t)m * 512 + lane * 8) = pack8(y);
        }
        {
            const float x = bf2f(zr[Z_KR + lane]); const float rs = 1.0f / sqrtf(wave_sum(x * x) * (1.0f / 64.0f) + EPS);
            const float y = x * rs * gkr[lane], pr = __shfl_xor(y, 32); const f32x2v cs = R64[pos * 32 + (lane & 31)];
            KR[(size_t)m * 64 + lane] = (bf16)f2bf(lane < 32 ? y * cs.x - pr * cs.y : y * cs.x + pr * cs.y);
        }
#pragma unroll 1
        for (int it = 0; it < 6; ++it) {
            const int chunk = it * 64 + lane, d0 = (chunk & 15) * 8; bf16* p = zr + Z_DQ + chunk * 8; const float* gg = (chunk < 192 ? gdq : gdk) + d0;
            float x[8], y[8]; float s = 0.f; unpack8(*(const GAS v4u*)p, x);
#pragma unroll
            for (int e = 0; e < 8; ++e) s += x[e] * x[e];
            s += __shfl_xor(s, 1); s += __shfl_xor(s, 2); s += __shfl_xor(s, 4); s += __shfl_xor(s, 8);
            const float rs = 1.0f / sqrtf(s * (1.0f / 128.0f) + EPS); const bool lo = (chunk & 8) == 0; const int i0 = (chunk & 7) * 8;
#pragma unroll
            for (int e = 0; e < 8; ++e) { const float v = x[e] * rs * gg[e], pr = __shfl_xor(v, 8); const f32x2v cs = R128[pos * 64 + i0 + e]; y[e] = lo ? v * cs.x - pr * cs.y : v * cs.x + pr * cs.y; }
            *(GAS v4u*)p = pack8(y);
        }
    }
}
__device__ __forceinline__ void mla_post(bf16* Q, bf16* KV, const InTab in, int l, unsigned char* ws, int gw, int NGW, int lane) {
    const GAS f32x2v* R64 = (const GAS f32x2v*)(ws + WS_R64);
    const float* gqn = in[20] + l * 128; const float* gqr = in[21] + l * 64; const float* gkn = in[22] + l * 128;
    for (int m = gw; m < TT; m += NGW) {
        const int pos = seq_pos(m);
#pragma unroll 1
        for (int it = 0; it < 6; ++it) {
            const int chunk = (it % 3) * 64 + lane, d0 = (chunk & 15) * 8; const bool isq = it < 3;
            bf16* p = isq ? Q + (size_t)m * QC + chunk * 8 : KV + (size_t)m * KVC + (chunk >> 4) * 256 + d0; const float* gg = (isq ? gqn : gkn) + d0;
            float x[8], y[8]; float s = 0.f; unpack8(*(const GAS v4u*)p, x);
#pragma unroll
            for (int e = 0; e < 8; ++e) s += x[e] * x[e];
            s += __shfl_xor(s, 1); s += __shfl_xor(s, 2); s += __shfl_xor(s, 4); s += __shfl_xor(s, 8);
            const float rs = 1.0f / sqrtf(s * (1.0f / 128.0f) + EPS);
#pragma unroll
            for (int e = 0; e < 8; ++e) y[e] = x[e] * rs * gg[e];
            *(GAS v4u*)p = pack8(y);
        }
#pragma unroll 1
        for (int it = 0; it < 2; ++it) {
            const int chunk = it * 64 + lane; const bool act = chunk < 96; const int i0 = (chunk & 3) * 8, d0 = (chunk & 7) * 8; bf16* p = Q + (size_t)m * QC + 1536 + chunk * 8;
            float x[8], y[8]; float s = 0.f; v4u w = {0u, 0u, 0u, 0u}; if (act) w = *(const GAS v4u*)p; unpack8(w, x);
#pragma unroll
            for (int e = 0; e < 8; ++e) s += x[e] * x[e];
            s += __shfl_xor(s, 1); s += __shfl_xor(s, 2); s += __shfl_xor(s, 4);
            const float rs = 1.0f / sqrtf(s * (1.0f / 64.0f) + EPS); const bool lo = (chunk & 4) == 0;
#pragma unroll
            for (int e = 0; e < 8; ++e) { const float v = x[e] * rs * gqr[d0 + e], pr = __shfl_xor(v, 4); const f32x2v cs = R64[pos * 32 + i0 + e]; y[e] = lo ? v * cs.x - pr * cs.y : v * cs.x + pr * cs.y; }
            if (act) *(GAS v4u*)p = pack8(y);
        }
    }
}
constexpr int CV_BS = 144, CV_RAW = 57344, CV_FC = 61696, CV_CS = 4240;
template <int TRUNK>
__device__ __forceinline__ void conv_unit(int c, const bf16* Rg, const bf16* UT, const bf16* X0T, bf16* YT, float skip, LAS unsigned char* lds, int tid, int lane, int wave) {
    constexpr int L = TRUNK ? 8192 : 2048, NB = L / 64, NBAT = TRUNK ? 1 : 8, PADB = TRUNK ? 32 : 8, NBLK = NB + 2 * PADB, UBS = NBLK * CV_BS + (TRUNK ? 0 : 16);
    constexpr int NR = TRUNK ? 1 : 2, TOK0 = TRUNK ? TP : 0, DC0 = TRUNK ? -128 : -32, DC1 = TRUNK ? 128 : 32;
    static_assert(NBAT * UBS <= CV_RAW, "u image fits");
    const bf16* urow = UT + (size_t)c * TT + TOK0;
    __syncthreads();
    for (int i = tid; i < NBAT * 2 * PADB * 8; i += 512) { const int b = i / (2 * PADB * 8), r = i % (2 * PADB * 8), pb = r >> 3, o8 = r & 7, blk = pb < PADB ? pb : pb + NB;
        *(LAS v4u*)(lds + b * UBS + blk * CV_BS + o8 * 16) = (v4u){0u, 0u, 0u, 0u}; }
    for (int ci = tid; ci < NBAT * L / 8; ci += 512) { const int b = ci / (L / 8), r = ci % (L / 8), blk = r >> 3, o8 = r & 7;
        *(LAS v4u*)(lds + b * UBS + (blk + PADB) * CV_BS + o8 * 16) = *(const GAS v4u*)(urow + (size_t)ci * 8); }
    const int n = lane & 31, h = lane >> 5;
    int batch, t1, dlo, dhi, R0;
    if (TRUNK == 0) { const int g = wave & 3, bh = wave >> 2; batch = 4 * bh + (n >> 3); t1 = 8 * g + (n & 7); dlo = 8 * g - 31; dhi = 8 * g + 7; R0 = 0; }
    else { const int Nb = wave & 3; batch = 0; t1 = 32 * Nb + n; dlo = 32 * Nb - 127; dhi = 32 * Nb + 31; R0 = wave >> 2; }
    const int sl = (8 - (n & 7)) & 7;
    const int abase0 = CV_FC + sl * CV_CS + 2 * (2048 - n + 8 * h - sl) - 64 * R0;
    const int bbase0 = batch * UBS + (t1 + PADB) * CV_BS + 16 * h;
    f32x16 acc[NR];
#pragma unroll
    for (int r = 0; r < NR; ++r) acc[r] = (f32x16){0.f, 0.f, 0.f, 0.f, 0.f, 0.f, 0.f, 0.f, 0.f, 0.f, 0.f, 0.f, 0.f, 0.f, 0.f, 0.f};
#pragma unroll 1
    for (int dc = DC0; dc < DC1; dc += 32) {
        const int nb0 = L - 64 * (dc + 32);
        __syncthreads();
        for (int i = tid; i < 265; i += 512) { const int nn = nb0 + 8 * i; v4u w = {0u, 0u, 0u, 0u}; if (nn + 8 <= 2 * L) w = *(const GAS v4u*)(Rg + nn); *(LAS v4u*)(lds + CV_RAW + 16 * i) = w; }
        __syncthreads();
        for (int idx = tid; idx < 8 * 264; idx += 512) { const int s = idx / 264, i = idx % 264; const LAS bf16* rp = (const LAS bf16*)(lds + CV_RAW) + 8 * i + s;
            v4u w; w.x = (unsigned)rp[0] | ((unsigned)rp[1] << 16); w.y = (unsigned)rp[2] | ((unsigned)rp[3] << 16); w.z = (unsigned)rp[4] | ((unsigned)rp[5] << 16); w.w = (unsigned)rp[6] | ((unsigned)rp[7] << 16);
            *(LAS v4u*)(lds + CV_FC + s * CV_CS + 16 * i) = w; }
        __syncthreads();
#pragma unroll 1
        for (int dd = 0; dd < 32; ++dd) {
            const int d = dc + dd; if (d < dlo || d > dhi) continue;
            const int ab = abase0 - 128 * dd, bb = bbase0 - d * CV_BS;
#pragma unroll
            for (int kb = 0; kb < 4; ++kb) {
                const bf16x8 bf = *(const LAS bf16x8*)(lds + bb + 32 * kb);
#pragma unroll
                for (int r = 0; r < NR; ++r) { const bf16x8 af = *(const LAS bf16x8*)(lds + ab - 64 * r + 32 * kb); acc[r] = __builtin_amdgcn_mfma_f32_32x32x16_bf16(af, bf, acc[r], 0, 0, 0); }
            }
        }
    }
    const size_t tokb = (size_t)c * TT + TOK0 + batch * 2048 + 64 * t1;
#pragma unroll
    for (int r = 0; r < NR; ++r)
#pragma unroll
        for (int kq = 0; kq < 4; ++kq) { const int t0 = 32 * (R0 + r) + 8 * kq + 4 * h;
            const v2u uu = *(const LAS v2u*)(lds + batch * UBS + (t1 + PADB) * CV_BS + 2 * t0); const v2u xx = *(const GAS v2u*)(X0T + tokb + t0);
            const float y0 = bflo(xx.x) * (acc[r][4 * kq + 0] + bflo(uu.x) * skip), y1 = bfhi(xx.x) * (acc[r][4 * kq + 1] + bfhi(uu.x) * skip);
            const float y2 = bflo(xx.y) * (acc[r][4 * kq + 2] + bflo(uu.y) * skip), y3 = bfhi(xx.y) * (acc[r][4 * kq + 3] + bfhi(uu.y) * skip);
            v2u o; o.x = pk2(y0, y1); o.y = pk2(y2, y3); *(GAS v2u*)(YT + tokb + t0) = o; }
}
__device__ __forceinline__ int crow(int r, int hi) { return (r & 3) + 8 * (r >> 2) + 4 * hi; }
__device__ __forceinline__ unsigned cvtpk(float lo, float hi) { unsigned r; asm volatile("v_cvt_pk_bf16_f32 %0, %1, %2" : "=v"(r) : "v"(lo), "v"(hi)); return r; }
__device__ __forceinline__ void glds16(const void* g, LAS unsigned char* l) { __builtin_amdgcn_global_load_lds((const unsigned*)g, (LAS unsigned*)l, 16, 0, 0); }
__device__ __forceinline__ int v_st(int k, int c) { const int kk = (k & ~0xC) | ((k & 4) << 1) | ((k & 8) >> 1); return ((kk >> 3) * 4 + (c >> 5)) * 512 + ((kk & 7) * 32 + (c & 31)) * 2; }
__device__ __forceinline__ int v_rd_base(int lane) { return ((lane & 3) << 3) | (((lane >> 2) & 3) << 6) | (((lane >> 4) & 1) << 5) | (((lane >> 5) & 1) << 8); }
constexpr int v_rd_off(int d0, int ks, int half) { return d0 * 512 + ks * 4096 + half * 2048; }
__device__ __forceinline__ void v_inv(int P, int& k, int& c) { const int sub = P >> 9, w = (P & 511) >> 1, kk = ((sub >> 2) << 3) | (w >> 5); c = ((sub & 3) << 5) | (w & 31); k = (kk & ~0xC) | ((kk & 4) << 1) | ((kk & 8) >> 1); }
template <int OFF> __device__ __forceinline__ s16x4 tr_read(int vb) { s16x4 r; asm volatile("ds_read_b64_tr_b16 %0, %1 offset:%2" : "=&v"(r) : "v"(vb), "i"(OFF) : "memory"); return r; }
template <int D0> __device__ __forceinline__ void pv_one(f32x16& od, int vb, bf16x8 pa0, bf16x8 pa1, bf16x8 pa2, bf16x8 pa3) {
    const s16x4 l0 = tr_read<v_rd_off(D0, 0, 0)>(vb), h0 = tr_read<v_rd_off(D0, 0, 1)>(vb), l1 = tr_read<v_rd_off(D0, 1, 0)>(vb), h1 = tr_read<v_rd_off(D0, 1, 1)>(vb);
    const s16x4 l2 = tr_read<v_rd_off(D0, 2, 0)>(vb), h2 = tr_read<v_rd_off(D0, 2, 1)>(vb), l3 = tr_read<v_rd_off(D0, 3, 0)>(vb), h3 = tr_read<v_rd_off(D0, 3, 1)>(vb);
    asm volatile("s_waitcnt lgkmcnt(0)" ::: "memory"); SBAR();
#define PKV(Lx, Hx) (bf16x8){Lx[0], Lx[1], Lx[2], Lx[3], Hx[0], Hx[1], Hx[2], Hx[3]}
    od = __builtin_amdgcn_mfma_f32_32x32x16_bf16(pa0, PKV(l0, h0), od, 0, 0, 0);
    od = __builtin_amdgcn_mfma_f32_32x32x16_bf16(pa1, PKV(l1, h1), od, 0, 0, 0);
    od = __builtin_amdgcn_mfma_f32_32x32x16_bf16(pa2, PKV(l2, h2), od, 0, 0, 0);
    od = __builtin_amdgcn_mfma_f32_32x32x16_bf16(pa3, PKV(l3, h3), od, 0, 0, 0);
#undef PKV
}
__device__ __forceinline__ void softmax_pv(f32x16& p0, f32x16& p1, float& m_reg, float& l_reg, f32x16 (&o)[4], int vb, LAS float* al, float C, int r32, int hi) {
    float pmax = p0[0];
#pragma unroll
    for (int r = 1; r < 16; ++r) pmax = fmaxf(pmax, p0[r]);
#pragma unroll
    for (int r = 0; r < 16; ++r) pmax = fmaxf(pmax, p1[r]);
    { auto rr = __builtin_amdgcn_permlane32_swap(__float_as_uint(pmax), __float_as_uint(pmax), false, false); pmax = fmaxf(__uint_as_float(rr[0]), __uint_as_float(rr[1])); }
    const float mn = fmaxf(m_reg, pmax), alpha = __builtin_amdgcn_exp2f((m_reg - mn) * C), mnC = -mn * C; m_reg = mn;
    float ps = 0.f;
#pragma unroll
    for (int r = 0; r < 16; ++r) { p0[r] = __builtin_amdgcn_exp2f(fmaf(p0[r], C, mnC)); ps += p0[r]; }
#pragma unroll
    for (int r = 0; r < 16; ++r) { p1[r] = __builtin_amdgcn_exp2f(fmaf(p1[r], C, mnC)); ps += p1[r]; }
    { auto rr = __builtin_amdgcn_permlane32_swap(__float_as_uint(ps), __float_as_uint(ps), false, false); ps = __uint_as_float(rr[0]) + __uint_as_float(rr[1]); }
    l_reg = l_reg * alpha + ps;
    if (__any(alpha < 1.f)) { if (hi == 0) al[r32] = alpha; asm volatile("s_waitcnt lgkmcnt(0)" ::: "memory");
#pragma unroll
        for (int d = 0; d < 4; ++d)
#pragma unroll
            for (int r = 0; r < 16; ++r) o[d][r] *= al[crow(r, hi)];
    }
    bf16x8 pa0, pa1, pa2, pa3;
#define PK4(P, BASE, OUT) do { unsigned a0 = cvtpk(P[BASE + 0], P[BASE + 1]), a1 = cvtpk(P[BASE + 2], P[BASE + 3]);   \
    unsigned b0 = cvtpk(P[BASE + 4], P[BASE + 5]), b1 = cvtpk(P[BASE + 6], P[BASE + 7]);                              \
    auto r0 = __builtin_amdgcn_permlane32_swap(a0, b0, false, false); auto r1 = __builtin_amdgcn_permlane32_swap(a1, b1, false, false); \
    v4u w = {r0[0], r1[0], r0[1], r1[1]}; OUT = __builtin_bit_cast(bf16x8, w); } while (0)
    PK4(p0, 0, pa0); PK4(p0, 8, pa1); PK4(p1, 0, pa2); PK4(p1, 8, pa3);
#undef PK4
    SBAR();
    pv_one<0>(o[0], vb, pa0, pa1, pa2, pa3); pv_one<1>(o[1], vb, pa0, pa1, pa2, pa3); pv_one<2>(o[2], vb, pa0, pa1, pa2, pa3); pv_one<3>(o[3], vb, pa0, pa1, pa2, pa3);
}
#define ATTN_STORE_O(ROWPTR_EXPR) do { if (hi == 0) al[r32] = l_reg; asm volatile("s_waitcnt lgkmcnt(0)" ::: "memory"); \
    _Pragma("unroll") for (int r = 0; r < 16; ++r) { const int qi = crow(r, hi); const float rl = __builtin_amdgcn_rcpf(al[qi]); bf16* op = (ROWPTR_EXPR); \
        _Pragma("unroll") for (int d0 = 0; d0 < 4; ++d0) op[d0 * 32 + r32] = (bf16)f2bf(o[d0][r] * rl); } } while (0)

constexpr int MLA_KB = 24576, MLA_VB = 16384, MLA_BUF = MLA_KB + MLA_VB;
__device__ __forceinline__ void mla_stage(const bf16* KV, const bf16* KR, int krow0, int head, LAS unsigned char* buf, int tid, int wave) {
#pragma unroll
    for (int i = 0; i < 3; ++i) { const int P = (i * 512 + tid) * 16, row = P / 384, cb = (P % 384) ^ ((row & 7) << 4);
        const bf16* src = cb < 256 ? KV + (size_t)(krow0 + row) * KVC + head * 256 + (cb >> 1) : KR + (size_t)(krow0 + row) * 64 + ((cb - 256) >> 1);
        glds16(src, buf + (i * 512 + wave * 64) * 16); }
#pragma unroll
    for (int i = 0; i < 2; ++i) { const int P = (i * 512 + tid) * 16; int k, c; v_inv(P, k, c);
        glds16(KV + (size_t)(krow0 + k) * KVC + head * 256 + 128 + c, buf + MLA_KB + (i * 512 + wave * 64) * 16); }
}
__device__ __forceinline__ void mla_unit(bf16* Q, const bf16* KV, const bf16* KR, int row0  , int L, int head, int qb, LAS unsigned char* lds, int tid, int lane, int wave) {
    const int r32 = lane & 31, hi = lane >> 5; constexpr float C = 0.07216878364870322f * 1.4426950408889634f;
    LAS float* al = (LAS float*)(lds + WSCR_OFF + wave * 128);
    const int qrow = row0 + qb * 256 + wave * 32 + r32;
    bf16x8 qr[12];
#pragma unroll
    for (int d0 = 0; d0 < 8; ++d0) qr[d0] = *(const GAS bf16x8*)(Q + (size_t)qrow * QC + head * 128 + d0 * 16 + hi * 8);
#pragma unroll
    for (int d0 = 0; d0 < 4; ++d0) qr[8 + d0] = *(const GAS bf16x8*)(Q + (size_t)qrow * QC + 1536 + head * 64 + d0 * 16 + hi * 8);
    float m_reg = -1e30f, l_reg = 0.f; f32x16 o[4];
#pragma unroll
    for (int d = 0; d < 4; ++d) o[d] = (f32x16){0.f, 0.f, 0.f, 0.f, 0.f, 0.f, 0.f, 0.f, 0.f, 0.f, 0.f, 0.f, 0.f, 0.f, 0.f, 0.f};
    const int NT = L / 64;
    __syncthreads();
    mla_stage(KV, KR, row0, head, lds, tid, wave);
#pragma unroll 1
    for (int j = 0; j < NT; ++j) {
        LAS unsigned char* cur = lds + (j & 1) * MLA_BUF;
        asm volatile("s_waitcnt vmcnt(0)" ::: "memory"); __syncthreads();
        if (j + 1 < NT) mla_stage(KV, KR, row0 + (j + 1) * 64, head, lds + ((j + 1) & 1) * MLA_BUF, tid, wave);
        f32x16 p0 = (f32x16){0.f, 0.f, 0.f, 0.f, 0.f, 0.f, 0.f, 0.f, 0.f, 0.f, 0.f, 0.f, 0.f, 0.f, 0.f, 0.f}, p1 = p0;
#pragma unroll
        for (int d0 = 0; d0 < 12; ++d0) { const int cb = d0 * 32 + hi * 16;
            const bf16x8 b0 = *(const LAS bf16x8*)(cur + r32 * 384 + (cb ^ ((r32 & 7) << 4)));
            const bf16x8 b1 = *(const LAS bf16x8*)(cur + (32 + r32) * 384 + (cb ^ ((r32 & 7) << 4)));
            p0 = __builtin_amdgcn_mfma_f32_32x32x16_bf16(b0, qr[d0], p0, 0, 0, 0);
            p1 = __builtin_amdgcn_mfma_f32_32x32x16_bf16(b1, qr[d0], p1, 0, 0, 0); }
        softmax_pv(p0, p1, m_reg, l_reg, o, (int)(unsigned)(uintptr_t)(cur + MLA_KB) + v_rd_base(lane), al, C, r32, hi);
    }
    ATTN_STORE_O(Q + (size_t)(row0 + qb * 256 + wave * 32 + qi) * QC + head * 128);
}
__device__ __forceinline__ void mla_phase(bf16* Q, const bf16* KV, const bf16* KR, LAS unsigned char* lds, int tid, int lane, int wave, int bid, int G) {
    const bool bal = (G == 256);
    const int nS = bal ? (bid < 128 ? 2 : 1) : (bid < 384 ? (384 - bid + G - 1) / G : 0), nP = bal ? (bid < 128 ? 1 : 5) : (bid < 768 ? (768 - bid + G - 1) / G : 0);
#pragma unroll 1
    for (int i = 0; i < nS + nP; ++i) {
        int row0, L, head, qb;
        if (i < nS) { const int u = bal ? (bid < 128 ? 2 * bid + i : 128 + bid) : bid + i * G; row0 = TP; L = 8192; head = u / 32; qb = u % 32; }
        else { const int k = i - nS, u = bal ? (bid < 128 ? bid : 128 + 5 * (bid - 128) + k) : bid + k * G; row0 = (u / 96) * 2048; L = 2048; head = (u % 96) / 8; qb = u % 8; }
        mla_unit(Q, KV, KR, row0, L, head, qb, lds, tid, lane, wave);
    }
}
__device__ __forceinline__ void dil_unit(bf16* Z, float* DLSE, int wu, LAS unsigned char* lds, int tid, int lane, int wave) {
    const int r32 = lane & 31, hi = lane >> 5, sub = wave >> 1, tl = tid & 127; constexpr float C = 0.08838834764831845f * 1.4426950408889634f;
    const int hd = wu % 12, quad = wu / 12, gb = quad * 4 + sub, grp = hd >> 2, dil = grp == 0 ? 1 : (grp == 1 ? 4 : 16);
    const int row0 = gb < 256 ? (gb >> 5) * 2048 : TP, L = gb < 256 ? 2048 : 8192, bi = gb < 256 ? (gb & 31) : gb - 256;
    const int res = bi % dil, blk = bi / dil, nblk = L / 64 / dil;
    LAS unsigned char* kb = lds + sub * 32768; LAS unsigned char* vbuf = kb + 16384;
    LAS float* al = (LAS float*)(lds + WSCR_OFF + wave * 128);
    const int qi_l = 32 * (wave & 1) + r32; const size_t qrow = (size_t)(row0 + (blk * 64 + qi_l) * dil + res);
    bf16x8 qr[8];
#pragma unroll
    for (int d0 = 0; d0 < 8; ++d0) qr[d0] = *(const GAS bf16x8*)(Z + qrow * ZC + Z_DQ + hd * 128 + d0 * 16 + hi * 8);
    float m_reg = -1e30f, l_reg = 0.f; f32x16 o[4];
#pragma unroll
    for (int d = 0; d < 4; ++d) o[d] = (f32x16){0.f, 0.f, 0.f, 0.f, 0.f, 0.f, 0.f, 0.f, 0.f, 0.f, 0.f, 0.f, 0.f, 0.f, 0.f, 0.f};
#pragma unroll 1
    for (int ti = 0; ti < 3; ++ti) {
        const int dt = ti == 0 ? 0 : (ti == 1 ? -1 : 1); const int kblk = blk + dt; const bool tvalid = kblk >= 0 && kblk < nblk; const int kbc = tvalid ? kblk : blk;
        __syncthreads();
#pragma unroll
        for (int i = 0; i < 8; ++i) { const int P = (i * 128 + tl) * 16, row = P >> 8, cb = (P & 255) ^ ((row & 7) << 4);
            glds16(Z + (size_t)(row0 + (kbc * 64 + row) * dil + res) * ZC + Z_DK + hd * 128 + (cb >> 1), kb + (i * 128 + (wave & 1) * 64) * 16); }
#pragma unroll
        for (int i = 0; i < 8; ++i) { const int P = (i * 128 + tl) * 16; int k, c; v_inv(P, k, c);
            glds16(Z + (size_t)(row0 + (kbc * 64 + k) * dil + res) * ZC + Z_DV + hd * 128 + c, vbuf + (i * 128 + (wave & 1) * 64) * 16); }
        asm volatile("s_waitcnt vmcnt(0)" ::: "memory"); __syncthreads();
        f32x16 p0 = (f32x16){0.f, 0.f, 0.f, 0.f, 0.f, 0.f, 0.f, 0.f, 0.f, 0.f, 0.f, 0.f, 0.f, 0.f, 0.f, 0.f}, p1 = p0;
#pragma unroll
        for (int d0 = 0; d0 < 8; ++d0) { const int cb = d0 * 32 + hi * 16;
            const bf16x8 b0 = *(const LAS bf16x8*)(kb + r32 * 256 + (cb ^ ((r32 & 7) << 4)));
            const bf16x8 b1 = *(const LAS bf16x8*)(kb + (32 + r32) * 256 + (cb ^ ((r32 & 7) << 4)));
            p0 = __builtin_amdgcn_mfma_f32_32x32x16_bf16(b0, qr[d0], p0, 0, 0, 0);
            p1 = __builtin_amdgcn_mfma_f32_32x32x16_bf16(b1, qr[d0], p1, 0, 0, 0); }
        if (ti != 0) {
#pragma unroll
            for (int r = 0; r < 16; ++r) { const int k0 = crow(r, hi), k1 = 32 + k0;
                const bool v0 = tvalid && (dt < 0 ? k0 >= qi_l : k0 <= qi_l), v1 = tvalid && (dt < 0 ? k1 >= qi_l : k1 <= qi_l);
                p0[r] = v0 ? p0[r] : -1e30f; p1[r] = v1 ? p1[r] : -1e30f; }
        }
        softmax_pv(p0, p1, m_reg, l_reg, o, (int)(unsigned)(uintptr_t)vbuf + v_rd_base(lane), al, C, r32, hi);
    }
    if (hi == 0) DLSE[(qrow) * 12 + hd] = m_reg * 0.08838834764831845f + logf(l_reg);
    __syncthreads();
    ATTN_STORE_O(Z + (size_t)(row0 + (blk * 64 + 32 * (wave & 1) + qi) * dil + res) * ZC + Z_DQ + hd * 128);
}
__device__ __forceinline__ void mixnorm_unit(int tb, const bf16* YT, const bf16* Q, const bf16* Z, const float* DLSE, const float* gout, bf16* MX, LAS unsigned char* lds, int tid, int lane, int wave) {
    LAS float* ssq = (LAS float*)(lds);
    LAS float* rstd = (LAS float*)(lds + 2048);
    LAS bf16* tile = (LAS bf16*)(lds + 4096);
    const int c = tid >> 3, t8 = (tid & 7) * 8, m0 = tb * 64;
    __syncthreads();
    float ps[8];
#pragma unroll
    for (int e = 0; e < 8; ++e) ps[e] = 0.f;
    for (int ck = 0; ck < 16; ++ck) { float x[8]; unpack8(*(const GAS v4u*)(YT + (size_t)(ck * 64 + c) * TT + m0 + t8), x);
#pragma unroll
        for (int e = 0; e < 8; ++e) ps[e] += x[e] * x[e]; }
#pragma unroll
    for (int e = 0; e < 8; ++e) { ps[e] += __shfl_xor(ps[e], 8); ps[e] += __shfl_xor(ps[e], 16); ps[e] += __shfl_xor(ps[e], 32); }
    if (lane < 8) {
#pragma unroll
        for (int e = 0; e < 8; ++e) ssq[wave * 64 + lane * 8 + e] = ps[e]; }
    __syncthreads();
    if (tid < 64) { float s = 0.f;
#pragma unroll
        for (int w = 0; w < 8; ++w) s += ssq[w * 64 + tid];
        rstd[tid] = 1.0f / sqrtf(s * (1.0f / 1024.0f) + EPS); }
    __syncthreads();
    for (int ck = 0; ck < 16; ++ck) {
        float x[8]; unpack8(*(const GAS v4u*)(YT + (size_t)(ck * 64 + c) * TT + m0 + t8), x); const float gg = gout[ck * 64 + c];
#pragma unroll
        for (int e = 0; e < 8; ++e) tile[c * 66 + t8 + e] = (bf16)f2bf(x[e] * rstd[t8 + e] * gg);
        __syncthreads();
        { const int t = tid >> 3, c8 = (tid & 7) * 8; v4u w;
          w.x = (unsigned)tile[(c8 + 0) * 66 + t] | ((unsigned)tile[(c8 + 1) * 66 + t] << 16); w.y = (unsigned)tile[(c8 + 2) * 66 + t] | ((unsigned)tile[(c8 + 3) * 66 + t] << 16);
          w.z = (unsigned)tile[(c8 + 4) * 66 + t] | ((unsigned)tile[(c8 + 5) * 66 + t] << 16); w.w = (unsigned)tile[(c8 + 6) * 66 + t] | ((unsigned)tile[(c8 + 7) * 66 + t] << 16);
          *(GAS v4u*)(MX + (size_t)(m0 + t) * DM + ck * 64 + c8) = w; }
        __syncthreads();
    }
#pragma unroll 1
    for (int k = 0; k < 8; ++k) {
        const int m = m0 + wave * 8 + k;
        {   float x[3][8]; float s = 0.f;
#pragma unroll
            for (int j = 0; j < 3; ++j) { unpack8(*(const GAS v4u*)(Q + (size_t)m * QC + lane * 8 + 512 * j), x[j]);
#pragma unroll
                for (int e = 0; e < 8; ++e) s += x[j][e] * x[j][e]; }
            const float rs = 1.0f / sqrtf(wave_sum(s) * (1.0f / 1536.0f) + EPS);
#pragma unroll
            for (int j = 0; j < 3; ++j) { const int cc = lane * 8 + 512 * j; float y[8];
#pragma unroll
                for (int e = 0; e < 8; ++e) y[e] = x[j][e] * rs * gout[1024 + cc + e];
                *(GAS v4u*)(MX + (size_t)m * DM + 1024 + cc) = pack8(y); }
        }
        {   float x[3][8]; float s = 0.f;
#pragma unroll
            for (int j = 0; j < 3; ++j) { const int cc = lane * 8 + 512 * j, hd = cc >> 7, slot = hd & 3;
                const float l0 = DLSE[(size_t)m * 12 + slot], l1 = DLSE[(size_t)m * 12 + 4 + slot], l2 = DLSE[(size_t)m * 12 + 8 + slot], lm = fmaxf(l0, fmaxf(l1, l2));
                const float e0 = expf(l0 - lm), e1 = expf(l1 - lm), e2 = expf(l2 - lm), mine = (hd >> 2) == 0 ? e0 : ((hd >> 2) == 1 ? e1 : e2), alpha = mine / (e0 + e1 + e2);
                unpack8(*(const GAS v4u*)(Z + (size_t)m * ZC + Z_DQ + cc), x[j]);
#pragma unroll
                for (int e = 0; e < 8; ++e) { x[j][e] *= alpha; s += x[j][e] * x[j][e]; } }
            const float rs = 1.0f / sqrtf(wave_sum(s) * (1.0f / 1536.0f) + EPS);
#pragma unroll
            for (int j = 0; j < 3; ++j) { const int cc = lane * 8 + 512 * j; float y[8];
#pragma unroll
                for (int e = 0; e < 8; ++e) y[e] = x[j][e] * rs * gout[2560 + cc + e];
                *(GAS v4u*)(MX + (size_t)m * DM + 2560 + cc) = pack8(y); }
        }
    }
}
#ifndef MK_N_LAUNCHES
#define MK_N_LAUNCHES 1
#endif
struct Args { const float* in[31]; float* out; unsigned char* ws; int ph_lo, ph_hi, li, pad; };
__global__ void __launch_bounds__(NWAVES * 64, 2) fwd(Args args) {
    extern __shared__ __attribute__((aligned(16))) unsigned char lds_raw[];
    LAS unsigned char* lds = (LAS unsigned char*)lds_raw;
    const int tid = threadIdx.x, lane = tid & 63, wave = __builtin_amdgcn_readfirstlane(tid >> 6), G = gridDim.x, bid = blockIdx.x;
    const int NGW = G * NWAVES, NGT = G * NWAVES * 64;
    for (int u = tid; u < (PTAB_OFF - LDSCTL_OFF) / 4; u += NWAVES * 64) ((LAS unsigned*)(lds + LDSCTL_OFF))[u] = 0u;
    __syncthreads();
    const int lo = args.ph_lo, hi = args.ph_hi;
    XcdBarrier bar; bar.bar = (unsigned*)(args.ws + WS_CTL) + CW_BAR; bar.x = 0; bar.st = nullptr;
    if (hi - lo > 1) bar = xcd_barrier_post((unsigned*)(args.ws + WS_CTL) + CW_BAR, (volatile LAS unsigned*)(lds + MISC_OFF) + 8);
#ifndef ONLY_REL
#define ONLY_REL -1
#endif
#ifndef EN_MASK
#define EN_MASK 0x3fff
#endif
#define EN(j) (((EN_MASK) >> (j)) & 1)
#define IN(k) (lo <= (k) && (k) < hi)
#define OPQ() int tid_ = tid, wave_ = wave; asm volatile("" : "+v"(tid_), "+s"(wave_)); tid_ &= 511; wave_ &= 7; const InTab in_{args.in}; unsigned char* const ws_ = args.ws; float* const out_ = args.out; (void)ws_; (void)out_; const int lane_ = tid_ & 63, gw_ = bid * NWAVES + wave_, gt_ = bid * (NWAVES * 64) + tid_; (void)lane_; (void)gw_; (void)gt_
#define SEAM(k) do { if (IN(k) && IN((k) + 1)) xcd_barrier(bar); } while (0)
#define P_H ((bf16*)(ws_ + WS_H))
#define P_Z ((bf16*)(ws_ + WS_Z))
#define P_Q ((bf16*)(ws_ + WS_Q))
#define P_KV ((bf16*)(ws_ + WS_KV))
#define P_UT ((bf16*)(ws_ + WS_UT))
#define P_A2 ((bf16*)(ws_ + WS_A2))
#define P_CQ ((bf16*)(ws_ + WS_CQ))
#define P_CKV ((bf16*)(ws_ + WS_CKV))
#define P_KR ((bf16*)(ws_ + WS_KR))
#define P_X0T ((bf16*)(ws_ + WS_X0T))
#define P_YT ((bf16*)(ws_ + WS_YT))
#define P_DLSE ((float*)(ws_ + WS_DLSE))
#define P_XP (in_[0])
#define P_XS (in_[1] - (size_t)TP * DM)
#define P_WL (ws_ + WS_WT + (size_t)l * WT_LAYER)

    if (EN(13) && IN(0)) {
        OPQ();
        for (int it = bid; it < NLAYER * 160; it += G) { const int layer = it / 160, r = it % 160; filter_item(in_, ws_, layer, r >= 32 ? 1 : 0, r >= 32 ? r - 32 : r, lds, tid_, lane_, wave_); }
        p0_weights(in_, ws_, (LAS float*)(lds + wave_ * 16384), gw_, NGW, lane_);
        p0_misc(ws_, gt_, NGT);
        rms_rows(P_XP, P_XS, in_[2], P_H, gw_, NGW, lane_);
    }
    SEAM(0);
#pragma unroll 1
    for (int l = 0; l < NLAYER; ++l) {
        const int pb = 1 + l * NPH_LAYER;
        if (EN(0) && IN(pb + 0)) {
            OPQ(); pg8::Gemm g{P_H, (const bf16*)(P_WL + WT_IN), TT, ZC, DM}; pg8::StaticOrder S; S.init(TT, ZC, G, bid); pg8::EpiBf16<0> E{P_Z, ZC};
            pg8::gemm_phase<pg8::EpiBf16<0>, pg8::StaticOrder, true, true>(lds, g, S, E);
        }
        SEAM(pb + 0);
        if (EN(1) && IN(pb + 1)) {
            OPQ();
            prep_hyena(P_Z, in_[4] + (size_t)l * 3 * 3072, in_[5] + (size_t)l * 3072, P_UT, P_X0T, lds, tid_, bid, G);
            prep_tokens(P_Z, in_, l, ws_, gw_, NGW, lane_);
        }
        SEAM(pb + 1);
        if (EN(2) && IN(pb + 2)) {
            { OPQ(); pg8::Gemm g{P_CQ, (const bf16*)(P_WL + WT_QB), TT, QC, 1536}; pg8::StaticOrder S; S.init(TT, QC, G, bid); pg8::EpiBf16<0> E{P_Q, QC};
              pg8::gemm_phase<pg8::EpiBf16<0>, pg8::StaticOrder, true, true>(lds, g, S, E); }
            { OPQ(); pg8::Gemm g{P_CKV, (const bf16*)(P_WL + WT_KVB), TT, KVC, 512}; pg8::StaticOrder S; S.init(TT, KVC, G, bid); pg8::EpiBf16<0> E{P_KV, KVC};
              pg8::gemm_phase<pg8::EpiBf16<0>, pg8::StaticOrder, true, true>(lds, g, S, E); }
        }
        SEAM(pb + 2);
        if (EN(3) && IN(pb + 3)) { OPQ(); mla_post(P_Q, P_KV, in_, l, ws_, gw_, NGW, lane_); }
        SEAM(pb + 3);
        if (EN(4) && IN(pb + 4)) {
            OPQ(); const unsigned char* fl = ws_ + WS_FILT + (size_t)l * FILT_LAYER;
            for (int u = bid; u < 2048; u += G) {
                const int c = u & 1023; const float skip = in_[15][l * 1024 + c];
                if (u < 1024) conv_unit<0>(c, (const bf16*)fl + (size_t)c * 4096, P_UT, P_X0T, P_YT, skip, lds, tid_, lane_, wave_);
                else conv_unit<1>(c, (const bf16*)(fl + FILT_S_OFF) + (size_t)c * 16384, P_UT, P_X0T, P_YT, skip, lds, tid_, lane_, wave_);
            }
        }
        SEAM(pb + 4);
        if (EN(5) && IN(pb + 5)) { OPQ(); mla_phase(P_Q, P_KV, P_KR, lds, tid_, lane_, wave_, bid, G); }
        SEAM(pb + 5);
        if (EN(6) && IN(pb + 6)) { OPQ(); for (int wu = bid; wu < 1152; wu += G) dil_unit(P_Z, P_DLSE, wu, lds, tid_, lane_, wave_); }
        SEAM(pb + 6);
        if (EN(7) && IN(pb + 7)) { OPQ(); for (int tb = bid; tb < 384; tb += G) mixnorm_unit(tb, P_YT, P_Q, P_Z, P_DLSE, in_[26] + (size_t)l * DM, P_H, lds, tid_, lane_, wave_); }
        SEAM(pb + 7);
        if (EN(8) && IN(pb + 8)) {
            OPQ(); pg8::Gemm g{P_H, (const bf16*)(P_WL + WT_OUT), TT, DM, DM}; pg8::StaticOrder S; S.init(TT, DM, G, bid);
            pg8::EpiRes E{l == 0 ? P_XP : out_, l == 0 ? P_XS : out_, out_, 64};
            pg8::gemm_phase<pg8::EpiRes, pg8::StaticOrder, true, true>(lds, g, S, E);
        }
        SEAM(pb + 8);
        if (EN(9) && IN(pb + 9)) { OPQ(); rms_rows(out_, out_, in_[28] + (size_t)l * DM, P_H, gw_, NGW, lane_); }
        SEAM(pb + 9);
        if (EN(10) && IN(pb + 10)) {
            OPQ(); pg8::Gemm g{P_H, (const bf16*)(P_WL + WT_UP), TT, DFF, DM}; pg8::StaticOrder S; S.init(TT, DFF, G, bid); pg8::EpiBf16<1> E{P_A2, DFF};
            pg8::gemm_phase<pg8::EpiBf16<1>, pg8::StaticOrder, true, true>(lds, g, S, E);
        }
        SEAM(pb + 10);
        if (EN(11) && IN(pb + 11)) {
            OPQ(); pg8::Gemm g{P_A2, (const bf16*)(P_WL + WT_DN), TT, DM, DFF}; pg8::StaticOrder S; S.init(TT, DM, G, bid); pg8::EpiRes E{out_, out_, out_, 64};
            pg8::gemm_phase<pg8::EpiRes, pg8::StaticOrder, true, true>(lds, g, S, E);
        }
        SEAM(pb + 11);
        if (EN(12) && IN(pb + 12) && l + 1 < NLAYER) { OPQ(); rms_rows(out_, out_, in_[2] + (size_t)(l + 1) * DM, P_H, gw_, NGW, lane_); }
        SEAM(pb + 12);
    }
#undef IN
#undef SEAM
}

extern "C" void kernel_launch(void* const* d_in, const int* in_sizes, int n_in, void* d_out, int out_size, void* d_ws, size_t ws_size, hipStream_t stream) {
    static int grid = 0;
    if (grid == 0) {
        if (n_in != 31 || in_sizes[0] != TP * DM || in_sizes[1] != TS * DM || out_size != TT * DM || ws_size < WS_END) {
            fprintf(stderr, "kernel_launch: shape mismatch: n_in %d in0 %d in1 %d out %d ws %zu (need >= %zu); nothing launched\n", n_in, n_in > 0 ? in_sizes[0] : -1, n_in > 1 ? in_sizes[1] : -1, out_size, ws_size, (size_t)WS_END); grid = -1; return; }
        int dev = 0, cus = 0, per_cu = 0;
        if (hipGetDevice(&dev) != hipSuccess || hipDeviceGetAttribute(&cus, hipDeviceAttributeMultiprocessorCount, dev) != hipSuccess) { fprintf(stderr, "kernel_launch: device query failed\n"); grid = -1; return; }
        if (hipFuncSetAttribute((const void*)fwd, hipFuncAttributeMaxDynamicSharedMemorySize, LDS_BYTES) != hipSuccess) { fprintf(stderr, "kernel_launch: hipFuncSetAttribute failed\n"); grid = -1; return; }
        if (hipOccupancyMaxActiveBlocksPerMultiprocessor(&per_cu, (const void*)fwd, NWAVES * 64, LDS_BYTES) != hipSuccess || per_cu < 1) fprintf(stderr, "kernel_launch: occupancy query says %d\n", per_cu);
        (void)hipGetLastError();
        grid = cus;
    }
    if (grid < 0) return;
    if (hipMemsetAsync((char*)d_ws + WS_CTL, 0, CTL_ZERO_BYTES, stream) != hipSuccess) { fprintf(stderr, "kernel_launch: memset failed\n"); return; }
    Args a{};
    for (int i = 0; i < 31; ++i) a.in[i] = (const float*)d_in[i];
    a.out = (float*)d_out; a.ws = (unsigned char*)d_ws;
    if (MK_N_LAUNCHES == 1) { a.ph_lo = 0; a.ph_hi = NPHASES; a.li = 0; hipLaunchKernelGGL(fwd, dim3(grid), dim3(NWAVES * 64), LDS_BYTES, stream, a); }
    else for (int p = 0; p < NPHASES - 1; ++p) { a.ph_lo = p; a.ph_hi = p + 1; a.li = p; hipLaunchKernelGGL(fwd, dim3(grid), dim3(NWAVES * 64), LDS_BYTES, stream, a); }
    const hipError_t le = hipPeekAtLastError();
    if (le != hipSuccess) fprintf(stderr, "kernel_launch: launch failed: %s\n", hipGetErrorName(le));
}
```

```cpp
#include <hip/hip_runtime.h>
#include <cstdio>
#include <cstdint>
#define MK_N_LAUNCHES 1
namespace pg8 {
#define PG8_LAS __attribute__((address_space(3)))
typedef unsigned short bf16_t;
typedef short bf16x8 __attribute__((ext_vector_type(8)));
typedef float f32x4 __attribute__((ext_vector_type(4)));
typedef unsigned u32x4 __attribute__((ext_vector_type(4)));
constexpr int BM = 256, BK = 64, HALF = 128, HTB = HALF * BK * 2  , STAGE_BYTES = 8 * HTB, NXCD = 8, WGM = 8;

__host__ __device__ __forceinline__ int lds_byte(int r, int c) { const int st = (r >> 4) * 2 + (c >> 5), rr = r & 15, cc = c & 31, ob = rr * 64 + cc * 2; return st * 1024 + (ob ^ (((ob >> 9) & 1) << 5)); }
__host__ __device__ __forceinline__ void stage_rc(int b, int& R, int& C) { const int st = b / 1024, sb = b % 1024, swz = sb ^ (((sb >> 9) & 1) << 5); R = (st >> 1) * 16 + swz / 64; C = (st & 1) * 32 + (swz % 64) / 2; }
__host__ __device__ __forceinline__ int perm32(int rho) { const int n = rho >> 4, i = rho & 15; return 8 * (i >> 2) + 4 * n + (i & 3); }

struct Unit { int pm, pn; };
struct Gemm { const bf16_t* A; const bf16_t* Bt; int M, N, K; };

struct StaticOrder {
    int nM, nN, nwg, G, c;
    __host__ __device__ void init(int M, int N, int G_, int c_) { nM = M / BM; nN = N / BM; nwg = nM * nN; G = G_; c = c_; }
    __host__ __device__ bool next(int i, Unit& u) const {
        const long L = (long)i * G + c; if (L >= nwg) return false;
        int wgid = (int)L; { const int q = nwg / NXCD, r = nwg % NXCD, xcd = wgid % NXCD, off = wgid / NXCD; wgid = (xcd < r ? xcd * (q + 1) : r * (q + 1) + (xcd - r) * q) + off; }
        const int nig = WGM * nN, gid = wgid / nig, fm = gid * WGM, gsz = (nM - fm) < WGM ? (nM - fm) : WGM;
        u.pm = fm + ((wgid % nig) % gsz); u.pn = (wgid % nig) / gsz; return true;
    }
    __device__ __forceinline__ void a_ready(const Unit&) const {}
    __device__ __forceinline__ void done(const Unit&) const {}
};

__device__ __forceinline__ unsigned cvt_pk_bf16(float lo, float hi) { unsigned r; asm volatile("v_cvt_pk_bf16_f32 %0, %1, %2" : "=v"(r) : "v"(lo), "v"(hi)); return r; }
typedef float f32x2 __attribute__((ext_vector_type(2)));
#ifndef EPI_NT
#define EPI_NT 0
#endif
template <int ACT  > struct EpiBf16 {
    static constexpr bool PERM = true, AFTER_DRAIN = false;
    bf16_t* O; int ldc; const float* ssq;
    __device__ __forceinline__ void operator()(const f32x4 (&acc)[2][2][4][2], const Unit& u, int wr, int wc, int fr, int fq) const {
        const int row0 = u.pm * BM + wr * 64 + fr, col0 = u.pn * BM + wc * 32 + 8 * fq;
        float rs[2][4];
#pragma unroll
        for (int ai = 0; ai < 2; ++ai)
#pragma unroll
            for (int m = 0; m < 4; ++m) rs[ai][m] = ssq ? ssq[row0 + ai * HALF + m * 16] : 1.0f;
#pragma unroll
        for (int ai = 0; ai < 2; ++ai)
#pragma unroll
            for (int m = 0; m < 4; ++m) { bf16_t* rowp = O + (size_t)(row0 + ai * HALF + m * 16) * ldc + col0;
#pragma unroll
                for (int bj = 0; bj < 2; ++bj) { f32x4 v0 = acc[ai][bj][m][0] * rs[ai][m], v1 = acc[ai][bj][m][1] * rs[ai][m];
                    if (ACT == 1) {
#pragma unroll
                        for (int j = 0; j < 4; ++j) { const float a = fmaxf(v0[j], 0.f), b = fmaxf(v1[j], 0.f); v0[j] = a * a; v1[j] = b * b; } }
                    u32x4 w; w.x = cvt_pk_bf16(v0[0], v0[1]); w.y = cvt_pk_bf16(v0[2], v0[3]); w.z = cvt_pk_bf16(v1[0], v1[1]); w.w = cvt_pk_bf16(v1[2], v1[3]);
                    if (EPI_NT) __builtin_nontemporal_store(w, (u32x4*)(rowp + bj * HALF)); else *(u32x4*)(rowp + bj * HALF) = w; } }
    }
};
template <int ACT> struct EpiBf16L {
    static constexpr bool PERM = true, AFTER_DRAIN = false;
    bf16_t* O; int ldc; const PG8_LAS float* tab;
    __device__ __forceinline__ void operator()(const f32x4 (&acc)[2][2][4][2], const Unit& u, int wr, int wc, int fr, int fq) const {
        const int row0 = u.pm * BM + wr * 64 + fr, col0 = u.pn * BM + wc * 32 + 8 * fq;
        const int pm0 = ((const PG8_LAS int*)tab)[768], pm1 = ((const PG8_LAS int*)tab)[769];
        const PG8_LAS float* tp = tab + (u.pm == pm0 ? 0 : (u.pm == pm1 ? 256 : 512)) + wr * 64 + fr;
        float rs[2][4];
#pragma unroll
        for (int ai = 0; ai < 2; ++ai)
#pragma unroll
            for (int m = 0; m < 4; ++m) rs[ai][m] = tp[ai * HALF + m * 16];
#pragma unroll
        for (int ai = 0; ai < 2; ++ai)
#pragma unroll
            for (int m = 0; m < 4; ++m) { bf16_t* rowp = O + (size_t)(row0 + ai * HALF + m * 16) * ldc + col0;
#pragma unroll
                for (int bj = 0; bj < 2; ++bj) { f32x4 v0 = acc[ai][bj][m][0] * rs[ai][m], v1 = acc[ai][bj][m][1] * rs[ai][m];
                    if (ACT == 1) {
#pragma unroll
                        for (int j = 0; j < 4; ++j) { const float a = fmaxf(v0[j], 0.f), b = fmaxf(v1[j], 0.f); v0[j] = a * a; v1[j] = b * b; } }
                    u32x4 w; w.x = cvt_pk_bf16(v0[0], v0[1]); w.y = cvt_pk_bf16(v0[2], v0[3]); w.z = cvt_pk_bf16(v1[0], v1[1]); w.w = cvt_pk_bf16(v1[2], v1[3]);
                    *(u32x4*)(rowp + bj * HALF) = w; } }
    }
};
template <bool RES32, bool OUT32> struct EpiRes {
    static constexpr bool PERM = false, AFTER_DRAIN = false;
    const float* r0; const float* r1; int pm_split; bf16_t* xb; float* ssq  ; float* out; PG8_LAS float* tab  ;
    __device__ __forceinline__ void operator()(const f32x4 (&acc)[2][2][4][2], const Unit& u, int wr, int wc, int fr, int fq) const {
        typedef unsigned u32x2e __attribute__((ext_vector_type(2)));
        const int row0 = u.pm * BM + wr * 64 + fr, col0 = u.pn * BM + wc * 32 + 4 * fq;
        const float* rb = (u.pm < pm_split) ? r0 : r1;
#pragma unroll
        for (int ai = 0; ai < 2; ++ai)
#pragma unroll
            for (int m = 0; m < 4; ++m) { const size_t off = (size_t)(row0 + ai * HALF + m * 16) * 4096 + col0;
                f32x4 x[2][2];
#pragma unroll
                for (int bj = 0; bj < 2; ++bj)
#pragma unroll
                    for (int n = 0; n < 2; ++n) {
                        if (RES32) x[bj][n] = *(const f32x4*)(rb + off + bj * HALF + n * 16);
                        else { const u32x2e w = *(const u32x2e*)(xb + off + bj * HALF + n * 16); x[bj][n] = (f32x4){__uint_as_float(w.x << 16), __uint_as_float(w.x & 0xffff0000u), __uint_as_float(w.y << 16), __uint_as_float(w.y & 0xffff0000u)}; } }
                float sq = 0.f;
#pragma unroll
                for (int bj = 0; bj < 2; ++bj)
#pragma unroll
                    for (int n = 0; n < 2; ++n) { const f32x4 v = x[bj][n] + acc[ai][bj][m][n];
                        if (OUT32) *(f32x4*)(out + off + bj * HALF + n * 16) = v;
                        else { sq += (v[0] * v[0] + v[1] * v[1]) + (v[2] * v[2] + v[3] * v[3]); u32x2e w; w.x = cvt_pk_bf16(v[0], v[1]); w.y = cvt_pk_bf16(v[2], v[3]); *(u32x2e*)(xb + off + bj * HALF + n * 16) = w; } }
                if (!OUT32) { sq += __shfl_xor(sq, 16); sq += __shfl_xor(sq, 32); if (fq == 0) tab[(ai * HALF + wr * 64 + m * 16 + fr) * 4 + wc] = sq; }
                asm volatile("" ::: "memory"); }
        if (!OUT32) {
            asm volatile("s_waitcnt lgkmcnt(0)" ::: "memory"); __builtin_amdgcn_s_barrier(); asm volatile("" ::: "memory");
            const int t = (wr * 4 + wc) * 64 + fq * 16 + fr;
            if (t < 256) { const f32x4 p = *(const PG8_LAS f32x4*)(tab + t * 4); ssq[(size_t)(u.pm * BM + t) * 16 + u.pn] = (p[0] + p[1]) + (p[2] + p[3]); }
        }
    }
};

struct EpiKv {
    static constexpr bool PERM = true, AFTER_DRAIN = false;
    bf16_t* O; int ldc; const float* gain; PG8_LAS float* tab;
    __device__ __forceinline__ void operator()(const f32x4 (&acc)[2][2][4][2], const Unit& u, int wr, int wc, int fr, int fq) const {
        const int row0 = u.pm * BM + wr * 64 + fr, col0 = u.pn * BM + wc * 32 + 8 * fq;
#pragma unroll
        for (int ai = 0; ai < 2; ++ai)
#pragma unroll
            for (int m = 0; m < 4; ++m) { const f32x4 a = acc[ai][0][m][0], b = acc[ai][0][m][1]; float s = (a[0] * a[0] + a[1] * a[1]) + (a[2] * a[2] + a[3] * a[3]) + (b[0] * b[0] + b[1] * b[1]) + (b[2] * b[2] + b[3] * b[3]);
                s += __shfl_xor(s, 16); s += __shfl_xor(s, 32);
                if (fq == 0) tab[(ai * HALF + wr * 64 + m * 16 + fr) * 4 + wc] = s; }
        asm volatile("s_waitcnt lgkmcnt(0)" ::: "memory"); __builtin_amdgcn_s_barrier(); asm volatile("" ::: "memory");
        const f32x4 g0 = *(const f32x4*)(gain + wc * 32 + 8 * fq), g1 = *(const f32x4*)(gain + wc * 32 + 8 * fq + 4);
#pragma unroll
        for (int ai = 0; ai < 2; ++ai)
#pragma unroll
            for (int m = 0; m < 4; ++m) { bf16_t* rowp = O + (size_t)(row0 + ai * HALF + m * 16) * ldc + col0;
                const f32x4 t = *(const PG8_LAS f32x4*)(tab + (ai * HALF + wr * 64 + m * 16 + fr) * 4); const float rs = 1.0f / sqrtf(((t[0] + t[1]) + (t[2] + t[3])) * (1.0f / 128.0f) + 1e-6f);
                { const f32x4 v0 = acc[ai][0][m][0] * rs * g0, v1 = acc[ai][0][m][1] * rs * g1; u32x4 w; w.x = cvt_pk_bf16(v0[0], v0[1]); w.y = cvt_pk_bf16(v0[2], v0[3]); w.z = cvt_pk_bf16(v1[0], v1[1]); w.w = cvt_pk_bf16(v1[2], v1[3]); *(u32x4*)rowp = w; }
                { const f32x4 v0 = acc[ai][1][m][0], v1 = acc[ai][1][m][1]; u32x4 w; w.x = cvt_pk_bf16(v0[0], v0[1]); w.y = cvt_pk_bf16(v0[2], v0[3]); w.z = cvt_pk_bf16(v1[0], v1[1]); w.w = cvt_pk_bf16(v1[2], v1[3]); *(u32x4*)(rowp + HALF) = w; } }
    }
};

struct EpiInProj {
    static constexpr bool PERM = true, AFTER_DRAIN = false;
    bf16_t* O; int ldc; const float* ssq; const float* gq; const float* gk; const float* rope  ; PG8_LAS float* tab;
    __device__ __forceinline__ void operator()(const f32x4 (&acc)[2][2][4][2], const Unit& u, int wr, int wc, int fr, int fq) const {
        const int row0 = u.pm * BM + wr * 64 + fr, col0 = u.pn * BM + wc * 32 + 8 * fq;
        if (u.pn >= 21 && u.pn < 33) {
#pragma unroll
            for (int ai = 0; ai < 2; ++ai)
#pragma unroll
                for (int m = 0; m < 4; ++m)
#pragma unroll
                    for (int bj = 0; bj < 2; ++bj) { const f32x4 a = acc[ai][bj][m][0], b = acc[ai][bj][m][1]; float s = (a[0] * a[0] + a[1] * a[1]) + (a[2] * a[2] + a[3] * a[3]) + (b[0] * b[0] + b[1] * b[1]) + (b[2] * b[2] + b[3] * b[3]);
                        s += __shfl_xor(s, 16); s += __shfl_xor(s, 32);
                        if (fq == 0) tab[((ai * HALF + wr * 64 + m * 16 + fr) * 2 + bj) * 4 + wc] = s; }
            asm volatile("s_waitcnt lgkmcnt(0)" ::: "memory"); __builtin_amdgcn_s_barrier(); asm volatile("" ::: "memory");
            const float* gg = u.pn < 27 ? gq : gk; const int i0 = 16 * wc + 4 * fq;
            const f32x4 g1 = *(const f32x4*)(gg + i0), g2 = *(const f32x4*)(gg + 64 + i0);
#pragma unroll
            for (int ai = 0; ai < 2; ++ai)
#pragma unroll
                for (int m = 0; m < 4; ++m) { const int row = row0 + ai * HALF + m * 16, pos = row < 16384 ? (row & 2047) : row - 16384; bf16_t* rowp = O + (size_t)row * ldc + col0;
                    const f32x4 cs0 = *(const f32x4*)(rope + (size_t)(pos * 64 + i0) * 2), cs1 = *(const f32x4*)(rope + (size_t)(pos * 64 + i0) * 2 + 4);
#pragma unroll
                    for (int bj = 0; bj < 2; ++bj) { const f32x4 t = *(const PG8_LAS f32x4*)(tab + ((ai * HALF + wr * 64 + m * 16 + fr) * 2 + bj) * 4); const float rs = 1.0f / sqrtf(((t[0] + t[1]) + (t[2] + t[3])) * (1.0f / 128.0f) + 1e-6f);
                        const f32x4 v0 = acc[ai][bj][m][0], v1 = acc[ai][bj][m][1];
                        const float a0 = v0[0] * rs * g1[0], b0 = v0[1] * rs * g2[0], a1 = v0[2] * rs * g1[1], b1 = v0[3] * rs * g2[1], a2 = v1[0] * rs * g1[2], b2 = v1[1] * rs * g2[2], a3 = v1[2] * rs * g1[3], b3 = v1[3] * rs * g2[3];
                        u32x4 w; w.x = cvt_pk_bf16(a0 * cs0[0] - b0 * cs0[1], b0 * cs0[0] + a0 * cs0[1]); w.y = cvt_pk_bf16(a1 * cs0[2] - b1 * cs0[3], b1 * cs0[2] + a1 * cs0[3]);
                        w.z = cvt_pk_bf16(a2 * cs1[0] - b2 * cs1[1], b2 * cs1[0] + a2 * cs1[1]); w.w = cvt_pk_bf16(a3 * cs1[2] - b3 * cs1[3], b3 * cs1[2] + a3 * cs1[3]);
                        *(u32x4*)(rowp + bj * HALF) = w; } }
        } else {
            float rs[2][4];
#pragma unroll
            for (int ai = 0; ai < 2; ++ai)
#pragma unroll
                for (int m = 0; m < 4; ++m) rs[ai][m] = ssq[row0 + ai * HALF + m * 16];
#pragma unroll
            for (int ai = 0; ai < 2; ++ai)
#pragma unroll
                for (int m = 0; m < 4; ++m) { bf16_t* rowp = O + (size_t)(row0 + ai * HALF + m * 16) * ldc + col0;
#pragma unroll
                    for (int bj = 0; bj < 2; ++bj) { const f32x4 v0 = acc[ai][bj][m][0] * rs[ai][m], v1 = acc[ai][bj][m][1] * rs[ai][m];
                        u32x4 w; w.x = cvt_pk_bf16(v0[0], v0[1]); w.y = cvt_pk_bf16(v0[2], v0[3]); w.z = cvt_pk_bf16(v1[0], v1[1]); w.w = cvt_pk_bf16(v1[2], v1[3]);
                        *(u32x4*)(rowp + bj * HALF) = w; } }
        }
    }
};
template <class Epi, class Sched, bool ALIGN_EPI = false, bool SP2 = false>
__device__ __forceinline__ void gemm_phase(PG8_LAS unsigned char* lds, const Gemm g, const Sched& S, const Epi& E) {
    int tid_o = threadIdx.x; asm volatile("" : "+v"(tid_o));
    const int tid = tid_o & 511, wid = __builtin_amdgcn_readfirstlane(tid >> 6), lane = tid & 63, wr = wid >> 2, wc = wid & 3, fr = lane & 15, fq = lane >> 4;
    const int K = g.K, nt = K / BK;
    unsigned voffA[2], voffB[2];
#pragma unroll
    for (int i = 0; i < 2; ++i) { int R, C; stage_rc(tid * 16 + i * 8192, R, C); const int Rb = Epi::PERM ? ((R & ~31) + perm32(R & 31)) : R;
        voffA[i] = (unsigned)(R * K + C) * 2u; voffB[i] = (unsigned)(Rb * K + C) * 2u; }
    const size_t kstep = (size_t)(BK * 2);
    const size_t hstep = (size_t)HALF * K * 2;
    const size_t tstep = 2 * hstep;
    const unsigned ldsw = (unsigned)wid * 1024u;
    const int aoff = lds_byte(wr * 64 + fr, fq * 8), boff = lds_byte(wc * 32 + fr, fq * 8);
#define PG8_SA(b, h) (((b) * 2 + (h)) * HTB)
#define PG8_SB(b, h) ((4 + (b) * 2 + (h)) * HTB)
#define PG8_STAGE(bufoff, gbase, voff) do { _Pragma("unroll") for (int _i = 0; _i < 2; ++_i) \
        __builtin_amdgcn_global_load_lds((const unsigned*)((const char*)(gbase) + (voff)[_i]), (PG8_LAS unsigned*)(lds + (bufoff) + ldsw + _i * 8192), 16, 0, 0); } while (0)
#define PG8_LDA(dst, b, h) do { _Pragma("unroll") for (int m = 0; m < 4; ++m) _Pragma("unroll") for (int k = 0; k < 2; ++k) dst[m][k] = *(const PG8_LAS bf16x8*)(lds + PG8_SA(b, h) + aoff + m * 2048 + k * 1024); } while (0)
#define PG8_LDB(dst, b, h) do { _Pragma("unroll") for (int n = 0; n < 2; ++n) _Pragma("unroll") for (int k = 0; k < 2; ++k) dst[n][k] = *(const PG8_LAS bf16x8*)(lds + PG8_SB(b, h) + boff + n * 2048 + k * 1024); } while (0)
#define PG8_MMA(ai, bj, At, Bt) do { __builtin_amdgcn_s_setprio(1); _Pragma("unroll") for (int m = 0; m < 4; ++m) _Pragma("unroll") for (int n = 0; n < 2; ++n) _Pragma("unroll") for (int k = 0; k < 2; ++k) \
        acc[ai][bj][m][n] = __builtin_amdgcn_mfma_f32_16x16x32_bf16(Bt[n][k], At[m][k], acc[ai][bj][m][n], 0, 0, 0); __builtin_amdgcn_s_setprio(0); } while (0)
#define PG8_WAIT_V(n) asm volatile("s_waitcnt vmcnt(" #n ")" ::: "memory")
#define PG8_WAIT_L(n) asm volatile("s_waitcnt lgkmcnt(" #n ")" ::: "memory")
#define PG8_BAR __builtin_amdgcn_s_barrier()
#define PG8_SCHED __builtin_amdgcn_sched_barrier(0)
    Unit cur, nxt; int ui = 0;
    if (!S.next(0, cur)) return;
    f32x4 acc[2][2][4][2];
#pragma unroll
    for (int a = 0; a < 2; ++a)
#pragma unroll
        for (int b = 0; b < 2; ++b)
#pragma unroll
            for (int m = 0; m < 4; ++m)
#pragma unroll
                for (int n = 0; n < 2; ++n) acc[a][b][m][n] = (f32x4){0.f, 0.f, 0.f, 0.f};
    bf16x8 At[4][2], B0[2][2], B1[2][2];
    const char* cA = (const char*)g.A + (size_t)cur.pm * tstep; const char* cB = (const char*)g.Bt + (size_t)cur.pn * tstep;
    S.a_ready(cur);
    if constexpr (SP2) {
        PG8_STAGE(PG8_SB(0, 0), cB, voffB); PG8_STAGE(PG8_SB(0, 1), cB + hstep, voffB); PG8_STAGE(PG8_SA(0, 0), cA, voffA); PG8_STAGE(PG8_SA(0, 1), cA + hstep, voffA);
        if (wr == 1) PG8_BAR;
        PG8_WAIT_V(2); PG8_BAR;
        PG8_STAGE(PG8_SB(1, 0), cB + kstep, voffB); PG8_STAGE(PG8_SA(1, 0), cA + kstep, voffA); PG8_STAGE(PG8_SB(1, 1), cB + hstep + kstep, voffB);
        PG8_WAIT_V(6); PG8_BAR;
    } else {
        PG8_STAGE(PG8_SB(0, 0), cB, voffB); PG8_STAGE(PG8_SA(0, 0), cA, voffA); PG8_STAGE(PG8_SB(0, 1), cB + hstep, voffB); PG8_STAGE(PG8_SA(0, 1), cA + hstep, voffA);
        if (wr == 1) PG8_BAR;
        PG8_WAIT_V(4); PG8_BAR;
        PG8_STAGE(PG8_SB(1, 0), cB + kstep, voffB); PG8_STAGE(PG8_SA(1, 0), cA + kstep, voffA); PG8_STAGE(PG8_SB(1, 1), cB + hstep + kstep, voffB);
        PG8_WAIT_V(6); PG8_BAR;
    }
    for (;;) {
        const bool has_next = S.next(ui + 1, nxt);
        const char* nA = has_next ? (const char*)g.A + (size_t)nxt.pm * tstep : cA; const char* nB = has_next ? (const char*)g.Bt + (size_t)nxt.pn * tstep : cB;
        for (int t = 0; t < nt; t += 2) {
            const bool last = (t == nt - 2);
            const char* a1 = cA + (size_t)(t + 1) * kstep;
            const char* a2 = last ? nA : cA + (size_t)(t + 2) * kstep; const char* b2 = last ? nB : cB + (size_t)(t + 2) * kstep;
            const char* a3 = a2 + kstep; const char* b3 = b2 + kstep;
            if (last && has_next) S.a_ready(nxt);
            if constexpr (SP2) {
            PG8_LDB(B0, 0, 0); PG8_LDB(B1, 0, 1); PG8_SCHED; PG8_LDA(At, 0, 0); PG8_STAGE(PG8_SA(1, 1), a1 + hstep, voffA);
            PG8_WAIT_V(8); PG8_WAIT_L(0); PG8_BAR; PG8_MMA(0, 0, At, B0); PG8_MMA(0, 1, At, B1); PG8_BAR; PG8_SCHED;
            PG8_LDA(At, 0, 1); PG8_STAGE(PG8_SB(0, 0), b2, voffB); PG8_STAGE(PG8_SB(0, 1), b2 + hstep, voffB); PG8_STAGE(PG8_SA(0, 0), a2, voffA);
            PG8_WAIT_V(8); PG8_WAIT_L(0); PG8_BAR; PG8_MMA(1, 0, At, B0); PG8_MMA(1, 1, At, B1); PG8_BAR; PG8_SCHED;
            PG8_LDB(B0, 1, 0); PG8_LDB(B1, 1, 1); PG8_SCHED; PG8_LDA(At, 1, 0); PG8_STAGE(PG8_SA(0, 1), a2 + hstep, voffA);
            PG8_WAIT_V(8); PG8_WAIT_L(0); PG8_BAR; PG8_MMA(0, 0, At, B0); PG8_MMA(0, 1, At, B1); PG8_BAR; PG8_SCHED;
            PG8_LDA(At, 1, 1); PG8_STAGE(PG8_SB(1, 0), b3, voffB); PG8_STAGE(PG8_SB(1, 1), b3 + hstep, voffB); PG8_STAGE(PG8_SA(1, 0), a3, voffA);
            PG8_WAIT_V(8); PG8_WAIT_L(0); PG8_BAR; PG8_MMA(1, 0, At, B0); PG8_MMA(1, 1, At, B1); PG8_BAR; PG8_SCHED;
            } else {
            PG8_LDB(B0, 0, 0); PG8_SCHED; PG8_LDA(At, 0, 0); PG8_STAGE(PG8_SA(1, 1), a1 + hstep, voffA);
            PG8_WAIT_L(8); PG8_BAR; PG8_WAIT_L(0); PG8_MMA(0, 0, At, B0); PG8_BAR; PG8_SCHED;
            PG8_LDB(B1, 0, 1); PG8_STAGE(PG8_SB(0, 0), b2, voffB);
            PG8_BAR; PG8_WAIT_L(0); PG8_MMA(0, 1, At, B1); PG8_BAR;
            PG8_LDA(At, 0, 1); PG8_STAGE(PG8_SA(0, 0), a2, voffA);
            PG8_BAR; PG8_WAIT_L(0); PG8_MMA(1, 0, At, B0); PG8_BAR; PG8_SCHED;
            PG8_STAGE(PG8_SB(0, 1), b2 + hstep, voffB);
            PG8_WAIT_V(6); PG8_BAR; PG8_MMA(1, 1, At, B1); PG8_BAR;
            PG8_LDB(B0, 1, 0); PG8_SCHED; PG8_LDA(At, 1, 0); PG8_STAGE(PG8_SA(0, 1), a2 + hstep, voffA);
            PG8_WAIT_L(8); PG8_BAR; PG8_WAIT_L(0); PG8_MMA(0, 0, At, B0); PG8_BAR; PG8_SCHED;
            PG8_LDB(B1, 1, 1); PG8_STAGE(PG8_SB(1, 0), b3, voffB);
            PG8_BAR; PG8_WAIT_L(0); PG8_MMA(0, 1, At, B1); PG8_BAR;
            PG8_LDA(At, 1, 1); PG8_STAGE(PG8_SA(1, 0), a3, voffA);
            PG8_BAR; PG8_WAIT_L(0); PG8_MMA(1, 0, At, B0); PG8_BAR; PG8_SCHED;
            PG8_STAGE(PG8_SB(1, 1), b3 + hstep, voffB);
            PG8_WAIT_V(6); PG8_BAR; PG8_MMA(1, 1, At, B1); PG8_BAR;
            }
        }
        if constexpr (ALIGN_EPI) { if (wr == 0) PG8_BAR; }
        if constexpr (!Epi::AFTER_DRAIN) { E(acc, cur, wr, wc, fr, fq); S.done(cur); }
        if (!has_next) break;
#pragma unroll
        for (int a = 0; a < 2; ++a)
#pragma unroll
            for (int b = 0; b < 2; ++b)
#pragma unroll
                for (int m = 0; m < 4; ++m)
#pragma unroll
                    for (int n = 0; n < 2; ++n) acc[a][b][m][n] = (f32x4){0.f, 0.f, 0.f, 0.f};
        cur = nxt; cA = nA; cB = nB; ++ui;
        if constexpr (ALIGN_EPI) { if (wr == 1) PG8_BAR; }
    }
    PG8_WAIT_V(0);
    if constexpr (!ALIGN_EPI) { if (wr == 0) PG8_BAR; }
    PG8_BAR;
    if constexpr (Epi::AFTER_DRAIN) { E.fused(acc, cur, wr, wc, fr, fq, lds, wid, lane); S.done(cur); }
#undef PG8_SA
#undef PG8_SB
#undef PG8_STAGE
#undef PG8_LDA
#undef PG8_LDB
#undef PG8_MMA
#undef PG8_WAIT_V
#undef PG8_WAIT_L
#undef PG8_BAR
#undef PG8_SCHED
}
}
#define GAS __attribute__((address_space(1)))
#define LAS __attribute__((address_space(3)))
typedef unsigned short bf16;
typedef unsigned v4u __attribute__((ext_vector_type(4)));
typedef float f32x4 __attribute__((ext_vector_type(4)));
typedef short bf16x8 __attribute__((ext_vector_type(8)));
typedef GAS unsigned gu32;
typedef GAS unsigned long long gu64;
#define RLX_AGENT __ATOMIC_RELAXED, __HIP_MEMORY_SCOPE_AGENT
#define LDS_WAIT() asm volatile("s_waitcnt lgkmcnt(0)" ::: "memory")
#define VM_WAIT() asm volatile("s_waitcnt vmcnt(0)" ::: "memory")
__device__ __forceinline__ unsigned long long rt() { return __builtin_amdgcn_s_memrealtime(); }
__device__ __forceinline__ unsigned f2bf(float f) { unsigned u = __builtin_bit_cast(unsigned, f); return (u + 0x7fffu + ((u >> 16) & 1u)) >> 16; }
typedef float f32x2_t __attribute__((ext_vector_type(2)));
typedef __bf16 bf16x2_t __attribute__((ext_vector_type(2)));
__device__ __forceinline__ unsigned pk2(float lo, float hi) { f32x2_t v = {lo, hi}; bf16x2_t b = __builtin_convertvector(v, bf16x2_t); return __builtin_bit_cast(unsigned, b); }
#define XB_TMO      128
#define XB_XCNT(j)  (256  + 64 * (j))
#define XB_XSUB(j)  (1280 + 64 * (j))
#define XB_XGEN(j)  (2304 + 64 * (j))
#define XB_TOP      3328
#define XB_TOPGEN   3392
#define XCD_BAR_WORDS 3456
#define XB_SPIN_CAP (1u << 18)

__device__ __forceinline__ unsigned xb_ld(unsigned* p)              { return __hip_atomic_load(p, __ATOMIC_RELAXED, __HIP_MEMORY_SCOPE_AGENT); }
__device__ __forceinline__ unsigned xb_add(unsigned* p, unsigned v) { return __hip_atomic_fetch_add(p, v, __ATOMIC_RELAXED, __HIP_MEMORY_SCOPE_AGENT); }
__device__ __forceinline__ unsigned xb_xcc_id() { return (unsigned)__builtin_amdgcn_s_getreg((3 << 11) | 20) & 0xFu; }
#define XB_SPIN(cond, bar) do { unsigned _sp = 0; while (cond) { __builtin_amdgcn_s_sleep(1); \
    if ((++_sp & 255u) == 0u) { if (xb_ld(&(bar)[XB_TMO])) break; if (_sp > XB_SPIN_CAP) { atomicAdd(&(bar)[XB_TMO], 1u); break; } } } } while (0)

struct XcdBarrier {
    unsigned* bar; unsigned x;
    volatile LAS unsigned* st;
};

__device__ __forceinline__ XcdBarrier xcd_barrier_post(unsigned* bar, volatile LAS unsigned* st) {
    XcdBarrier b; b.bar = bar; b.x = xb_xcc_id(); b.st = st;
    if (threadIdx.x == 0) (void)xb_add(&bar[XB_XCNT(b.x)], 1u);
    return b;
}
__device__ __forceinline__ void xcd_barrier_complete(unsigned* bar, unsigned x, unsigned& nloc, unsigned& nx) {
    const unsigned G = gridDim.x * gridDim.y * gridDim.z;
    unsigned sum, cnt, mine, sp = 0u;
    for (;;) {
        sum = 0u; cnt = 0u; mine = 0u;
#pragma unroll
        for (unsigned j = 0; j < 16; ++j) { const unsigned c = xb_ld(&bar[XB_XCNT(j)]); sum += c; cnt += (c > 0u) ? 1u : 0u; mine = (j == x) ? c : mine; }
        if (sum == G) break;
        __builtin_amdgcn_s_sleep(1);
        if ((++sp & 255u) == 0u) { if (xb_ld(&bar[XB_TMO])) break; if (sp > XB_SPIN_CAP) { atomicAdd(&bar[XB_TMO], 1u); break; } }
    }
    nloc = mine > 0u ? mine : 1u; nx = cnt > 0u ? cnt : 1u;
}

__device__ __forceinline__ void xcd_barrier(const XcdBarrier& b) {
    asm volatile("s_waitcnt vmcnt(0)" ::: "memory");
    __syncthreads();
    if (threadIdx.x == 0) {
        unsigned* bar = b.bar;
        __builtin_amdgcn_s_waitcnt(0);
        unsigned nloc = b.st[0], nx = b.st[1];
        if (nloc == 0u) { xcd_barrier_complete(bar, b.x, nloc, nx); b.st[0] = nloc; b.st[1] = nx; }
        const unsigned old = xb_add(&bar[XB_XSUB(b.x)], 1u);
        const unsigned gen = old / nloc;
        if (old + 1u == (gen + 1u) * nloc) {
            __builtin_amdgcn_fence(__ATOMIC_RELEASE, "agent");
            asm volatile("s_waitcnt vmcnt(0)" ::: "memory");
            const unsigned og = xb_add(&bar[XB_TOP], 1u);
            const unsigned tg = og / nx;
            if (og + 1u == (tg + 1u) * nx) xb_add(&bar[XB_TOPGEN], 1u);
            else XB_SPIN(xb_ld(&bar[XB_TOPGEN]) == tg, bar);
            __builtin_amdgcn_fence(__ATOMIC_ACQUIRE, "agent");
            xb_add(&bar[XB_XGEN(b.x)], 1u);
            asm volatile("s_waitcnt vmcnt(0)" ::: "memory");
        } else {
            XB_SPIN(xb_ld(&bar[XB_XGEN(b.x)]) == gen, bar);
            __builtin_amdgcn_fence(__ATOMIC_ACQUIRE, "agent");
            asm volatile("s_waitcnt vmcnt(0)" ::: "memory");
        }
    }
    __syncthreads();
}
constexpr int NWAVES = 8;
constexpr int DM = 4096, TP = 16384, TS = 8192, TT = 24576, NLAYER = 2;
constexpr int INC = 9792, ZC = 9984;
constexpr int Z_CQ = 3072, Z_CKV = 4608, Z_KR = 5120, Z_DQ = 5376, Z_DK = 6912, Z_DV = 8448;
constexpr int QC = 2304, KVC = 3072, DFF = 16384;
constexpr float EPS = 1e-6f;
constexpr int NPH_LAYER = 10, NPHASES = 1 + NLAYER * NPH_LAYER;

constexpr size_t MiB = 1u << 20;
constexpr size_t WS_CTL = 0, CTL_ZERO_BYTES = 1 * MiB;
constexpr size_t WS_R64 = 1 * MiB, WS_R128 = 3 * MiB;
constexpr size_t WS_FILT = 7 * MiB, FILT_LAYER = 40 * MiB, FILT_S_OFF = 8 * MiB;
constexpr size_t WS_WT = 87 * MiB;
constexpr size_t WT_IN = 0, WT_OUT = 78 * MiB, WT_UP = 110 * MiB, WT_DN = 238 * MiB, WT_QB = 366 * MiB, WT_KVB = WT_QB + 7077888, WT_LAYER = WT_KVB + 3 * MiB;
constexpr size_t WS_H = WS_WT + 2 * WT_LAYER;
constexpr size_t WS_A2 = WS_H + 192 * MiB;
constexpr size_t WS_Z = WS_A2, WS_Q = WS_Z + 468 * MiB, WS_KV = WS_Q + 108 * MiB, WS_UT = WS_KV + 144 * MiB;
constexpr size_t WS_CQ = WS_A2 + 768 * MiB, WS_CKV = WS_CQ + 72 * MiB, WS_KR = WS_CKV + 24 * MiB, WS_X0T = WS_KR + 3 * MiB, WS_YT = WS_X0T + 48 * MiB, WS_DLSE = WS_YT + 48 * MiB;
constexpr size_t WS_SSQP = WS_DLSE + 2 * MiB;
constexpr size_t WS_END = WS_SSQP + 2 * MiB;
constexpr size_t WS_XB = WS_H;
constexpr size_t WS_MIX = WS_KV;
constexpr size_t WS_SSQ = 128 * 1024;
static_assert(WS_MIX + (size_t)TT * DM * 2 == WS_A2 + 768 * MiB && WS_SSQ + 4 * (size_t)TT * 4 <= CTL_ZERO_BYTES, "MIXED overlay / ssq arrays");
static_assert(WS_END <= 2048 * MiB, "workspace map fits 2 GiB");

constexpr int CW_TMO = 0, CW_BAR = 4096;
constexpr int RING_BYTES = 131072, LDSCTL_OFF = RING_BYTES, MISC_OFF = LDSCTL_OFF + 320, WSCR_OFF = RING_BYTES + 1024, PTAB_OFF = RING_BYTES + 2048, KVTAB_OFF = RING_BYTES + 4096  , LDS_BYTES = 147456;

typedef unsigned short bf16;
typedef unsigned v4u __attribute__((ext_vector_type(4)));
typedef unsigned v2u __attribute__((ext_vector_type(2)));
typedef float f32x4 __attribute__((ext_vector_type(4)));
typedef float f32x2v __attribute__((ext_vector_type(2)));
typedef float f32x16 __attribute__((ext_vector_type(16)));
typedef short bf16x8 __attribute__((ext_vector_type(8)));
typedef short s16x4 __attribute__((ext_vector_type(4)));
#define SBAR() __builtin_amdgcn_sched_barrier(0)
struct InTab { const float* const (&t)[31]; __device__ __forceinline__ const float* operator[](int k) const { return t[k]; } };

__device__ __forceinline__ float bf2f(unsigned v) { return __uint_as_float(v << 16); }
__device__ __forceinline__ float bflo(unsigned w) { return __uint_as_float(w << 16); }
__device__ __forceinline__ float bfhi(unsigned w) { return __uint_as_float(w & 0xffff0000u); }
__device__ __forceinline__ int crow_(int r, int hi) { return (r & 3) + 8 * (r >> 2) + 4 * hi; }
__device__ __forceinline__ float wave_sum(float v) {
#pragma unroll
    for (int o = 1; o < 64; o <<= 1) v += __shfl_xor(v, o);
    return v;
}
__device__ __forceinline__ void unpack8(const v4u w, float (&f)[8]) { f[0] = bflo(w.x); f[1] = bfhi(w.x); f[2] = bflo(w.y); f[3] = bfhi(w.y); f[4] = bflo(w.z); f[5] = bfhi(w.z); f[6] = bflo(w.w); f[7] = bfhi(w.w); }
__device__ __forceinline__ v4u pack8(const float (&f)[8]) { v4u w; w.x = pk2(f[0], f[1]); w.y = pk2(f[2], f[3]); w.z = pk2(f[4], f[5]); w.w = pk2(f[6], f[7]); return w; }
__device__ __forceinline__ int seq_pos(int m) { return m < TP ? (m & 2047) : (m - TP); }
__device__ __forceinline__ int seq_len(int m) { return m < TP ? 2048 : 8192; }

__device__ __forceinline__ void transpose_item(const float* W, int ldw, bf16* WT, int K, int k0, int nsrc, int ndst, int dstr  , const float* gk  , LAS float* scr, int lane) {
    float tv[32];
#pragma unroll
    for (int i = 0; i < 32; ++i) tv[i] = W[(size_t)(k0 + 2 * i + (lane >> 5)) * ldw + nsrc + (lane & 31)];
    if (gk) {
#pragma unroll
        for (int i = 0; i < 32; ++i) tv[i] *= gk[k0 + 2 * i + (lane >> 5)]; }
#pragma unroll
    for (int i = 0; i < 32; ++i) scr[(2 * i + (lane >> 5)) * 33 + (lane & 31)] = tv[i];
    LDS_WAIT(); asm volatile("" ::: "memory");
    const int c = lane & 7;
#pragma unroll
    for (int j = 0; j < 4; ++j) { const int n = (lane >> 3) + 8 * j; const LAS float* s = scr + (8 * c) * 33 + n;
        v4u o; o.x = pk2(s[0 * 33], s[1 * 33]); o.y = pk2(s[2 * 33], s[3 * 33]); o.z = pk2(s[4 * 33], s[5 * 33]); o.w = pk2(s[6 * 33], s[7 * 33]);
        *(GAS v4u*)(WT + (size_t)(ndst + n * dstr) * K + k0 + 8 * c) = o; }
    LDS_WAIT(); asm volatile("" ::: "memory");
}
constexpr int I_IN = 64 * 306, I_OUT = 64 * 128, I_UP = 64 * 512, I_DN = 256 * 128, I_QB = 24 * 72, I_KVB = 8 * 96, I_LAYER = I_IN + I_OUT + I_UP + I_DN + I_QB + I_KVB;
__device__ __forceinline__ void p0_weights(const InTab in, unsigned char* ws, LAS float* scr, int gw, int NGW, int lane) {
    for (int it = gw; it < NLAYER * I_LAYER; it += NGW) {
        const int l = it / I_LAYER; int r = it % I_LAYER; unsigned char* wl = ws + WS_WT + (size_t)l * WT_LAYER;
        if (r < I_IN) { const int kb = r / 306, nb = r % 306, n0 = 32 * nb; int nd = n0, ds = 1;
            if (n0 >= 8256) nd = n0 + 192;
            else if (n0 >= 5184) { const int nl = n0 - 5184, d0 = nl & 127; nd = Z_DQ + (nl & ~127) + (d0 < 64 ? 2 * d0 : 2 * (d0 - 64) + 1); ds = 2; }
            transpose_item(in[3] + (size_t)l * DM * INC, INC, (bf16*)(wl + WT_IN), DM, 64 * kb, n0, nd, ds, in[2] + l * DM, scr, lane); continue; } r -= I_IN;
        if (r < I_OUT) { const int kb = r / 128, nb = r % 128; transpose_item(in[27] + (size_t)l * DM * DM, DM, (bf16*)(wl + WT_OUT), DM, 64 * kb, 32 * nb, 32 * nb, 1, nullptr, scr, lane); continue; } r -= I_OUT;
        if (r < I_UP) { const int kb = r / 512, nb = r % 512; transpose_item(in[29] + (size_t)l * DM * DFF, DFF, (bf16*)(wl + WT_UP), DM, 64 * kb, 32 * nb, 32 * nb, 1, in[28] + l * DM, scr, lane); continue; } r -= I_UP;
        if (r < I_DN) { const int kb = r / 128, nb = r % 128; transpose_item(in[30] + (size_t)l * DFF * DM, DM, (bf16*)(wl + WT_DN), DFF, 64 * kb, 32 * nb, 32 * nb, 1, nullptr, scr, lane); continue; } r -= I_DN;
        if (r < I_QB) { const int kb = r / 72, nb = r % 72, n0 = 32 * nb, h = n0 / 192, j = n0 % 192;
            transpose_item(in[17] + (size_t)l * 1536 * QC, QC, (bf16*)(wl + WT_QB), 1536, 64 * kb, n0, j < 128 ? h * 128 + j : 1536 + h * 64 + (j - 128), 1, nullptr, scr, lane); continue; } r -= I_QB;
        { const int kb = r / 96, nb = r % 96; transpose_item(in[19] + (size_t)l * 512 * KVC, KVC, (bf16*)(wl + WT_KVB), 512, 64 * kb, 32 * nb, 32 * nb, 1, nullptr, scr, lane); }
    }
}
__device__ __forceinline__ void p0_misc(unsigned char* ws, int gt, int NGT) {
    for (int i = gt; i < NLAYER * 98304; i += NGT) { const int l = i / 98304, r = i % 98304; *(GAS v4u*)(ws + WS_WT + (size_t)l * WT_LAYER + WT_IN + (size_t)5184 * DM * 2 + (size_t)r * 16) = (v4u){0u, 0u, 0u, 0u}; }
    for (int i = gt; i < 8192 * 96; i += NGT) { const int pos = i / 96, j = i % 96; float sv, cv;
        if (j < 32) { const float inv = 1.0f / powf(10000.0f, (float)(2 * j) / 64.0f); sincosf((float)pos * inv, &sv, &cv); ((GAS f32x2v*)(ws + WS_R64))[pos * 32 + j] = (f32x2v){cv, sv}; }
        else { const int jj = j - 32; const float inv = 1.0f / powf(10000.0f, (float)(2 * jj) / 128.0f); sincosf((float)pos * inv, &sv, &cv); ((GAS f32x2v*)(ws + WS_R128))[pos * 64 + jj] = (f32x2v){cv, sv}; } }
}
constexpr int FI_W1 = 0, FI_W2 = 33 * 64 * 4, FI_W3 = FI_W2 + 16384, FI_B = FI_W3 + 16384  , FI_H0 = FI_B + 1024, FI_H1 = FI_H0 + 16384, FI_H3 = FI_H1 + 16384;
__device__ __forceinline__ void filter_item(const InTab in, unsigned char* ws, int layer, int trunk, int pblk, LAS unsigned char* lds, int tid, int lane, int wave) {
    const int L = trunk ? 8192 : 2048, p0 = pblk * 64, p = p0 + lane;
    bf16* Rg = (bf16*)(ws + WS_FILT + (size_t)layer * FILT_LAYER + (trunk ? FILT_S_OFF : 0));
    const float* w4 = in[12] + (size_t)layer * 64 * 2048; const float* b4 = in[13] + layer * 2048;
    __syncthreads();
    { const float* w1 = in[6] + layer * 33 * 64; const float* w2 = in[8] + layer * 4096; const float* w3 = in[10] + layer * 4096;
      for (int i = tid; i < 33 * 64; i += 512) ((LAS float*)(lds + FI_W1))[i] = w1[i];
      for (int i = tid; i < 4096; i += 512) { ((LAS float*)(lds + FI_W2))[i] = w2[i]; ((LAS float*)(lds + FI_W3))[i] = w3[i]; }
      if (tid < 64) { ((LAS float*)(lds + FI_B))[tid] = in[7][layer * 64 + tid]; ((LAS float*)(lds + FI_B))[64 + tid] = in[9][layer * 64 + tid];
                      ((LAS float*)(lds + FI_B))[128 + tid] = in[11][layer * 64 + tid]; ((LAS float*)(lds + FI_B))[192 + tid] = in[14][layer * 64 + tid]; } }
    const float tp = (float)p / (float)(L - 1), wang = 6.283185307179586f * (float)p / (float)L;
    if (wave == 0) ((LAS float*)(lds + FI_H1))[lane] = tp;
#pragma unroll 1
    for (int jj = 0; jj < 2; ++jj) { const int j = 2 * wave + jj; const float f = 1e-4f + (float)j * ((15.0f - 1e-4f) / 15.0f); float sv, cv; sincosf(f * wang, &sv, &cv);
        ((LAS float*)(lds + FI_H1))[(1 + j) * 64 + lane] = cv; ((LAS float*)(lds + FI_H1))[(17 + j) * 64 + lane] = -sv; }
    __syncthreads();
    const LAS float* Bv = (const LAS float*)(lds + FI_B);
    float hv[64];
#pragma unroll
    for (int k = 0; k < 33; ++k) hv[k] = ((const LAS float*)(lds + FI_H1))[k * 64 + lane];
#pragma unroll 1
    for (int u = 0; u < 8; ++u) { const int k = 8 * wave + u; const LAS float* wc = (const LAS float*)(lds + FI_W1) + k; float a = Bv[k];
#pragma unroll
        for (int j = 0; j < 33; ++j) a += hv[j] * wc[j * 64];
        ((LAS float*)(lds + FI_H0))[k * 64 + lane] = sinf(Bv[192 + k] * a); }
    __syncthreads();
#pragma unroll
    for (int k = 0; k < 64; ++k) hv[k] = ((const LAS float*)(lds + FI_H0))[k * 64 + lane];
#pragma unroll 1
    for (int u = 0; u < 8; ++u) { const int k = 8 * wave + u; const LAS float* wc = (const LAS float*)(lds + FI_W2) + k; float a = Bv[64 + k];
#pragma unroll
        for (int j = 0; j < 64; ++j) a += hv[j] * wc[j * 64];
        ((LAS float*)(lds + FI_H1))[k * 64 + lane] = sinf(Bv[192 + k] * a); }
    __syncthreads();
#pragma unroll
    for (int k = 0; k < 64; ++k) hv[k] = ((const LAS float*)(lds + FI_H1))[k * 64 + lane];
#pragma unroll 1
    for (int u = 0; u < 8; ++u) { const int k = 8 * wave + u; const LAS float* wc = (const LAS float*)(lds + FI_W3) + k; float a = Bv[128 + k];
#pragma unroll
        for (int j = 0; j < 64; ++j) a += hv[j] * wc[j * 64];
        ((LAS bf16*)(lds + FI_H3))[lane * 72 + k] = (bf16)f2bf(sinf(Bv[192 + k] * a)); }
    __syncthreads();
    const int r32 = lane & 31, hi = lane >> 5;
    float tq[2]; int pq[2];
#pragma unroll
    for (int pb = 0; pb < 2; ++pb) { pq[pb] = p0 + pb * 32 + r32; tq[pb] = -1.4426950408889634f * (float)pq[pb] / (float)(L - 1); }
#pragma unroll 1
    for (int cbk = 0; cbk < 8; ++cbk) {
        const int c0 = 256 * wave + 32 * cbk;
        f32x16 acc[2];
#pragma unroll
        for (int pb = 0; pb < 2; ++pb) acc[pb] = (f32x16){0.f, 0.f, 0.f, 0.f, 0.f, 0.f, 0.f, 0.f, 0.f, 0.f, 0.f, 0.f, 0.f, 0.f, 0.f, 0.f};
#pragma unroll 1
        for (int ks = 0; ks < 4; ++ks) {
            const float* wk = w4 + (size_t)(ks * 16 + hi * 8) * 2048 + c0 + r32; float wv[8];
#pragma unroll
            for (int j = 0; j < 8; ++j) wv[j] = wk[j * 2048];
            const bf16x8 b0 = *(const LAS bf16x8*)(lds + FI_H3 + r32 * 144 + (ks * 16 + hi * 8) * 2), b1 = *(const LAS bf16x8*)(lds + FI_H3 + (32 + r32) * 144 + (ks * 16 + hi * 8) * 2);
            v4u aw; aw.x = pk2(wv[0], wv[1]); aw.y = pk2(wv[2], wv[3]); aw.z = pk2(wv[4], wv[5]); aw.w = pk2(wv[6], wv[7]);
            const bf16x8 af = __builtin_bit_cast(bf16x8, aw);
            acc[0] = __builtin_amdgcn_mfma_f32_32x32x16_bf16(af, b0, acc[0], 0, 0, 0); acc[1] = __builtin_amdgcn_mfma_f32_32x32x16_bf16(af, b1, acc[1], 0, 0, 0);
        }
        const bool fwd = wave < 4;
        unsigned nidx[2]; bool zr[2];
#pragma unroll
        for (int pb = 0; pb < 2; ++pb) { zr[pb] = !fwd && pq[pb] == 0; nidx[pb] = fwd ? (unsigned)(L - pq[pb]) : (zr[pb] ? 0u : (unsigned)(L + pq[pb])); }
#pragma unroll
        for (int r = 0; r < 16; ++r) { const unsigned col = (unsigned)(c0 + crow_(r, hi)), ch = col & 1023u;
            const float delta = fabsf(-3.0701134573253944f + (float)ch * ((-15.350567286626972f + 3.0701134573253944f) / 1023.0f)), bb = b4[col];
#pragma unroll
            for (int pb = 0; pb < 2; ++pb) { const float v = (acc[pb][r] + bb) * __builtin_amdgcn_exp2f(tq[pb] * delta);
                Rg[ch * (unsigned)(2 * L) + nidx[pb]] = zr[pb] ? (bf16)0 : (bf16)f2bf(v); }
            if ((r & 3) == 3) asm volatile("" ::: "memory"); }
    }
    __syncthreads();
}
__device__ __forceinline__ void cvt_rows(const float* x0, const float* x1, bf16* XB, float* ssq, int gw, int NGW, int lane) {
    for (int m = gw; m < TT; m += NGW) {
        const GAS f32x4* xr = (const GAS f32x4*)((m < TP ? x0 : x1) + (size_t)m * DM) + lane;
        f32x4 v[16]; float s = 0.f;
#pragma unroll
        for (int j = 0; j < 16; ++j) { v[j] = xr[64 * j]; s += (v[j].x * v[j].x + v[j].y * v[j].y) + (v[j].z * v[j].z + v[j].w * v[j].w); }
        s = wave_sum(s); if (lane == 0) ssq[m] = 1.0f / sqrtf(s * (1.0f / DM) + EPS);
        GAS v2u* o8 = (GAS v2u*)(XB + (size_t)m * DM) + lane;
#pragma unroll
        for (int j = 0; j < 16; ++j) { v2u w; w.x = pk2(v[j].x, v[j].y); w.y = pk2(v[j].z, v[j].w); o8[64 * j] = w; }
    }
}

__device__ __forceinline__ void rstd_rows(const float* ssqp, float* rstd, int gt, int NGT) {
    for (int m = gt; m < TT; m += NGT) { const GAS f32x4* p = (const GAS f32x4*)(ssqp + (size_t)m * 16); const f32x4 a = p[0], b = p[1], c = p[2], d = p[3];
        const float s = (((a.x + a.y) + (a.z + a.w)) + ((b.x + b.y) + (b.z + b.w))) + (((c.x + c.y) + (c.z + c.w)) + ((d.x + d.y) + (d.z + d.w)));
        rstd[m] = 1.0f / sqrtf(s * (1.0f / DM) + EPS); }
}
__device__ __forceinline__ void prep_hyena(const bf16* Z, const float* cw, const float* cb, bf16* UT, bf16* X0T, LAS unsigned char* lds, int tid, int bid, int G) {
    for (int tile = bid; tile < 384 * 8; tile += G) {
        const int tb = tile >> 3, cbk = tile & 7, row = tid >> 3, c8 = (tid & 7) * 8, m = tb * 64 + row;
        const int pos = seq_pos(m), L = seq_len(m); const bool hasm = pos > 0, hasp = pos < L - 1;
        v4u zw[2][3][3];
#pragma unroll
        for (int hc = 0; hc < 2; ++hc)
#pragma unroll
            for (int gI = 0; gI < 3; ++gI) { const bf16* zp = Z + (size_t)m * ZC + gI * 1024 + cbk * 128 + hc * 64 + c8;
                zw[hc][gI][1] = *(const GAS v4u*)zp; zw[hc][gI][0] = hasm ? *(const GAS v4u*)(zp - ZC) : (v4u){0u, 0u, 0u, 0u}; zw[hc][gI][2] = hasp ? *(const GAS v4u*)(zp + ZC) : (v4u){0u, 0u, 0u, 0u}; }
        __syncthreads();
#pragma unroll
        for (int hc = 0; hc < 2; ++hc) {
            const int c0 = cbk * 128 + hc * 64 + c8; float xc[3][8];
#pragma unroll
            for (int gI = 0; gI < 3; ++gI) { float a[8], b[8], c[8]; unpack8(zw[hc][gI][0], a); unpack8(zw[hc][gI][1], b); unpack8(zw[hc][gI][2], c); const float* wp = cw + gI * 1024 + c0;
#pragma unroll
                for (int e = 0; e < 8; ++e) xc[gI][e] = a[e] * wp[e] + b[e] * wp[3072 + e] + c[e] * wp[6144 + e] + cb[gI * 1024 + c0 + e]; }
            LAS bf16* TU = (LAS bf16*)(lds + hc * (2 * 64 * 132)); LAS bf16* TX = TU + 64 * 66;
#pragma unroll
            for (int e = 0; e < 8; ++e) { TU[(c8 + e) * 66 + row] = (bf16)f2bf(xc[1][e] * xc[2][e]); TX[(c8 + e) * 66 + row] = (bf16)f2bf(xc[0][e]); }
        }
        __syncthreads();
#pragma unroll
        for (int hc = 0; hc < 2; ++hc) { const int c = tid >> 3, t8 = (tid & 7) * 8; const LAS bf16* TU = (const LAS bf16*)(lds + hc * (2 * 64 * 132)); const LAS bf16* TX = TU + 64 * 66;
            const LAS unsigned* su = (const LAS unsigned*)(TU + c * 66 + t8); const LAS unsigned* sx = (const LAS unsigned*)(TX + c * 66 + t8);
            const v4u wu = {su[0], su[1], su[2], su[3]}, wx = {sx[0], sx[1], sx[2], sx[3]};
            const size_t o = (size_t)(cbk * 128 + hc * 64 + c) * TT + tb * 64 + t8; *(GAS v4u*)(UT + o) = wu; *(GAS v4u*)(X0T + o) = wx; }
    }
}
__device__ __forceinline__ void prep_tokens(const bf16* Z, const InTab in, int l, unsigned char* ws, int gw, int NGW, int lane) {
    bf16* CQ = (bf16*)(ws + WS_CQ); bf16* CKV = (bf16*)(ws + WS_CKV); bf16* KR = (bf16*)(ws + WS_KR);
    const GAS f32x2v* R64 = (const GAS f32x2v*)(ws + WS_R64); const GAS f32x2v* R128 = (const GAS f32x2v*)(ws + WS_R128);
    const float* gq = in[16] + l * 1536; const float* gkv = in[18] + l * 512; const float* gkr = in[23] + l * 64; const float* gdq = in[24] + l * 128; const float* gdk = in[25] + l * 128;
    for (int m = gw; m < TT; m += NGW) {
        const int pos = seq_pos(m); const bf16* zr = Z + (size_t)m * ZC;
        v4u cqw[3], ckw;
#pragma unroll
        for (int j = 0; j < 3; ++j) cqw[j] = *(const GAS v4u*)(zr + Z_CQ + lane * 8 + 512 * j);
        ckw = *(const GAS v4u*)(zr + Z_CKV + lane * 8); const unsigned krw = zr[Z_KR + lane];
        {
            float x[3][8]; float s = 0.f;
#pragma unroll
            for (int j = 0; j < 3; ++j) { unpack8(cqw[j], x[j]);
#pragma unroll
                for (int e = 0; e < 8; ++e) s += x[j][e] * x[j][e]; }
            const float rs = 1.0f / sqrtf(wave_sum(s) * (1.0f / 1536.0f) + EPS);
#pragma unroll
            for (int j = 0; j < 3; ++j) { const int c = lane * 8 + 512 * j; float y[8];
#pragma unroll
                for (int e = 0; e < 8; ++e) y[e] = x[j][e] * rs * gq[c + e];
                *(GAS v4u*)(CQ + (size_t)m * 1536 + c) = pack8(y); }
        }
        {
            float x[8], y[8]; float s = 0.f; unpack8(ckw, x);
#pragma unroll
            for (int e = 0; e < 8; ++e) s += x[e] * x[e];
            const float rs = 1.0f / sqrtf(wave_sum(s) * (1.0f / 512.0f) + EPS);
#pragma unroll
            for (int e = 0; e < 8; ++e) y[e] = x[e] * rs * gkv[lane * 8 + e];
            *(GAS v4u*)(CKV + (size_t)m * 512 + lane * 8) = pack8(y);
        }
        {
            const float x = bf2f(krw); const float rs = 1.0f / sqrtf(wave_sum(x * x) * (1.0f / 64.0f) + EPS);
            const float y = x * rs * gkr[lane], pr = __shfl_xor(y, 32); const f32x2v cs = R64[pos * 32 + (lane & 31)];
            KR[(size_t)m * 64 + lane] = (bf16)f2bf(lane < 32 ? y * cs.x - pr * cs.y : y * cs.x + pr * cs.y);
        }
    }
}
constexpr int CV_BS = 144;
template <int TRUNK>
__device__ __forceinline__ void conv_unit(int c, const bf16* Rg, const bf16* UT, const bf16* X0T, bf16* YT, float skip, LAS unsigned char* lds, int tid, int lane, int wave,
                                          v4u (&upre)[4], bool pre_valid, const bf16* next_urow, int next_np) {
    constexpr int L = TRUNK ? 8192 : 2048, NB = L / 64, NBAT = TRUNK ? 1 : 8, PADB = TRUNK ? 32 : 8, NBLK = NB + 2 * PADB, UBS = NBLK * CV_BS + (TRUNK ? 0 : 128);
    constexpr int NR = 2  , ENR = TRUNK ? 1 : 2  , TOK0 = TRUNK ? TP : 0, DC0 = TRUNK ? -128 : -32, DC1 = TRUNK ? 128 : 32;
    constexpr int ND = TRUNK ? 32 : 8, NPC = (64 * ND + 64) / 8  , NPR = NPC + 1  , CV_CS = NPC * 16 + 16, CV_RAW = TRUNK ? 28672 : 57344, CV_RSZ = (NPR * 16 + 255) & ~255, CV_FC = CV_RAW + 2 * CV_RSZ;
    static_assert(NBAT * UBS <= CV_RAW && CV_FC + 16 * CV_CS <= RING_BYTES && (CV_CS / 16) % 16 == 9 && NPR <= 512 && DC0 == -4 * ND && DC1 == 4 * ND, "conv LDS map");
    const bf16* urow = UT + (size_t)c * TT + TOK0;
    __syncthreads();
    for (int i = tid; i < NBAT * 2 * PADB * 8; i += 512) { const int b = i / (2 * PADB * 8), r = i % (2 * PADB * 8), pb = r >> 3, o8 = r & 7, blk = pb < PADB ? pb : pb + NB;
        *(LAS v4u*)(lds + b * UBS + blk * CV_BS + o8 * 16) = (v4u){0u, 0u, 0u, 0u}; }
    static_assert(NBAT * L / 8 % 512 == 0 && NBAT * L / 8 / 512 <= 4, "u pieces per thread");
#pragma unroll
    for (int k = 0; k < NBAT * L / 8 / 512; ++k) { const int ci = tid + 512 * k, b = ci / (L / 8), r = ci % (L / 8), blk = r >> 3, o8 = r & 7;
        const v4u uv = pre_valid ? upre[k] : *(const GAS v4u*)(urow + (size_t)ci * 8);
        *(LAS v4u*)(lds + b * UBS + (blk + PADB) * CV_BS + o8 * 16) = uv; }
    if (next_urow) {
#pragma unroll
        for (int k = 0; k < 4; ++k) if (k < next_np) upre[k] = *(const GAS v4u*)(next_urow + (size_t)(tid + 512 * k) * 8); }
    const int n = lane & 31, h = lane >> 5;
    int batch, t1, dlo, dhi, R0;
    const int g = wave & 3;
    if (TRUNK == 0) { const int bh = wave >> 2; batch = 4 * bh + (n >> 3); t1 = 8 * g + (n & 7); dlo = 8 * g - 31; dhi = 8 * g + 7; R0 = 0; }
    else { batch = 0; t1 = 32 * g + n; dlo = 32 * g - 127; dhi = 32 * g + 31; R0 = wave >> 2; }
    const int sl = (8 - (n & 7)) & 7;
    const int abase0 = CV_FC + sl * CV_CS + 2 * (64 * ND - n + 8 * h - sl);
    const int bbase0 = batch * UBS + (t1 + PADB) * CV_BS + 16 * h;
    f32x16 acc[NR];
#pragma unroll
    for (int r = 0; r < NR; ++r) acc[r] = (f32x16){0.f, 0.f, 0.f, 0.f, 0.f, 0.f, 0.f, 0.f, 0.f, 0.f, 0.f, 0.f, 0.f, 0.f, 0.f, 0.f};
    v2u xg[ENR][4];
    { const size_t tokb_ = (size_t)c * TT + TOK0 + batch * 2048 + 64 * t1;
#pragma unroll
      for (int r = 0; r < ENR; ++r)
#pragma unroll
          for (int kq = 0; kq < 4; ++kq) xg[r][kq] = *(const GAS v2u*)(X0T + tokb_ + 32 * (R0 + r) + 8 * kq + 4 * h); }
    v4u rawv[2] = {{0u, 0u, 0u, 0u}, {0u, 0u, 0u, 0u}};
#pragma unroll
    for (int k = 0; k < 2; ++k) { const int ch = k == 0 ? 0 : 5, nn = L - 64 * (DC0 + ND * ch + ND) + 8 * tid; if (tid < NPR && nn + 8 <= 2 * L) rawv[k] = *(const GAS v4u*)(Rg + nn); }
#pragma unroll 1
    for (int j = 0; j < 5; ++j) {
        if (j < 4) {
            __syncthreads();
            if (tid < NPR) { *(LAS v4u*)(lds + CV_RAW + 16 * tid) = rawv[0]; *(LAS v4u*)(lds + CV_RAW + CV_RSZ + 16 * tid) = rawv[1]; }
#pragma unroll
            for (int k = 0; k < 2; ++k) { const int ch = k == 0 ? j + 1 : (j + 1 < 3 ? 6 + j : 4), nn = L - 64 * (DC0 + ND * ch + ND) + 8 * tid; rawv[k] = (v4u){0u, 0u, 0u, 0u};
                if (j + 1 < 4 && tid < NPR && nn + 8 <= 2 * L) rawv[k] = *(const GAS v4u*)(Rg + nn); }
            __syncthreads();
#define CV_D(k) ((k) == 0 ? lo.x : (k) == 1 ? lo.y : (k) == 2 ? lo.z : (k) == 3 ? lo.w : (k) == 4 ? hi.x : (k) == 5 ? hi.y : (k) == 6 ? hi.z : hi.w)
#define CV_EMIT(s) do { v4u w; if ((s) & 1) { w.x = __builtin_amdgcn_alignbyte(CV_D((s) / 2 + 1), CV_D((s) / 2), 2); w.y = __builtin_amdgcn_alignbyte(CV_D((s) / 2 + 2), CV_D((s) / 2 + 1), 2); \
            w.z = __builtin_amdgcn_alignbyte(CV_D((s) / 2 + 3), CV_D((s) / 2 + 2), 2); w.w = __builtin_amdgcn_alignbyte(CV_D((s) / 2 + 4), CV_D((s) / 2 + 3), 2); } \
        else { w.x = CV_D((s) / 2); w.y = CV_D((s) / 2 + 1); w.z = CV_D((s) / 2 + 2); w.w = CV_D((s) / 2 + 3); } *(LAS v4u*)(dst + (s) * CV_CS) = w; } while (0)
            for (int idx = tid; idx < 4 * NPC; idx += 512) { const int q = idx / NPC, i = idx - q * NPC, win = q >> 1, hh = q & 1;
                const LAS unsigned char* rp = lds + CV_RAW + win * CV_RSZ + 16 * i; const v4u lo = *(const LAS v4u*)rp, hi = *(const LAS v4u*)(rp + 16); LAS unsigned char* dst = lds + CV_FC + win * (8 * CV_CS) + 16 * i;
                if (hh == 0) { CV_EMIT(0); CV_EMIT(1); CV_EMIT(2); CV_EMIT(3); } else { CV_EMIT(4); CV_EMIT(5); CV_EMIT(6); CV_EMIT(7); } }
#undef CV_EMIT
#undef CV_D
            __syncthreads();
        }
        const bool lower = j < 3 ? (g <= j) : (j == 3 ? g < 2 : g >= 2);
        const int ch = lower ? (j < 4 ? j : 3) : (j < 3 ? 5 + j : 4), dc = DC0 + ND * ch, abw = abase0 + (lower ? 0 : 8 * CV_CS);
        constexpr int DSTEP = TRUNK ? 2 : 1;
        int ddlo = dlo - dc > 0 ? dlo - dc : 0; const int ddhi = dhi - dc < ND - 1 ? dhi - dc : ND - 1;
        if (TRUNK) ddlo += ((dc + ddlo) ^ R0) & 1;
        if (ddlo <= ddhi) {
            bf16x8 fb[4], fa[4][NR];
            { const int ab = abw - 128 * ddlo, bb = bbase0 - (dc + ddlo) * CV_BS;
#pragma unroll
              for (int kb = 0; kb < 4; ++kb) { fb[kb] = *(const LAS bf16x8*)(lds + bb + 32 * kb);
#pragma unroll
                  for (int r = 0; r < NR; ++r) fa[kb][r] = *(const LAS bf16x8*)(lds + ab - 64 * r + 32 * kb); } }
#pragma unroll 2
            for (int dd = ddlo; dd <= ddhi; dd += DSTEP) {
                const int dn = dd + DSTEP <= ddhi ? dd + DSTEP : dd; const int ab = abw - 128 * dn, bb = bbase0 - (dc + dn) * CV_BS;
                bf16x8 nb[4], na[4][NR];
#pragma unroll
                for (int kb = 0; kb < 4; ++kb) { nb[kb] = *(const LAS bf16x8*)(lds + bb + 32 * kb);
#pragma unroll
                    for (int r = 0; r < NR; ++r) na[kb][r] = *(const LAS bf16x8*)(lds + ab - 64 * r + 32 * kb); }
#pragma unroll
                for (int kb = 0; kb < 4; ++kb)
#pragma unroll
                    for (int r = 0; r < NR; ++r) acc[r] = __builtin_amdgcn_mfma_f32_32x32x16_bf16(fa[kb][r], fb[kb], acc[r], 0, 0, 0);
#pragma unroll
                for (int kb = 0; kb < 4; ++kb) { fb[kb] = nb[kb];
#pragma unroll
                    for (int r = 0; r < NR; ++r) fa[kb][r] = na[kb][r]; }
            }
        }
    }
    if (TRUNK) {
        __syncthreads();
        LAS f32x4* xb = (LAS f32x4*)(lds + CV_FC);
#pragma unroll
        for (int q = 0; q < 4; ++q) { f32x4 v;
#pragma unroll
            for (int e = 0; e < 4; ++e) v[e] = R0 ? acc[0][4 * q + e] : acc[1][4 * q + e];
            xb[wave * 256 + q * 64 + lane] = v; }
        __syncthreads();
#pragma unroll
        for (int q = 0; q < 4; ++q) { const f32x4 v = xb[(wave ^ 4) * 256 + q * 64 + lane];
#pragma unroll
            for (int e = 0; e < 4; ++e) acc[0][4 * q + e] = (R0 ? acc[1][4 * q + e] : acc[0][4 * q + e]) + v[e]; }
    }
    const size_t tokb = (size_t)c * TT + TOK0 + batch * 2048 + 64 * t1;
#pragma unroll
    for (int r = 0; r < ENR; ++r)
#pragma unroll
        for (int kq = 0; kq < 4; ++kq) { const int t0 = 32 * (R0 + r) + 8 * kq + 4 * h;
            const v2u uu = *(const LAS v2u*)(lds + batch * UBS + (t1 + PADB) * CV_BS + 2 * t0); const v2u xx = xg[r][kq];
            const float y0 = bflo(xx.x) * (acc[r][4 * kq + 0] + bflo(uu.x) * skip), y1 = bfhi(xx.x) * (acc[r][4 * kq + 1] + bfhi(uu.x) * skip);
            const float y2 = bflo(xx.y) * (acc[r][4 * kq + 2] + bflo(uu.y) * skip), y3 = bfhi(xx.y) * (acc[r][4 * kq + 3] + bfhi(uu.y) * skip);
            v2u o; o.x = pk2(y0, y1); o.y = pk2(y2, y3); *(GAS v2u*)(YT + tokb + t0) = o; }
}
__device__ __forceinline__ int crow(int r, int hi) { return (r & 3) + 8 * (r >> 2) + 4 * hi; }
__device__ __forceinline__ unsigned cvtpk(float lo, float hi) { unsigned r; asm volatile("v_cvt_pk_bf16_f32 %0, %1, %2" : "=v"(r) : "v"(lo), "v"(hi)); return r; }
__device__ __forceinline__ void glds16(const void* g, LAS unsigned char* l) { __builtin_amdgcn_global_load_lds((const unsigned*)g, (LAS unsigned*)l, 16, 0, 0); }
__device__ __forceinline__ int v_st(int k, int c) { const int kk = (k & ~0xC) | ((k & 4) << 1) | ((k & 8) >> 1); return ((kk >> 3) * 4 + (c >> 5)) * 512 + ((kk & 7) * 32 + (c & 31)) * 2; }
__device__ __forceinline__ int v_rd_base(int lane) { return ((lane & 3) << 3) | (((lane >> 2) & 3) << 6) | (((lane >> 4) & 1) << 5) | (((lane >> 5) & 1) << 8); }
constexpr int v_rd_off(int d0, int ks, int half) { return d0 * 512 + ks * 4096 + half * 2048; }
__device__ __forceinline__ void v_inv(int P, int& k, int& c) { const int sub = P >> 9, w = (P & 511) >> 1, kk = ((sub >> 2) << 3) | (w >> 5); c = ((sub & 3) << 5) | (w & 31); k = (kk & ~0xC) | ((kk & 4) << 1) | ((kk & 8) >> 1); }
template <int OFF> __device__ __forceinline__ s16x4 tr_read(int vb) { s16x4 r; asm volatile("ds_read_b64_tr_b16 %0, %1 offset:%2" : "=&v"(r) : "v"(vb), "i"(OFF) : "memory"); return r; }
template <int D0> __device__ __forceinline__ void pv_one(f32x16& od, int vb, bf16x8 pa0, bf16x8 pa1, bf16x8 pa2, bf16x8 pa3) {
    const s16x4 l0 = tr_read<v_rd_off(D0, 0, 0)>(vb), h0 = tr_read<v_rd_off(D0, 0, 1)>(vb), l1 = tr_read<v_rd_off(D0, 1, 0)>(vb), h1 = tr_read<v_rd_off(D0, 1, 1)>(vb);
    const s16x4 l2 = tr_read<v_rd_off(D0, 2, 0)>(vb), h2 = tr_read<v_rd_off(D0, 2, 1)>(vb), l3 = tr_read<v_rd_off(D0, 3, 0)>(vb), h3 = tr_read<v_rd_off(D0, 3, 1)>(vb);
    asm volatile("s_waitcnt lgkmcnt(0)" ::: "memory"); SBAR();
#define PKV(Lx, Hx) (bf16x8){Lx[0], Lx[1], Lx[2], Lx[3], Hx[0], Hx[1], Hx[2], Hx[3]}
    od = __builtin_amdgcn_mfma_f32_32x32x16_bf16(pa0, PKV(l0, h0), od, 0, 0, 0);
    od = __builtin_amdgcn_mfma_f32_32x32x16_bf16(pa1, PKV(l1, h1), od, 0, 0, 0);
    od = __builtin_amdgcn_mfma_f32_32x32x16_bf16(pa2, PKV(l2, h2), od, 0, 0, 0);
    od = __builtin_amdgcn_mfma_f32_32x32x16_bf16(pa3, PKV(l3, h3), od, 0, 0, 0);
#undef PKV
}
__device__ __forceinline__ void softmax_p(f32x16& p0, f32x16& p1, float& m_reg, float& l_reg, f32x16 (&o)[4], bf16x8& pa0, bf16x8& pa1, bf16x8& pa2, bf16x8& pa3, LAS float* al, float C, int r32, int hi) {
    float pmax = p0[0];
#pragma unroll
    for (int r = 1; r < 16; ++r) pmax = fmaxf(pmax, p0[r]);
#pragma unroll
    for (int r = 0; r < 16; ++r) pmax = fmaxf(pmax, p1[r]);
    { auto rr = __builtin_amdgcn_permlane32_swap(__float_as_uint(pmax), __float_as_uint(pmax), false, false); pmax = fmaxf(__uint_as_float(rr[0]), __uint_as_float(rr[1])); }
    float mn = m_reg, alpha = 1.f; const bool resc = !__all((pmax - m_reg) * C <= 8.0f * 1.4426950408889634f);
    if (resc) { mn = fmaxf(m_reg, pmax); alpha = __builtin_amdgcn_exp2f((m_reg - mn) * C); m_reg = mn; }
    const float mnC = -mn * C;
    float ps = 0.f;
#pragma unroll
    for (int r = 0; r < 16; ++r) { p0[r] = __builtin_amdgcn_exp2f(fmaf(p0[r], C, mnC)); ps += p0[r]; }
#pragma unroll
    for (int r = 0; r < 16; ++r) { p1[r] = __builtin_amdgcn_exp2f(fmaf(p1[r], C, mnC)); ps += p1[r]; }
    { auto rr = __builtin_amdgcn_permlane32_swap(__float_as_uint(ps), __float_as_uint(ps), false, false); ps = __uint_as_float(rr[0]) + __uint_as_float(rr[1]); }
    l_reg = l_reg * alpha + ps;
    if (resc) { if (hi == 0) al[r32] = alpha; asm volatile("s_waitcnt lgkmcnt(0)" ::: "memory");
#pragma unroll
        for (int d = 0; d < 4; ++d)
#pragma unroll
            for (int r = 0; r < 16; ++r) o[d][r] *= al[crow(r, hi)];
    }
#define PK4(P, BASE, OUT) do { unsigned a0 = cvtpk(P[BASE + 0], P[BASE + 1]), a1 = cvtpk(P[BASE + 2], P[BASE + 3]);   \
    unsigned b0 = cvtpk(P[BASE + 4], P[BASE + 5]), b1 = cvtpk(P[BASE + 6], P[BASE + 7]);                              \
    auto r0 = __builtin_amdgcn_permlane32_swap(a0, b0, false, false); auto r1 = __builtin_amdgcn_permlane32_swap(a1, b1, false, false); \
    v4u w = {r0[0], r1[0], r0[1], r1[1]}; OUT = __builtin_bit_cast(bf16x8, w); } while (0)
    PK4(p0, 0, pa0); PK4(p0, 8, pa1); PK4(p1, 0, pa2); PK4(p1, 8, pa3);
#undef PK4
}
struct VF8 { s16x4 l0, h0, l1, h1, l2, h2, l3, h3; };
template <int D0> __device__ __forceinline__ void vf8_read(VF8& f, int vb) {
    f.l0 = tr_read<v_rd_off(D0, 0, 0)>(vb); f.h0 = tr_read<v_rd_off(D0, 0, 1)>(vb); f.l1 = tr_read<v_rd_off(D0, 1, 0)>(vb); f.h1 = tr_read<v_rd_off(D0, 1, 1)>(vb);
    f.l2 = tr_read<v_rd_off(D0, 2, 0)>(vb); f.h2 = tr_read<v_rd_off(D0, 2, 1)>(vb); f.l3 = tr_read<v_rd_off(D0, 3, 0)>(vb); f.h3 = tr_read<v_rd_off(D0, 3, 1)>(vb); }
__device__ __forceinline__ void vf8_mma(f32x16& od, const VF8& f, bf16x8 pa0, bf16x8 pa1, bf16x8 pa2, bf16x8 pa3) {
#define PKV(Lx, Hx) (bf16x8){Lx[0], Lx[1], Lx[2], Lx[3], Hx[0], Hx[1], Hx[2], Hx[3]}
    od = __builtin_amdgcn_mfma_f32_32x32x16_bf16(pa0, PKV(f.l0, f.h0), od, 0, 0, 0);
    od = __builtin_amdgcn_mfma_f32_32x32x16_bf16(pa1, PKV(f.l1, f.h1), od, 0, 0, 0);
    od = __builtin_amdgcn_mfma_f32_32x32x16_bf16(pa2, PKV(f.l2, f.h2), od, 0, 0, 0);
    od = __builtin_amdgcn_mfma_f32_32x32x16_bf16(pa3, PKV(f.l3, f.h3), od, 0, 0, 0);
#undef PKV
}
__device__ __forceinline__ void pv_all(f32x16 (&o)[4], int vb, bf16x8 pa0, bf16x8 pa1, bf16x8 pa2, bf16x8 pa3) {
    VF8 fa, fb;
    SBAR(); __builtin_amdgcn_s_setprio(1);
    vf8_read<0>(fa, vb); asm volatile("s_waitcnt lgkmcnt(0)" ::: "memory"); SBAR();
    vf8_read<1>(fb, vb); vf8_mma(o[0], fa, pa0, pa1, pa2, pa3); asm volatile("s_waitcnt lgkmcnt(0)" ::: "memory"); SBAR();
    vf8_read<2>(fa, vb); vf8_mma(o[1], fb, pa0, pa1, pa2, pa3); asm volatile("s_waitcnt lgkmcnt(0)" ::: "memory"); SBAR();
    vf8_read<3>(fb, vb); vf8_mma(o[2], fa, pa0, pa1, pa2, pa3); asm volatile("s_waitcnt lgkmcnt(0)" ::: "memory"); SBAR();
    vf8_mma(o[3], fb, pa0, pa1, pa2, pa3);
    __builtin_amdgcn_s_setprio(0);
}
__device__ __forceinline__ void softmax_pv(f32x16& p0, f32x16& p1, float& m_reg, float& l_reg, f32x16 (&o)[4], int vb, LAS float* al, float C, int r32, int hi) {
    bf16x8 pa0, pa1, pa2, pa3; softmax_p(p0, p1, m_reg, l_reg, o, pa0, pa1, pa2, pa3, al, C, r32, hi); pv_all(o, vb, pa0, pa1, pa2, pa3);
}
#define ATTN_STORE_O(ROWPTR_EXPR) do { if (hi == 0) al[r32] = l_reg; asm volatile("s_waitcnt lgkmcnt(0)" ::: "memory"); \
    _Pragma("unroll") for (int r = 0; r < 16; ++r) { const int qi = crow(r, hi); const float rl = __builtin_amdgcn_rcpf(al[qi]); bf16* op = (ROWPTR_EXPR); \
        _Pragma("unroll") for (int d0 = 0; d0 < 4; ++d0) op[d0 * 32 + r32] = (bf16)f2bf(o[d0][r] * rl); } } while (0)

constexpr int MLA_KB = 32768, MLA_VB = 16384, MLA_BUF = MLA_KB + MLA_VB;
__device__ __forceinline__ void mla_stage(const bf16* KV, const bf16* KR, int krow0, int head, LAS unsigned char* buf, int tid, int wave) {
#pragma unroll
    for (int i = 0; i < 4; ++i) { const int P = i * 512 + tid, row = P >> 5, c = (P & 31) ^ (row & 15);
        const bf16* src = c < 16 ? KV + (size_t)(krow0 + row) * KVC + head * 256 + c * 8 : KR + (size_t)(krow0 + row) * 64 + (c < 24 ? (c - 16) * 8 : 0);
        glds16(src, buf + (i * 512 + wave * 64) * 16); }
#pragma unroll
    for (int i = 0; i < 2; ++i) { const int P = (i * 512 + tid) * 16; int k, c; v_inv(P, k, c);
        glds16(KV + (size_t)(krow0 + k) * KVC + head * 256 + 128 + c, buf + MLA_KB + (i * 512 + wave * 64) * 16); }
}
struct MlaSrc { unsigned o[6]; unsigned kvm; };
__device__ __forceinline__ void mla_src_init(MlaSrc& s, const bf16* KV, const bf16* KR, int krow0, int head, int tid) {
    const unsigned dkr = (unsigned)((const char*)KR - (const char*)KV);
    s.kvm = 0u;
#pragma unroll
    for (int i = 0; i < 4; ++i) { const int P = i * 512 + tid, row = P >> 5, c = (P & 31) ^ (row & 15);
        s.o[i] = c < 16 ? (unsigned)(((krow0 + row) * KVC + head * 256 + c * 8) * 2) : dkr + (unsigned)(((krow0 + row) * 64 + (c < 24 ? (c - 16) * 8 : 0)) * 2); s.kvm |= (c < 16 ? 1u : 0u) << i; }
#pragma unroll
    for (int i = 0; i < 2; ++i) { const int P = (i * 512 + tid) * 16; int k, c; v_inv(P, k, c); s.o[4 + i] = (unsigned)(((krow0 + k) * KVC + head * 256 + 128 + c) * 2); }
}
__device__ __forceinline__ void mla_stage_adv(MlaSrc& s, const bf16* KV, LAS unsigned char* buf, int wave) {
#pragma unroll
    for (int i = 0; i < 4; ++i) { glds16((const char*)KV + s.o[i], buf + (i * 512 + wave * 64) * 16); s.o[i] += ((s.kvm >> i) & 1u) ? 64u * KVC * 2u : 64u * 64u * 2u; }
#pragma unroll
    for (int i = 0; i < 2; ++i) { glds16((const char*)KV + s.o[4 + i], buf + MLA_KB + (i * 512 + wave * 64) * 16); s.o[4 + i] += 64u * KVC * 2u; }
}
__device__ __forceinline__ void mla_unit(const bf16* Q, const bf16* KV, const bf16* KR, const float* gqn, const float* gqr, const GAS f32x2v* R64, bf16* O, int opitch, int row0  , int L, int head, int qb, LAS unsigned char* lds, int tid, int lane, int wave) {
    const int r32 = lane & 31, hi = lane >> 5; constexpr float C = 0.07216878364870322f * 1.4426950408889634f;
    LAS float* al = (LAS float*)(lds + WSCR_OFF + wave * 128);
    const int qrow = row0 + qb * 256 + wave * 32 + r32;
    __syncthreads();
    MlaSrc src; mla_src_init(src, KV, KR, row0, head, tid);
    mla_stage_adv(src, KV, lds, wave);
    bf16x8 qr[12];
    {   const bf16* qn_p = Q + (size_t)qrow * QC + head * 128 + hi * 8; const bf16* qr_p = Q + (size_t)qrow * QC + 1536 + head * 64 + hi * 8;
        float sn = 0.f, sr = 0.f;
#pragma unroll
        for (int d0 = 0; d0 < 12; ++d0) { float x[8]; unpack8(*(const GAS v4u*)(d0 < 8 ? qn_p + d0 * 16 : qr_p + (d0 - 8) * 16), x); float s = 0.f;
#pragma unroll
            for (int e = 0; e < 8; ++e) s += x[e] * x[e];
            if (d0 < 8) sn += s; else sr += s; }
        sn += __shfl_xor(sn, 32); sr += __shfl_xor(sr, 32);
        const float rn = 1.0f / sqrtf(sn * (1.0f / 128.0f) + EPS), rr = 1.0f / sqrtf(sr * (1.0f / 64.0f) + EPS);
#pragma unroll
        for (int d0 = 0; d0 < 8; ++d0) { float x[8], y[8]; unpack8(*(const GAS v4u*)(qn_p + d0 * 16), x); const GAS f32x4* gp = (const GAS f32x4*)(gqn + d0 * 16 + hi * 8); const f32x4 g0 = gp[0], g1 = gp[1];
            y[0] = x[0] * rn * g0.x; y[1] = x[1] * rn * g0.y; y[2] = x[2] * rn * g0.z; y[3] = x[3] * rn * g0.w; y[4] = x[4] * rn * g1.x; y[5] = x[5] * rn * g1.y; y[6] = x[6] * rn * g1.z; y[7] = x[7] * rn * g1.w;
            qr[d0] = __builtin_bit_cast(bf16x8, pack8(y)); asm volatile("" ::: "memory"); }
        const int pos = qb * 256 + wave * 32 + r32;
#pragma unroll
        for (int d0 = 0; d0 < 2; ++d0) {
            float x1[8], x2[8], y1[8], y2[8]; unpack8(*(const GAS v4u*)(qr_p + d0 * 16), x1); unpack8(*(const GAS v4u*)(qr_p + (d0 + 2) * 16), x2); const int i0 = d0 * 16 + hi * 8;
            const GAS f32x4* ct = (const GAS f32x4*)(R64 + pos * 32 + i0); const f32x4 c01 = ct[0], c23 = ct[1], c45 = ct[2], c67 = ct[3];
            const float cs[16] = {c01.x, c01.y, c01.z, c01.w, c23.x, c23.y, c23.z, c23.w, c45.x, c45.y, c45.z, c45.w, c67.x, c67.y, c67.z, c67.w};
#pragma unroll
            for (int e = 0; e < 8; ++e) { const float a = x1[e] * rr * gqr[i0 + e], b = x2[e] * rr * gqr[32 + i0 + e]; y1[e] = a * cs[2 * e] - b * cs[2 * e + 1]; y2[e] = b * cs[2 * e] + a * cs[2 * e + 1]; }
            qr[8 + d0] = __builtin_bit_cast(bf16x8, pack8(y1)); qr[10 + d0] = __builtin_bit_cast(bf16x8, pack8(y2)); asm volatile("" ::: "memory"); }
    }
    float m_reg = -1e30f, l_reg = 0.f; f32x16 o[4];
#pragma unroll
    for (int d = 0; d < 4; ++d) o[d] = (f32x16){0.f, 0.f, 0.f, 0.f, 0.f, 0.f, 0.f, 0.f, 0.f, 0.f, 0.f, 0.f, 0.f, 0.f, 0.f, 0.f};
    const int NT = L / 64;
#pragma unroll 1
    for (int j = 0; j < NT; ++j) {
        LAS unsigned char* cur = lds + (j & 1) * MLA_BUF;
        asm volatile("s_waitcnt vmcnt(0)" ::: "memory"); __syncthreads();
        if (j + 1 < NT) mla_stage_adv(src, KV, lds + ((j + 1) & 1) * MLA_BUF, wave);
        f32x16 p0 = (f32x16){0.f, 0.f, 0.f, 0.f, 0.f, 0.f, 0.f, 0.f, 0.f, 0.f, 0.f, 0.f, 0.f, 0.f, 0.f, 0.f}, p1 = p0;
        __builtin_amdgcn_s_setprio(1);
#pragma unroll
        for (int d0 = 0; d0 < 12; ++d0) { const int c = 2 * d0 + hi;
            const bf16x8 b0 = *(const LAS bf16x8*)(cur + r32 * 512 + ((c ^ (r32 & 15)) << 4));
            const bf16x8 b1 = *(const LAS bf16x8*)(cur + (32 + r32) * 512 + ((c ^ (r32 & 15)) << 4));
            p0 = __builtin_amdgcn_mfma_f32_32x32x16_bf16(b0, qr[d0], p0, 0, 0, 0);
            p1 = __builtin_amdgcn_mfma_f32_32x32x16_bf16(b1, qr[d0], p1, 0, 0, 0); }
        __builtin_amdgcn_s_setprio(0);
        softmax_pv(p0, p1, m_reg, l_reg, o, (int)(unsigned)(uintptr_t)(cur + MLA_KB) + v_rd_base(lane), al, C, r32, hi);
    }
    ATTN_STORE_O(O + (size_t)(row0 + qb * 256 + wave * 32 + qi) * opitch + head * 128);
}
__device__ __forceinline__ void mla_phase(const bf16* Q, const bf16* KV, const bf16* KR, const float* gqn, const float* gqr, const GAS f32x2v* R64, bf16* O, int opitch, LAS unsigned char* lds, int tid, int lane, int wave, int bid, int G) {
    const bool bal = (G == 256); const int x = bid & 7, li = bid >> 3;
    const int nS = bal ? (li < 16 ? 2 : 1) : (bid < 384 ? (384 - bid + G - 1) / G : 0), nP = bal ? (li < 16 ? 1 : 5) : (bid < 768 ? (768 - bid + G - 1) / G : 0);
#pragma unroll 1
    for (int i = 0; i < nS + nP; ++i) {
        int row0, L, head, qb;
        if (i < nS) { const int u = bal ? 48 * x + (li < 16 ? 2 * li + i : 16 + li) : bid + i * G; row0 = TP; L = 8192; head = u / 32; qb = u % 32; }
        else { const int k = i - nS, u = bal ? 96 * x + (li < 16 ? li : 16 + 5 * (li - 16) + k) : bid + k * G; row0 = (u / 96) * 2048; L = 2048; head = (u % 96) / 8; qb = u % 8; }
        mla_unit(Q, KV, KR, gqn, gqr, R64, O, opitch, row0, L, head, qb, lds, tid, lane, wave);
    }
}
__device__ __forceinline__ void dil_unit(const bf16* Z, bf16* O, int opitch, float* DLSE, int wu, LAS unsigned char* lds, int tid, int lane, int wave) {
    const int r32 = lane & 31, hi = lane >> 5, sub = wave >> 1, tl = tid & 127; constexpr float C = 0.08838834764831845f * 1.4426950408889634f;
    const int hd = wu % 12, quad = wu / 12, gb = quad * 4 + sub, grp = hd >> 2, dil = grp == 0 ? 1 : (grp == 1 ? 4 : 16);
    const int row0 = gb < 256 ? (gb >> 5) * 2048 : TP, L = gb < 256 ? 2048 : 8192, bi = gb < 256 ? (gb & 31) : gb - 256;
    const int res = bi % dil, blk = bi / dil, nblk = L / 64 / dil;
    LAS unsigned char* kb = lds + sub * 32768; LAS unsigned char* vbuf = kb + 16384;
    LAS float* al = (LAS float*)(lds + WSCR_OFF + wave * 128);
    const int qi_l = 32 * (wave & 1) + r32; const size_t qrow = (size_t)(row0 + (blk * 64 + qi_l) * dil + res);
    bf16x8 qr[8];
#pragma unroll
    for (int d0 = 0; d0 < 8; ++d0) qr[d0] = *(const GAS bf16x8*)(Z + qrow * ZC + Z_DQ + hd * 128 + d0 * 16 + hi * 8);
    float m_reg = -1e30f, l_reg = 0.f; f32x16 o[4];
#pragma unroll
    for (int d = 0; d < 4; ++d) o[d] = (f32x16){0.f, 0.f, 0.f, 0.f, 0.f, 0.f, 0.f, 0.f, 0.f, 0.f, 0.f, 0.f, 0.f, 0.f, 0.f, 0.f};
#pragma unroll 1
    for (int ti = 0; ti < 3; ++ti) {
        const int dt = ti == 0 ? 0 : (ti == 1 ? -1 : 1); const int kblk = blk + dt; const bool tvalid = kblk >= 0 && kblk < nblk; const int kbc = tvalid ? kblk : blk;
        __syncthreads();
#pragma unroll
        for (int i = 0; i < 8; ++i) { const int P = (i * 128 + tl) * 16, row = P >> 8, cb = (P & 255) ^ ((row & 7) << 4);
            glds16(Z + (size_t)(row0 + (kbc * 64 + row) * dil + res) * ZC + Z_DK + hd * 128 + (cb >> 1), kb + (i * 128 + (wave & 1) * 64) * 16); }
#pragma unroll
        for (int i = 0; i < 8; ++i) { const int P = (i * 128 + tl) * 16; int k, c; v_inv(P, k, c);
            glds16(Z + (size_t)(row0 + (kbc * 64 + k) * dil + res) * ZC + Z_DV + hd * 128 + c, vbuf + (i * 128 + (wave & 1) * 64) * 16); }
        asm volatile("s_waitcnt vmcnt(0)" ::: "memory"); __syncthreads();
        f32x16 p0 = (f32x16){0.f, 0.f, 0.f, 0.f, 0.f, 0.f, 0.f, 0.f, 0.f, 0.f, 0.f, 0.f, 0.f, 0.f, 0.f, 0.f}, p1 = p0;
#pragma unroll
        for (int d0 = 0; d0 < 8; ++d0) { const int cb = d0 * 32 + hi * 16;
            const bf16x8 b0 = *(const LAS bf16x8*)(kb + r32 * 256 + (cb ^ ((r32 & 7) << 4)));
            const bf16x8 b1 = *(const LAS bf16x8*)(kb + (32 + r32) * 256 + (cb ^ ((r32 & 7) << 4)));
            p0 = __builtin_amdgcn_mfma_f32_32x32x16_bf16(b0, qr[d0], p0, 0, 0, 0);
            p1 = __builtin_amdgcn_mfma_f32_32x32x16_bf16(b1, qr[d0], p1, 0, 0, 0); }
        if (ti != 0) {
#pragma unroll
            for (int r = 0; r < 16; ++r) { const int k0 = crow(r, hi), k1 = 32 + k0;
                const bool v0 = tvalid && (dt < 0 ? k0 >= qi_l : k0 <= qi_l), v1 = tvalid && (dt < 0 ? k1 >= qi_l : k1 <= qi_l);
                p0[r] = v0 ? p0[r] : -1e30f; p1[r] = v1 ? p1[r] : -1e30f; }
        }
        softmax_pv(p0, p1, m_reg, l_reg, o, (int)(unsigned)(uintptr_t)vbuf + v_rd_base(lane), al, C, r32, hi);
    }
    if (hi == 0) DLSE[(qrow) * 12 + hd] = m_reg * 0.08838834764831845f + logf(l_reg);
    __syncthreads();
    ATTN_STORE_O(O + (size_t)(row0 + (blk * 64 + 32 * (wave & 1) + qi) * dil + res) * opitch + hd * 128);
}
__device__ __forceinline__ void mixnorm_hyena(int tb, const bf16* YT, const float* gout, bf16* MX, LAS unsigned char* lds, int tid, int lane, int wave) {
    LAS float* ssq = (LAS float*)(lds);
    LAS float* rstd = (LAS float*)(lds + 2048);
    LAS bf16* tile = (LAS bf16*)(lds + 4096);
    const int c = tid >> 3, t8 = (tid & 7) * 8, m0 = tb * 64;
    v4u xw[16];
#pragma unroll
    for (int ck = 0; ck < 16; ++ck) xw[ck] = *(const GAS v4u*)(YT + (size_t)(ck * 64 + c) * TT + m0 + t8);
    __syncthreads();
    float ps[8];
#pragma unroll
    for (int e = 0; e < 8; ++e) ps[e] = 0.f;
#pragma unroll
    for (int ck = 0; ck < 16; ++ck) { float x[8]; unpack8(xw[ck], x);
#pragma unroll
        for (int e = 0; e < 8; ++e) ps[e] += x[e] * x[e]; }
#pragma unroll
    for (int e = 0; e < 8; ++e) { ps[e] += __shfl_xor(ps[e], 8); ps[e] += __shfl_xor(ps[e], 16); ps[e] += __shfl_xor(ps[e], 32); }
    if (lane < 8) {
#pragma unroll
        for (int e = 0; e < 8; ++e) ssq[wave * 64 + lane * 8 + e] = ps[e]; }
    __syncthreads();
    if (tid < 64) { float s = 0.f;
#pragma unroll
        for (int w = 0; w < 8; ++w) s += ssq[w * 64 + tid];
        rstd[tid] = 1.0f / sqrtf(s * (1.0f / 1024.0f) + EPS); }
    __syncthreads();
    float rt[8];
#pragma unroll
    for (int e = 0; e < 8; ++e) rt[e] = rstd[t8 + e];
#pragma unroll
    for (int half = 0; half < 2; ++half) {
#pragma unroll
        for (int k = 0; k < 8; ++k) { const int ck = half * 8 + k; float x[8]; unpack8(xw[ck], x); const float gg = gout[ck * 64 + c];
#pragma unroll
            for (int e = 0; e < 8; ++e) tile[k * (64 * 66) + c * 66 + t8 + e] = (bf16)f2bf(x[e] * rt[e] * gg); }
        __syncthreads();
        { const int t = tid >> 3, c8 = (tid & 7) * 8;
#pragma unroll
          for (int k = 0; k < 8; ++k) { const LAS bf16* tk = tile + k * (64 * 66); v4u w;
              w.x = (unsigned)tk[(c8 + 0) * 66 + t] | ((unsigned)tk[(c8 + 1) * 66 + t] << 16); w.y = (unsigned)tk[(c8 + 2) * 66 + t] | ((unsigned)tk[(c8 + 3) * 66 + t] << 16);
              w.z = (unsigned)tk[(c8 + 4) * 66 + t] | ((unsigned)tk[(c8 + 5) * 66 + t] << 16); w.w = (unsigned)tk[(c8 + 6) * 66 + t] | ((unsigned)tk[(c8 + 7) * 66 + t] << 16);
              *(GAS v4u*)(MX + (size_t)(m0 + t) * DM + (half * 8 + k) * 64 + c8) = w; } }
        __syncthreads();
    }
}
__device__ __forceinline__ void mixnorm_tokens(const bf16* Q, const bf16* Z, const float* DLSE, const float* gout, bf16* MX, int gw, int NGW, int lane) {
    for (int m = gw; m < TT; m += NGW) {
        v4u qw[3], zw[3];
#pragma unroll
        for (int j = 0; j < 3; ++j) { qw[j] = *(const GAS v4u*)(Q + (size_t)m * QC + lane * 8 + 512 * j); zw[j] = *(const GAS v4u*)(Z + (size_t)m * ZC + Z_DQ + lane * 8 + 512 * j); }
        {   float x[3][8]; float s = 0.f;
#pragma unroll
            for (int j = 0; j < 3; ++j) { unpack8(qw[j], x[j]);
#pragma unroll
                for (int e = 0; e < 8; ++e) s += x[j][e] * x[j][e]; }
            const float rs = 1.0f / sqrtf(wave_sum(s) * (1.0f / 1536.0f) + EPS);
#pragma unroll
            for (int j = 0; j < 3; ++j) { const int cc = lane * 8 + 512 * j; float y[8];
#pragma unroll
                for (int e = 0; e < 8; ++e) y[e] = x[j][e] * rs * gout[1024 + cc + e];
                *(GAS v4u*)(MX + (size_t)m * DM + 1024 + cc) = pack8(y); }
        }
        {   float x[3][8]; float s = 0.f;
#pragma unroll
            for (int j = 0; j < 3; ++j) { const int cc = lane * 8 + 512 * j, hd = cc >> 7, slot = hd & 3;
                const float l0 = DLSE[(size_t)m * 12 + slot], l1 = DLSE[(size_t)m * 12 + 4 + slot], l2 = DLSE[(size_t)m * 12 + 8 + slot], lm = fmaxf(l0, fmaxf(l1, l2));
                const float e0 = expf(l0 - lm), e1 = expf(l1 - lm), e2 = expf(l2 - lm), mine = (hd >> 2) == 0 ? e0 : ((hd >> 2) == 1 ? e1 : e2), alpha = mine / (e0 + e1 + e2);
                unpack8(zw[j], x[j]);
#pragma unroll
                for (int e = 0; e < 8; ++e) { x[j][e] *= alpha; s += x[j][e] * x[j][e]; } }
            const float rs = 1.0f / sqrtf(wave_sum(s) * (1.0f / 1536.0f) + EPS);
#pragma unroll
            for (int j = 0; j < 3; ++j) { const int cc = lane * 8 + 512 * j; float y[8];
#pragma unroll
                for (int e = 0; e < 8; ++e) y[e] = x[j][e] * rs * gout[2560 + cc + e];
                *(GAS v4u*)(MX + (size_t)m * DM + 2560 + cc) = pack8(y); }
        }
    }
}
#ifndef MK_N_LAUNCHES
#define MK_N_LAUNCHES 1
#endif
struct Args { const float* in[31]; float* out; unsigned char* ws; int ph_lo, ph_hi, li, pad; };
__global__ void __launch_bounds__(NWAVES * 64, 2) fwd(Args args) {
    extern __shared__ __attribute__((aligned(16))) unsigned char lds_raw[];
    LAS unsigned char* lds = (LAS unsigned char*)lds_raw;
    const int tid = threadIdx.x, wave = __builtin_amdgcn_readfirstlane(tid >> 6), G = gridDim.x, bid = blockIdx.x;
    const int NGW = G * NWAVES, NGT = G * NWAVES * 64;
    for (int u = tid; u < (PTAB_OFF - LDSCTL_OFF) / 4; u += NWAVES * 64) ((LAS unsigned*)(lds + LDSCTL_OFF))[u] = 0u;
    __syncthreads();
    const int lo = args.ph_lo, hi = args.ph_hi;
    XcdBarrier bar; bar.bar = (unsigned*)(args.ws + WS_CTL) + CW_BAR; bar.x = 0; bar.st = nullptr;
    if (hi - lo > 1) bar = xcd_barrier_post((unsigned*)(args.ws + WS_CTL) + CW_BAR, (volatile LAS unsigned*)(lds + MISC_OFF) + 8);
#define IN(k) (lo <= (k) && (k) < hi)
#define SEAM(k) do { if (IN(k) && IN((k) + 1)) xcd_barrier(bar); } while (0)
#define OPQ() int tid_ = tid, wave_ = wave; asm volatile("" : "+v"(tid_), "+s"(wave_)); tid_ &= 511; wave_ &= 7; const InTab in_{args.in}; unsigned char* const ws_ = args.ws; float* const out_ = args.out; (void)ws_; (void)out_; \
    const int lane_ = tid_ & 63, gw_ = bid * NWAVES + wave_, gt_ = bid * (NWAVES * 64) + tid_; (void)lane_; (void)gw_; (void)gt_
#define P_MIX ((bf16*)(ws_ + WS_MIX))
#define P_Z ((bf16*)(ws_ + WS_Z))
#define P_Q ((bf16*)(ws_ + WS_Q))
#define P_KV ((bf16*)(ws_ + WS_KV))
#define P_UT ((bf16*)(ws_ + WS_UT))
#define P_A2 ((bf16*)(ws_ + WS_A2))
#define P_CQ ((bf16*)(ws_ + WS_CQ))
#define P_CKV ((bf16*)(ws_ + WS_CKV))
#define P_KR ((bf16*)(ws_ + WS_KR))
#define P_X0T ((bf16*)(ws_ + WS_X0T))
#define P_YT ((bf16*)(ws_ + WS_YT))
#define P_DLSE ((float*)(ws_ + WS_DLSE))
#define P_XP (in_[0])
#define P_XS (in_[1] - (size_t)TP * DM)
#define P_WL (ws_ + WS_WT + (size_t)l * WT_LAYER)
#define P_XB ((bf16*)(ws_ + WS_XB))
#define P_SSQ(i) ((float*)(ws_ + WS_SSQ) + (size_t)(i) * TT)
#define P_SSQP ((float*)(ws_ + WS_SSQP))

    if (IN(0)) {
        OPQ();
        for (int it = bid; it < NLAYER * 160; it += G) { const int layer = it / 160, r = it % 160; filter_item(in_, ws_, layer, r >= 32 ? 1 : 0, r >= 32 ? r - 32 : r, lds, tid_, lane_, wave_); }
        p0_weights(in_, ws_, (LAS float*)(lds + wave_ * 16384), gw_, NGW, lane_);
        p0_misc(ws_, gt_, NGT);
        cvt_rows(P_XP, P_XS, P_XB, P_SSQ(0), gw_, NGW, lane_);
    }
    SEAM(0);
#pragma unroll 1
    for (int l = 0; l < NLAYER; ++l) {
        const int pb = 1 + l * NPH_LAYER;
        if (IN(pb + 0)) {
            OPQ(); pg8::Gemm g{P_XB, (const bf16*)(P_WL + WT_IN), TT, ZC, DM}; pg8::StaticOrder S; S.init(TT, ZC, G, bid);
            pg8::EpiInProj E{P_Z, ZC, P_SSQ(2 * l), in_[24] + l * 128, in_[25] + l * 128, (const float*)(ws_ + WS_R128), (LAS float*)(lds + KVTAB_OFF)};
            pg8::gemm_phase<pg8::EpiInProj, pg8::StaticOrder, true, true>(lds, g, S, E);
        }
        SEAM(pb + 0);
        if (IN(pb + 1)) {
            OPQ();
            prep_hyena(P_Z, in_[4] + (size_t)l * 3 * 3072, in_[5] + (size_t)l * 3072, P_UT, P_X0T, lds, tid_, bid, G);
            prep_tokens(P_Z, in_, l, ws_, gw_, NGW, lane_);
        }
        SEAM(pb + 1);
        if (IN(pb + 2)) {
            { OPQ(); pg8::Gemm g{P_CQ, (const bf16*)(P_WL + WT_QB), TT, QC, 1536}; pg8::StaticOrder S; S.init(TT, QC, G, bid); pg8::EpiBf16<0> E{P_Q, QC, nullptr};
              pg8::gemm_phase<pg8::EpiBf16<0>, pg8::StaticOrder, true, true>(lds, g, S, E); }
            { OPQ(); pg8::Gemm g{P_CKV, (const bf16*)(P_WL + WT_KVB), TT, KVC, 512}; pg8::StaticOrder S; S.init(TT, KVC, G, (bid + (G >> 1)) % G);     pg8::EpiKv E{P_KV, KVC, in_[22] + l * 128, (LAS float*)(lds + KVTAB_OFF)};
              pg8::gemm_phase<pg8::EpiKv, pg8::StaticOrder, true, true>(lds, g, S, E); }
            { OPQ(); const unsigned char* fl = ws_ + WS_FILT + (size_t)l * FILT_LAYER;
              v4u upre[4] = {{0u, 0u, 0u, 0u}, {0u, 0u, 0u, 0u}, {0u, 0u, 0u, 0u}, {0u, 0u, 0u, 0u}}; bool pv = false;
              for (int u = bid; u < 2048; u += G) {
                  const int c = u & 1023; const float skip = in_[15][l * 1024 + c];
                  const int un = u + G; const bf16* nxt = un < 2048 ? P_UT + (size_t)(un & 1023) * TT + (un >= 1024 ? TP : 0) : nullptr; const int nnp = un >= 1024 ? 2 : 4;
                  if (u < 1024) conv_unit<0>(c, (const bf16*)fl + (size_t)c * 4096, P_UT, P_X0T, P_YT, skip, lds, tid_, lane_, wave_, upre, pv, nxt, nnp);
                  else conv_unit<1>(c, (const bf16*)(fl + FILT_S_OFF) + (size_t)c * 16384, P_UT, P_X0T, P_YT, skip, lds, tid_, lane_, wave_, upre, pv, nxt, nnp);
                  pv = nxt != nullptr;
              } }
            { OPQ(); for (int wu = (bid + (G >> 1)) % G; wu < 1152; wu += G) dil_unit(P_Z, P_Z + Z_DQ, ZC, P_DLSE, wu, lds, tid_, lane_, wave_); }
        }
        SEAM(pb + 2);
        if (IN(pb + 3)) { OPQ(); mla_phase(P_Q, P_KV, P_KR, in_[20] + l * 128, in_[21] + l * 64, (const GAS f32x2v*)(ws_ + WS_R64), P_Q, QC, lds, tid_, lane_, wave_, bid, G); }
        SEAM(pb + 3);
        if (IN(pb + 4)) { OPQ(); for (int tb = bid; tb < 384; tb += G) mixnorm_hyena(tb, P_YT, in_[26] + (size_t)l * DM, P_MIX, lds, tid_, lane_, wave_);
            mixnorm_tokens(P_Q, P_Z, P_DLSE, in_[26] + (size_t)l * DM, P_MIX, gw_, NGW, lane_); }
        SEAM(pb + 4);
        if (IN(pb + 5)) {
            OPQ(); pg8::Gemm g{P_MIX, (const bf16*)(P_WL + WT_OUT), TT, DM, DM}; pg8::StaticOrder S; S.init(TT, DM, G, bid);
            { pg8::EpiRes<false, false> E{nullptr, nullptr, 0, P_XB, P_SSQP, nullptr, (LAS float*)(lds + KVTAB_OFF)}; pg8::gemm_phase<pg8::EpiRes<false, false>, pg8::StaticOrder, true, true>(lds, g, S, E); }
        }
        SEAM(pb + 5);
        if (IN(pb + 7)) {
            OPQ(); pg8::Gemm g{P_XB, (const bf16*)(P_WL + WT_UP), TT, DFF, DM}; pg8::StaticOrder S; S.init(TT, DFF, G, bid);
            int pm0 = -1, pm1 = -1, pm2 = -1;
            { pg8::Unit uu; for (int i = 0; S.next(i, uu); ++i) { if (pm0 < 0) pm0 = uu.pm; else if (uu.pm != pm0 && pm1 < 0) pm1 = uu.pm; else if (uu.pm != pm0 && uu.pm != pm1 && pm2 < 0) pm2 = uu.pm; } }
            LAS float* rt = (LAS float*)(lds + KVTAB_OFF);
            __syncthreads();
            for (int rr = tid_; rr < 768; rr += 512) { const int pmx = rr < 256 ? pm0 : (rr < 512 ? pm1 : pm2);
                if (pmx >= 0) { const int m = pmx * 256 + (rr & 255); const GAS f32x4* p = (const GAS f32x4*)(P_SSQP + (size_t)m * 16); const f32x4 a = p[0], b = p[1], c = p[2], d = p[3];
                    const float s = (((a.x + a.y) + (a.z + a.w)) + ((b.x + b.y) + (b.z + b.w))) + (((c.x + c.y) + (c.z + c.w)) + ((d.x + d.y) + (d.z + d.w)));
                    rt[rr] = 1.0f / sqrtf(s * (1.0f / DM) + EPS); } }
            if (tid_ == 0) { ((LAS int*)rt)[768] = pm0; ((LAS int*)rt)[769] = pm1; }
            __syncthreads();
            pg8::EpiBf16L<1> E{P_A2, DFF, rt};
            pg8::gemm_phase<pg8::EpiBf16L<1>, pg8::StaticOrder, true, true>(lds, g, S, E);
        }
        SEAM(pb + 7);
        if (IN(pb + 8)) {
            OPQ(); pg8::Gemm g{P_A2, (const bf16*)(P_WL + WT_DN), TT, DM, DFF}; pg8::StaticOrder S; S.init(TT, DM, G, bid);
            if (l + 1 < NLAYER) { pg8::EpiRes<false, false> E{nullptr, nullptr, 0, P_XB, P_SSQP, nullptr, (LAS float*)(lds + KVTAB_OFF)}; pg8::gemm_phase<pg8::EpiRes<false, false>, pg8::StaticOrder, true, true>(lds, g, S, E); }
            else { pg8::EpiRes<false, true> E{nullptr, nullptr, 0, P_XB, nullptr, out_, (LAS float*)(lds + KVTAB_OFF)}; pg8::gemm_phase<pg8::EpiRes<false, true>, pg8::StaticOrder, true, true>(lds, g, S, E); }
        }
        if (l + 1 < NLAYER) SEAM(pb + 8);
        if (IN(pb + 9) && l + 1 < NLAYER) { OPQ(); rstd_rows(P_SSQP, P_SSQ(2 * l + 2), gt_, NGT); }
        SEAM(pb + 9);
    }
#undef IN
#undef SEAM
}

extern "C" void kernel_launch(void* const* d_in, const int* in_sizes, int n_in, void* d_out, int out_size, void* d_ws, size_t ws_size, hipStream_t stream) {
    static int grid = 0;
    if (grid == 0) {
        if (n_in != 31 || in_sizes[0] != TP * DM || in_sizes[1] != TS * DM || out_size != TT * DM || ws_size < WS_END) {
            fprintf(stderr, "kernel_launch: shape mismatch: n_in %d in0 %d in1 %d out %d ws %zu (need >= %zu); nothing launched\n", n_in, n_in > 0 ? in_sizes[0] : -1, n_in > 1 ? in_sizes[1] : -1, out_size, ws_size, (size_t)WS_END); grid = -1; return; }
        int dev = 0, cus = 0, per_cu = 0;
        if (hipGetDevice(&dev) != hipSuccess || hipDeviceGetAttribute(&cus, hipDeviceAttributeMultiprocessorCount, dev) != hipSuccess) { fprintf(stderr, "kernel_launch: device query failed\n"); grid = -1; return; }
        if (hipFuncSetAttribute((const void*)fwd, hipFuncAttributeMaxDynamicSharedMemorySize, LDS_BYTES) != hipSuccess) { fprintf(stderr, "kernel_launch: hipFuncSetAttribute failed\n"); grid = -1; return; }
        if (hipOccupancyMaxActiveBlocksPerMultiprocessor(&per_cu, (const void*)fwd, NWAVES * 64, LDS_BYTES) != hipSuccess || per_cu < 1) fprintf(stderr, "kernel_launch: occupancy query says %d\n", per_cu);
        (void)hipGetLastError();
        grid = cus;
    }
    if (grid < 0) return;
    if (hipMemsetAsync((char*)d_ws + WS_CTL, 0, CTL_ZERO_BYTES, stream) != hipSuccess) { fprintf(stderr, "kernel_launch: memset failed\n"); return; }
    Args a{};
    for (int i = 0; i < 31; ++i) a.in[i] = (const float*)d_in[i];
    a.out = (float*)d_out; a.ws = (unsigned char*)d_ws;
    if (MK_N_LAUNCHES == 1) { a.ph_lo = 0; a.ph_hi = NPHASES; a.li = 0; hipLaunchKernelGGL(fwd, dim3(grid), dim3(NWAVES * 64), LDS_BYTES, stream, a); }
    else for (int p = 0; p < NPHASES; ++p) { a.ph_lo = p; a.ph_hi = p + 1; a.li = p; hipLaunchKernelGGL(fwd, dim3(grid), dim3(NWAVES * 64), LDS_BYTES, stream, a); }
    const hipError_t le = hipPeekAtLastError();
    if (le != hipSuccess) fprintf(stderr, "kernel_launch: launch failed: %s\n", hipGetErrorName(le));
}
```

```cpp
#include <hip/hip_runtime.h>
#include <cstdio>
#include <cstdint>
#define MK_N_LAUNCHES 1
namespace pg8 {
#define PG8_LAS __attribute__((address_space(3)))
typedef unsigned short bf16_t;
typedef short bf16x8 __attribute__((ext_vector_type(8)));
typedef float f32x4 __attribute__((ext_vector_type(4)));
typedef unsigned u32x4 __attribute__((ext_vector_type(4)));
constexpr int BM = 256, BK = 64, HALF = 128, HTB = HALF * BK * 2  , STAGE_BYTES = 8 * HTB, NXCD = 8, WGM = 8;

__host__ __device__ __forceinline__ int lds_byte(int r, int c) { const int st = (r >> 4) * 2 + (c >> 5), rr = r & 15, cc = c & 31, ob = rr * 64 + cc * 2; return st * 1024 + (ob ^ (((ob >> 9) & 1) << 5)); }
__host__ __device__ __forceinline__ void stage_rc(int b, int& R, int& C) { const int st = b / 1024, sb = b % 1024, swz = sb ^ (((sb >> 9) & 1) << 5); R = (st >> 1) * 16 + swz / 64; C = (st & 1) * 32 + (swz % 64) / 2; }
__host__ __device__ __forceinline__ int perm32(int rho) { const int n = rho >> 4, i = rho & 15; return 8 * (i >> 2) + 4 * n + (i & 3); }

struct Unit { int pm, pn; };
struct Gemm { const bf16_t* A; const bf16_t* Bt; int M, N, K; };

struct StaticOrder {
    int nM, nN, nwg, G, c;
    __host__ __device__ void init(int M, int N, int G_, int c_) { nM = M / BM; nN = N / BM; nwg = nM * nN; G = G_; c = c_; }
    __host__ __device__ bool next(int i, Unit& u) const {
        const long L = (long)i * G + c; if (L >= nwg) return false;
        int wgid = (int)L; { const int q = nwg / NXCD, r = nwg % NXCD, xcd = wgid % NXCD, off = wgid / NXCD; wgid = (xcd < r ? xcd * (q + 1) : r * (q + 1) + (xcd - r) * q) + off; }
        const int nig = WGM * nN, gid = wgid / nig, fm = gid * WGM, gsz = (nM - fm) < WGM ? (nM - fm) : WGM;
        u.pm = fm + ((wgid % nig) % gsz); u.pn = (wgid % nig) / gsz; return true;
    }
    __device__ __forceinline__ void a_ready(const Unit&) const {}
    __device__ __forceinline__ void done(const Unit&) const {}
};

__device__ __forceinline__ unsigned cvt_pk_bf16(float lo, float hi) { unsigned r; asm volatile("v_cvt_pk_bf16_f32 %0, %1, %2" : "=v"(r) : "v"(lo), "v"(hi)); return r; }
typedef float f32x2 __attribute__((ext_vector_type(2)));
#ifndef EPI_NT
#define EPI_NT 0
#endif
template <int ACT  > struct EpiBf16 {
    static constexpr bool PERM = true, AFTER_DRAIN = false;
    bf16_t* O; int ldc; const float* ssq;
    __device__ __forceinline__ void operator()(const f32x4 (&acc)[2][2][4][2], const Unit& u, int wr, int wc, int fr, int fq) const {
        const int row0 = u.pm * BM + wr * 64 + fr, col0 = u.pn * BM + wc * 32 + 8 * fq;
        float rs[2][4];
#pragma unroll
        for (int ai = 0; ai < 2; ++ai)
#pragma unroll
            for (int m = 0; m < 4; ++m) rs[ai][m] = ssq ? ssq[row0 + ai * HALF + m * 16] : 1.0f;
#pragma unroll
        for (int ai = 0; ai < 2; ++ai)
#pragma unroll
            for (int m = 0; m < 4; ++m) { bf16_t* rowp = O + (size_t)(row0 + ai * HALF + m * 16) * ldc + col0;
#pragma unroll
                for (int bj = 0; bj < 2; ++bj) { f32x4 v0 = acc[ai][bj][m][0] * rs[ai][m], v1 = acc[ai][bj][m][1] * rs[ai][m];
                    if (ACT == 1) {
#pragma unroll
                        for (int j = 0; j < 4; ++j) { const float a = fmaxf(v0[j], 0.f), b = fmaxf(v1[j], 0.f); v0[j] = a * a; v1[j] = b * b; } }
                    u32x4 w; w.x = cvt_pk_bf16(v0[0], v0[1]); w.y = cvt_pk_bf16(v0[2], v0[3]); w.z = cvt_pk_bf16(v1[0], v1[1]); w.w = cvt_pk_bf16(v1[2], v1[3]);
                    if (EPI_NT) __builtin_nontemporal_store(w, (u32x4*)(rowp + bj * HALF)); else *(u32x4*)(rowp + bj * HALF) = w; } }
    }
};
template <bool RES32, bool OUT32> struct EpiRes {
    static constexpr bool PERM = false, AFTER_DRAIN = false;
    const float* r0; const float* r1; int pm_split; bf16_t* xb; float* ssq  ; float* out; PG8_LAS float* tab  ;
    __device__ __forceinline__ void operator()(const f32x4 (&acc)[2][2][4][2], const Unit& u, int wr, int wc, int fr, int fq) const {
        typedef unsigned u32x2e __attribute__((ext_vector_type(2)));
        const int row0 = u.pm * BM + wr * 64 + fr, col0 = u.pn * BM + wc * 32 + 4 * fq;
        const float* rb = (u.pm < pm_split) ? r0 : r1;
#pragma unroll
        for (int ai = 0; ai < 2; ++ai)
#pragma unroll
            for (int m = 0; m < 4; ++m) { const size_t off = (size_t)(row0 + ai * HALF + m * 16) * 4096 + col0;
                f32x4 x[2][2];
#pragma unroll
                for (int bj = 0; bj < 2; ++bj)
#pragma unroll
                    for (int n = 0; n < 2; ++n) {
                        if (RES32) x[bj][n] = *(const f32x4*)(rb + off + bj * HALF + n * 16);
                        else { const u32x2e w = *(const u32x2e*)(xb + off + bj * HALF + n * 16); x[bj][n] = (f32x4){__uint_as_float(w.x << 16), __uint_as_float(w.x & 0xffff0000u), __uint_as_float(w.y << 16), __uint_as_float(w.y & 0xffff0000u)}; } }
                float sq = 0.f;
#pragma unroll
                for (int bj = 0; bj < 2; ++bj)
#pragma unroll
                    for (int n = 0; n < 2; ++n) { const f32x4 v = x[bj][n] + acc[ai][bj][m][n];
                        if (OUT32) *(f32x4*)(out + off + bj * HALF + n * 16) = v;
                        else { sq += (v[0] * v[0] + v[1] * v[1]) + (v[2] * v[2] + v[3] * v[3]); u32x2e w; w.x = cvt_pk_bf16(v[0], v[1]); w.y = cvt_pk_bf16(v[2], v[3]); *(u32x2e*)(xb + off + bj * HALF + n * 16) = w; } }
                if (!OUT32) { sq += __shfl_xor(sq, 16); sq += __shfl_xor(sq, 32); if (fq == 0) tab[(ai * HALF + wr * 64 + m * 16 + fr) * 4 + wc] = sq; }
                asm volatile("" ::: "memory"); }
        if (!OUT32) {
            asm volatile("s_waitcnt lgkmcnt(0)" ::: "memory"); __builtin_amdgcn_s_barrier(); asm volatile("" ::: "memory");
            const int t = (wr * 4 + wc) * 64 + fq * 16 + fr;
            if (t < 256) { const f32x4 p = *(const PG8_LAS f32x4*)(tab + t * 4); ssq[(size_t)(u.pm * BM + t) * 16 + u.pn] = (p[0] + p[1]) + (p[2] + p[3]); }
        }
    }
};

struct EpiKv {
    static constexpr bool PERM = true, AFTER_DRAIN = false;
    bf16_t* O; int ldc; const float* gain; PG8_LAS float* tab;
    __device__ __forceinline__ void operator()(const f32x4 (&acc)[2][2][4][2], const Unit& u, int wr, int wc, int fr, int fq) const {
        const int row0 = u.pm * BM + wr * 64 + fr, col0 = u.pn * BM + wc * 32 + 8 * fq;
#pragma unroll
        for (int ai = 0; ai < 2; ++ai)
#pragma unroll
            for (int m = 0; m < 4; ++m) { const f32x4 a = acc[ai][0][m][0], b = acc[ai][0][m][1]; float s = (a[0] * a[0] + a[1] * a[1]) + (a[2] * a[2] + a[3] * a[3]) + (b[0] * b[0] + b[1] * b[1]) + (b[2] * b[2] + b[3] * b[3]);
                s += __shfl_xor(s, 16); s += __shfl_xor(s, 32);
                if (fq == 0) tab[(ai * HALF + wr * 64 + m * 16 + fr) * 4 + wc] = s; }
        asm volatile("s_waitcnt lgkmcnt(0)" ::: "memory"); __builtin_amdgcn_s_barrier(); asm volatile("" ::: "memory");
        const f32x4 g0 = *(const f32x4*)(gain + wc * 32 + 8 * fq), g1 = *(const f32x4*)(gain + wc * 32 + 8 * fq + 4);
#pragma unroll
        for (int ai = 0; ai < 2; ++ai)
#pragma unroll
            for (int m = 0; m < 4; ++m) { bf16_t* rowp = O + (size_t)(row0 + ai * HALF + m * 16) * ldc + col0;
                const f32x4 t = *(const PG8_LAS f32x4*)(tab + (ai * HALF + wr * 64 + m * 16 + fr) * 4); const float rs = 1.0f / sqrtf(((t[0] + t[1]) + (t[2] + t[3])) * (1.0f / 128.0f) + 1e-6f);
                { const f32x4 v0 = acc[ai][0][m][0] * rs * g0, v1 = acc[ai][0][m][1] * rs * g1; u32x4 w; w.x = cvt_pk_bf16(v0[0], v0[1]); w.y = cvt_pk_bf16(v0[2], v0[3]); w.z = cvt_pk_bf16(v1[0], v1[1]); w.w = cvt_pk_bf16(v1[2], v1[3]); *(u32x4*)rowp = w; }
                { const f32x4 v0 = acc[ai][1][m][0], v1 = acc[ai][1][m][1]; u32x4 w; w.x = cvt_pk_bf16(v0[0], v0[1]); w.y = cvt_pk_bf16(v0[2], v0[3]); w.z = cvt_pk_bf16(v1[0], v1[1]); w.w = cvt_pk_bf16(v1[2], v1[3]); *(u32x4*)(rowp + HALF) = w; } }
    }
};

struct EpiInProj {
    static constexpr bool PERM = true, AFTER_DRAIN = false;
    bf16_t* O; int ldc; const float* ssq; const float* gq; const float* gk; const float* rope  ; PG8_LAS float* tab;
    __device__ __forceinline__ void operator()(const f32x4 (&acc)[2][2][4][2], const Unit& u, int wr, int wc, int fr, int fq) const {
        const int row0 = u.pm * BM + wr * 64 + fr, col0 = u.pn * BM + wc * 32 + 8 * fq;
        if (u.pn >= 21 && u.pn < 33) {
#pragma unroll
            for (int ai = 0; ai < 2; ++ai)
#pragma unroll
                for (int m = 0; m < 4; ++m)
#pragma unroll
                    for (int bj = 0; bj < 2; ++bj) { const f32x4 a = acc[ai][bj][m][0], b = acc[ai][bj][m][1]; float s = (a[0] * a[0] + a[1] * a[1]) + (a[2] * a[2] + a[3] * a[3]) + (b[0] * b[0] + b[1] * b[1]) + (b[2] * b[2] + b[3] * b[3]);
                        s += __shfl_xor(s, 16); s += __shfl_xor(s, 32);
                        if (fq == 0) tab[((ai * HALF + wr * 64 + m * 16 + fr) * 2 + bj) * 4 + wc] = s; }
            asm volatile("s_waitcnt lgkmcnt(0)" ::: "memory"); __builtin_amdgcn_s_barrier(); asm volatile("" ::: "memory");
            const float* gg = u.pn < 27 ? gq : gk; const int i0 = 16 * wc + 4 * fq;
            const f32x4 g1 = *(const f32x4*)(gg + i0), g2 = *(const f32x4*)(gg + 64 + i0);
#pragma unroll
            for (int ai = 0; ai < 2; ++ai)
#pragma unroll
                for (int m = 0; m < 4; ++m) { const int row = row0 + ai * HALF + m * 16, pos = row < 16384 ? (row & 2047) : row - 16384; bf16_t* rowp = O + (size_t)row * ldc + col0;
                    const f32x4 cs0 = *(const f32x4*)(rope + (size_t)(pos * 64 + i0) * 2), cs1 = *(const f32x4*)(rope + (size_t)(pos * 64 + i0) * 2 + 4);
#pragma unroll
                    for (int bj = 0; bj < 2; ++bj) { const f32x4 t = *(const PG8_LAS f32x4*)(tab + ((ai * HALF + wr * 64 + m * 16 + fr) * 2 + bj) * 4); const float rs = 1.0f / sqrtf(((t[0] + t[1]) + (t[2] + t[3])) * (1.0f / 128.0f) + 1e-6f);
                        const f32x4 v0 = acc[ai][bj][m][0], v1 = acc[ai][bj][m][1];
                        const float a0 = v0[0] * rs * g1[0], b0 = v0[1] * rs * g2[0], a1 = v0[2] * rs * g1[1], b1 = v0[3] * rs * g2[1], a2 = v1[0] * rs * g1[2], b2 = v1[1] * rs * g2[2], a3 = v1[2] * rs * g1[3], b3 = v1[3] * rs * g2[3];
                        u32x4 w; w.x = cvt_pk_bf16(a0 * cs0[0] - b0 * cs0[1], b0 * cs0[0] + a0 * cs0[1]); w.y = cvt_pk_bf16(a1 * cs0[2] - b1 * cs0[3], b1 * cs0[2] + a1 * cs0[3]);
                        w.z = cvt_pk_bf16(a2 * cs1[0] - b2 * cs1[1], b2 * cs1[0] + a2 * cs1[1]); w.w = cvt_pk_bf16(a3 * cs1[2] - b3 * cs1[3], b3 * cs1[2] + a3 * cs1[3]);
                        *(u32x4*)(rowp + bj * HALF) = w; } }
        } else {
            float rs[2][4];
#pragma unroll
            for (int ai = 0; ai < 2; ++ai)
#pragma unroll
                for (int m = 0; m < 4; ++m) rs[ai][m] = ssq[row0 + ai * HALF + m * 16];
#pragma unroll
            for (int ai = 0; ai < 2; ++ai)
#pragma unroll
                for (int m = 0; m < 4; ++m) { bf16_t* rowp = O + (size_t)(row0 + ai * HALF + m * 16) * ldc + col0;
#pragma unroll
                    for (int bj = 0; bj < 2; ++bj) { const f32x4 v0 = acc[ai][bj][m][0] * rs[ai][m], v1 = acc[ai][bj][m][1] * rs[ai][m];
                        u32x4 w; w.x = cvt_pk_bf16(v0[0], v0[1]); w.y = cvt_pk_bf16(v0[2], v0[3]); w.z = cvt_pk_bf16(v1[0], v1[1]); w.w = cvt_pk_bf16(v1[2], v1[3]);
                        *(u32x4*)(rowp + bj * HALF) = w; } }
        }
    }
};
template <class Epi, class Sched, bool ALIGN_EPI = false, bool SP2 = false>
__device__ __forceinline__ void gemm_phase(PG8_LAS unsigned char* lds, const Gemm g, const Sched& S, const Epi& E) {
    int tid_o = threadIdx.x; asm volatile("" : "+v"(tid_o));
    const int tid = tid_o & 511, wid = __builtin_amdgcn_readfirstlane(tid >> 6), lane = tid & 63, wr = wid >> 2, wc = wid & 3, fr = lane & 15, fq = lane >> 4;
    const int K = g.K, nt = K / BK;
    unsigned voffA[2], voffB[2];
#pragma unroll
    for (int i = 0; i < 2; ++i) { int R, C; stage_rc(tid * 16 + i * 8192, R, C); const int Rb = Epi::PERM ? ((R & ~31) + perm32(R & 31)) : R;
        voffA[i] = (unsigned)(R * K + C) * 2u; voffB[i] = (unsigned)(Rb * K + C) * 2u; }
    const size_t kstep = (size_t)(BK * 2);
    const size_t hstep = (size_t)HALF * K * 2;
    const size_t tstep = 2 * hstep;
    const unsigned ldsw = (unsigned)wid * 1024u;
    const int aoff = lds_byte(wr * 64 + fr, fq * 8), boff = lds_byte(wc * 32 + fr, fq * 8);
#define PG8_SA(b, h) (((b) * 2 + (h)) * HTB)
#define PG8_SB(b, h) ((4 + (b) * 2 + (h)) * HTB)
#define PG8_STAGE(bufoff, gbase, voff) do { _Pragma("unroll") for (int _i = 0; _i < 2; ++_i) { asm volatile("" : "+v"((voff)[_i])); \
        __builtin_amdgcn_global_load_lds((const unsigned*)((const char*)(gbase) + (voff)[_i]), (PG8_LAS unsigned*)(lds + (bufoff) + ldsw + _i * 8192), 16, 0, 0); } } while (0)
#define PG8_LDA(dst, b, h) do { _Pragma("unroll") for (int m = 0; m < 4; ++m) _Pragma("unroll") for (int k = 0; k < 2; ++k) dst[m][k] = *(const PG8_LAS bf16x8*)(lds + PG8_SA(b, h) + aoff + m * 2048 + k * 1024); } while (0)
#define PG8_LDB(dst, b, h) do { _Pragma("unroll") for (int n = 0; n < 2; ++n) _Pragma("unroll") for (int k = 0; k < 2; ++k) dst[n][k] = *(const PG8_LAS bf16x8*)(lds + PG8_SB(b, h) + boff + n * 2048 + k * 1024); } while (0)
#define PG8_MMA(ai, bj, At, Bt) do { __builtin_amdgcn_s_setprio(1); _Pragma("unroll") for (int m = 0; m < 4; ++m) _Pragma("unroll") for (int n = 0; n < 2; ++n) _Pragma("unroll") for (int k = 0; k < 2; ++k) \
        acc[ai][bj][m][n] = __builtin_amdgcn_mfma_f32_16x16x32_bf16(Bt[n][k], At[m][k], acc[ai][bj][m][n], 0, 0, 0); __builtin_amdgcn_s_setprio(0); } while (0)
#define PG8_WAIT_V(n) asm volatile("s_waitcnt vmcnt(" #n ")" ::: "memory")
#define PG8_WAIT_L(n) asm volatile("s_waitcnt lgkmcnt(" #n ")" ::: "memory")
#define PG8_BAR __builtin_amdgcn_s_barrier()
#define PG8_SCHED __builtin_amdgcn_sched_barrier(0)
    Unit cur, nxt; int ui = 0;
    if (!S.next(0, cur)) return;
    f32x4 acc[2][2][4][2];
#pragma unroll
    for (int a = 0; a < 2; ++a)
#pragma unroll
        for (int b = 0; b < 2; ++b)
#pragma unroll
            for (int m = 0; m < 4; ++m)
#pragma unroll
                for (int n = 0; n < 2; ++n) acc[a][b][m][n] = (f32x4){0.f, 0.f, 0.f, 0.f};
    bf16x8 At[4][2], B0[2][2], B1[2][2];
    const char* cA = (const char*)g.A + (size_t)cur.pm * tstep; const char* cB = (const char*)g.Bt + (size_t)cur.pn * tstep;
    S.a_ready(cur);
    if constexpr (SP2) {
        PG8_STAGE(PG8_SB(0, 0), cB, voffB); PG8_STAGE(PG8_SB(0, 1), cB + hstep, voffB); PG8_STAGE(PG8_SA(0, 0), cA, voffA); PG8_STAGE(PG8_SA(0, 1), cA + hstep, voffA);
        if (wr == 1) PG8_BAR;
        PG8_WAIT_V(2); PG8_BAR;
        PG8_STAGE(PG8_SB(1, 0), cB + kstep, voffB); PG8_STAGE(PG8_SA(1, 0), cA + kstep, voffA); PG8_STAGE(PG8_SB(1, 1), cB + hstep + kstep, voffB);
        PG8_WAIT_V(6); PG8_BAR;
    } else {
        PG8_STAGE(PG8_SB(0, 0), cB, voffB); PG8_STAGE(PG8_SA(0, 0), cA, voffA); PG8_STAGE(PG8_SB(0, 1), cB + hstep, voffB); PG8_STAGE(PG8_SA(0, 1), cA + hstep, voffA);
        if (wr == 1) PG8_BAR;
        PG8_WAIT_V(4); PG8_BAR;
        PG8_STAGE(PG8_SB(1, 0), cB + kstep, voffB); PG8_STAGE(PG8_SA(1, 0), cA + kstep, voffA); PG8_STAGE(PG8_SB(1, 1), cB + hstep + kstep, voffB);
        PG8_WAIT_V(6); PG8_BAR;
    }
    for (;;) {
        const bool has_next = S.next(ui + 1, nxt);
        const char* nA = has_next ? (const char*)g.A + (size_t)nxt.pm * tstep : cA; const char* nB = has_next ? (const char*)g.Bt + (size_t)nxt.pn * tstep : cB;
        for (int t = 0; t < nt; t += 2) {
            const bool last = (t == nt - 2);
            const char* a1 = cA + (size_t)(t + 1) * kstep;
            const char* a2 = last ? nA : cA + (size_t)(t + 2) * kstep; const char* b2 = last ? nB : cB + (size_t)(t + 2) * kstep;
            const char* a3 = a2 + kstep; const char* b3 = b2 + kstep;
            if (last && has_next) S.a_ready(nxt);
            if constexpr (SP2) {
            PG8_LDB(B0, 0, 0); PG8_LDB(B1, 0, 1); PG8_SCHED; PG8_LDA(At, 0, 0); PG8_STAGE(PG8_SA(1, 1), a1 + hstep, voffA);
            PG8_WAIT_V(8); PG8_WAIT_L(0); PG8_BAR; PG8_MMA(0, 0, At, B0); PG8_MMA(0, 1, At, B1); PG8_BAR; PG8_SCHED;
            PG8_LDA(At, 0, 1); PG8_STAGE(PG8_SB(0, 0), b2, voffB); PG8_STAGE(PG8_SB(0, 1), b2 + hstep, voffB); PG8_STAGE(PG8_SA(0, 0), a2, voffA);
            PG8_WAIT_V(8); PG8_WAIT_L(0); PG8_BAR; PG8_MMA(1, 0, At, B0); PG8_MMA(1, 1, At, B1); PG8_BAR; PG8_SCHED;
            PG8_LDB(B0, 1, 0); PG8_LDB(B1, 1, 1); PG8_SCHED; PG8_LDA(At, 1, 0); PG8_STAGE(PG8_SA(0, 1), a2 + hstep, voffA);
            PG8_WAIT_V(8); PG8_WAIT_L(0); PG8_BAR; PG8_MMA(0, 0, At, B0); PG8_MMA(0, 1, At, B1); PG8_BAR; PG8_SCHED;
            PG8_LDA(At, 1, 1); PG8_STAGE(PG8_SB(1, 0), b3, voffB); PG8_STAGE(PG8_SB(1, 1), b3 + hstep, voffB); PG8_STAGE(PG8_SA(1, 0), a3, voffA);
            PG8_WAIT_V(8); PG8_WAIT_L(0); PG8_BAR; PG8_MMA(1, 0, At, B0); PG8_MMA(1, 1, At, B1); PG8_BAR; PG8_SCHED;
            } else {
            PG8_LDB(B0, 0, 0); PG8_SCHED; PG8_LDA(At, 0, 0); PG8_STAGE(PG8_SA(1, 1), a1 + hstep, voffA);
            PG8_WAIT_L(8); PG8_BAR; PG8_WAIT_L(0); PG8_MMA(0, 0, At, B0); PG8_BAR; PG8_SCHED;
            PG8_LDB(B1, 0, 1); PG8_STAGE(PG8_SB(0, 0), b2, voffB);
            PG8_BAR; PG8_WAIT_L(0); PG8_MMA(0, 1, At, B1); PG8_BAR;
            PG8_LDA(At, 0, 1); PG8_STAGE(PG8_SA(0, 0), a2, voffA);
            PG8_BAR; PG8_WAIT_L(0); PG8_MMA(1, 0, At, B0); PG8_BAR; PG8_SCHED;
            PG8_STAGE(PG8_SB(0, 1), b2 + hstep, voffB);
            PG8_WAIT_V(6); PG8_BAR; PG8_MMA(1, 1, At, B1); PG8_BAR;
            PG8_LDB(B0, 1, 0); PG8_SCHED; PG8_LDA(At, 1, 0); PG8_STAGE(PG8_SA(0, 1), a2 + hstep, voffA);
            PG8_WAIT_L(8); PG8_BAR; PG8_WAIT_L(0); PG8_MMA(0, 0, At, B0); PG8_BAR; PG8_SCHED;
            PG8_LDB(B1, 1, 1); PG8_STAGE(PG8_SB(1, 0), b3, voffB);
            PG8_BAR; PG8_WAIT_L(0); PG8_MMA(0, 1, At, B1); PG8_BAR;
            PG8_LDA(At, 1, 1); PG8_STAGE(PG8_SA(1, 0), a3, voffA);
            PG8_BAR; PG8_WAIT_L(0); PG8_MMA(1, 0, At, B0); PG8_BAR; PG8_SCHED;
            PG8_STAGE(PG8_SB(1, 1), b3 + hstep, voffB);
            PG8_WAIT_V(6); PG8_BAR; PG8_MMA(1, 1, At, B1); PG8_BAR;
            }
        }
        if constexpr (ALIGN_EPI) { if (wr == 0) PG8_BAR; }
        if constexpr (!Epi::AFTER_DRAIN) { E(acc, cur, wr, wc, fr, fq); S.done(cur); }
        if (!has_next) break;
#pragma unroll
        for (int a = 0; a < 2; ++a)
#pragma unroll
            for (int b = 0; b < 2; ++b)
#pragma unroll
                for (int m = 0; m < 4; ++m)
#pragma unroll
                    for (int n = 0; n < 2; ++n) acc[a][b][m][n] = (f32x4){0.f, 0.f, 0.f, 0.f};
        cur = nxt; cA = nA; cB = nB; ++ui;
        if constexpr (ALIGN_EPI) { if (wr == 1) PG8_BAR; }
    }
    PG8_WAIT_V(0);
    if constexpr (!ALIGN_EPI) { if (wr == 0) PG8_BAR; }
    PG8_BAR;
    if constexpr (Epi::AFTER_DRAIN) { E.fused(acc, cur, wr, wc, fr, fq, lds, wid, lane); S.done(cur); }
#undef PG8_SA
#undef PG8_SB
#undef PG8_STAGE
#undef PG8_LDA
#undef PG8_LDB
#undef PG8_MMA
#undef PG8_WAIT_V
#undef PG8_WAIT_L
#undef PG8_BAR
#undef PG8_SCHED
}
}
#define GAS __attribute__((address_space(1)))
#define LAS __attribute__((address_space(3)))
typedef unsigned short bf16;
typedef unsigned v4u __attribute__((ext_vector_type(4)));
typedef float f32x4 __attribute__((ext_vector_type(4)));
typedef short bf16x8 __attribute__((ext_vector_type(8)));
typedef GAS unsigned gu32;
typedef GAS unsigned long long gu64;
#define RLX_AGENT __ATOMIC_RELAXED, __HIP_MEMORY_SCOPE_AGENT
#define LDS_WAIT() asm volatile("s_waitcnt lgkmcnt(0)" ::: "memory")
#define VM_WAIT() asm volatile("s_waitcnt vmcnt(0)" ::: "memory")
__device__ __forceinline__ unsigned long long rt() { return __builtin_amdgcn_s_memrealtime(); }
__device__ __forceinline__ unsigned f2bf(float f) { unsigned u = __builtin_bit_cast(unsigned, f); return (u + 0x7fffu + ((u >> 16) & 1u)) >> 16; }
typedef float f32x2_t __attribute__((ext_vector_type(2)));
typedef __bf16 bf16x2_t __attribute__((ext_vector_type(2)));
__device__ __forceinline__ unsigned pk2(float lo, float hi) { f32x2_t v = {lo, hi}; bf16x2_t b = __builtin_convertvector(v, bf16x2_t); return __builtin_bit_cast(unsigned, b); }
#define XB_TMO      128
#define XB_XCNT(j)  (256  + 64 * (j))
#define XB_XSUB(j)  (1280 + 64 * (j))
#define XB_XGEN(j)  (2304 + 64 * (j))
#define XB_TOP      3328
#define XB_TOPGEN   3392
#define XCD_BAR_WORDS 3456
#define XB_SPIN_CAP (1u << 18)

__device__ __forceinline__ unsigned xb_ld(unsigned* p)              { return __hip_atomic_load(p, __ATOMIC_RELAXED, __HIP_MEMORY_SCOPE_AGENT); }
__device__ __forceinline__ unsigned xb_add(unsigned* p, unsigned v) { return __hip_atomic_fetch_add(p, v, __ATOMIC_RELAXED, __HIP_MEMORY_SCOPE_AGENT); }
__device__ __forceinline__ unsigned xb_xcc_id() { return (unsigned)__builtin_amdgcn_s_getreg((3 << 11) | 20) & 0xFu; }
#define XB_SPIN(cond, bar) do { unsigned _sp = 0; while (cond) { __builtin_amdgcn_s_sleep(1); \
    if ((++_sp & 255u) == 0u) { if (xb_ld(&(bar)[XB_TMO])) break; if (_sp > XB_SPIN_CAP) { atomicAdd(&(bar)[XB_TMO], 1u); break; } } } } while (0)

struct XcdBarrier {
    unsigned* bar; unsigned x;
    volatile LAS unsigned* st;
};

__device__ __forceinline__ XcdBarrier xcd_barrier_post(unsigned* bar, volatile LAS unsigned* st) {
    XcdBarrier b; b.bar = bar; b.x = xb_xcc_id(); b.st = st;
    if (threadIdx.x == 0) (void)xb_add(&bar[XB_XCNT(b.x)], 1u);
    return b;
}
__device__ __forceinline__ void xcd_barrier_complete(unsigned* bar, unsigned x, unsigned& nloc, unsigned& nx) {
    const unsigned G = gridDim.x * gridDim.y * gridDim.z;
    unsigned sum, cnt, mine, sp = 0u;
    for (;;) {
        sum = 0u; cnt = 0u; mine = 0u;
#pragma unroll
        for (unsigned j = 0; j < 16; ++j) { const unsigned c = xb_ld(&bar[XB_XCNT(j)]); sum += c; cnt += (c > 0u) ? 1u : 0u; mine = (j == x) ? c : mine; }
        if (sum == G) break;
        __builtin_amdgcn_s_sleep(1);
        if ((++sp & 255u) == 0u) { if (xb_ld(&bar[XB_TMO])) break; if (sp > XB_SPIN_CAP) { atomicAdd(&bar[XB_TMO], 1u); break; } }
    }
    nloc = mine > 0u ? mine : 1u; nx = cnt > 0u ? cnt : 1u;
}

__device__ __forceinline__ void xcd_barrier(const XcdBarrier& b) {
    asm volatile("s_waitcnt vmcnt(0)" ::: "memory");
    __syncthreads();
    if (threadIdx.x == 0) {
        unsigned* bar = b.bar;
        __builtin_amdgcn_s_waitcnt(0);
        unsigned nloc = b.st[0], nx = b.st[1];
        if (nloc == 0u) { xcd_barrier_complete(bar, b.x, nloc, nx); b.st[0] = nloc; b.st[1] = nx; }
        const unsigned old = xb_add(&bar[XB_XSUB(b.x)], 1u);
        const unsigned gen = old / nloc;
        if (old + 1u == (gen + 1u) * nloc) {
            __builtin_amdgcn_fence(__ATOMIC_RELEASE, "agent");
            asm volatile("s_waitcnt vmcnt(0)" ::: "memory");
            const unsigned og = xb_add(&bar[XB_TOP], 1u);
            const unsigned tg = og / nx;
            if (og + 1u == (tg + 1u) * nx) xb_add(&bar[XB_TOPGEN], 1u);
            else XB_SPIN(xb_ld(&bar[XB_TOPGEN]) == tg, bar);
            __builtin_amdgcn_fence(__ATOMIC_ACQUIRE, "agent");
            xb_add(&bar[XB_XGEN(b.x)], 1u);
            asm volatile("s_waitcnt vmcnt(0)" ::: "memory");
        } else {
            XB_SPIN(xb_ld(&bar[XB_XGEN(b.x)]) == gen, bar);
            __builtin_amdgcn_fence(__ATOMIC_ACQUIRE, "agent");
            asm volatile("s_waitcnt vmcnt(0)" ::: "memory");
        }
    }
    __syncthreads();
}
constexpr int NWAVES = 8;
constexpr int DM = 4096, TP = 16384, TS = 8192, TT = 24576, NLAYER = 2;
constexpr int INC = 9792, ZC = 9984;
constexpr int Z_CQ = 3072, Z_CKV = 4608, Z_KR = 5120, Z_DQ = 5376, Z_DK = 6912, Z_DV = 8448;
constexpr int QC = 2304, KVC = 3072, DFF = 16384;
constexpr float EPS = 1e-6f;
constexpr int NPH_LAYER = 10, NPHASES = 1 + NLAYER * NPH_LAYER;

constexpr size_t MiB = 1u << 20;
constexpr size_t WS_CTL = 0, CTL_ZERO_BYTES = 1 * MiB;
constexpr size_t WS_R64 = 1 * MiB, WS_R128 = 3 * MiB;
constexpr size_t WS_FILT = 7 * MiB, FILT_LAYER = 40 * MiB, FILT_S_OFF = 8 * MiB;
constexpr size_t WS_WT = 87 * MiB;
constexpr size_t WT_IN = 0, WT_OUT = 78 * MiB, WT_UP = 110 * MiB, WT_DN = 238 * MiB, WT_QB = 366 * MiB, WT_KVB = WT_QB + 7077888, WT_LAYER = WT_KVB + 3 * MiB;
constexpr size_t WS_H = WS_WT + 2 * WT_LAYER;
constexpr size_t WS_A2 = WS_H + 192 * MiB;
constexpr size_t WS_Z = WS_A2, WS_Q = WS_Z + 468 * MiB, WS_KV = WS_Q + 108 * MiB, WS_UT = WS_KV + 144 * MiB;
constexpr size_t WS_CQ = WS_A2 + 768 * MiB, WS_CKV = WS_CQ + 72 * MiB, WS_KR = WS_CKV + 24 * MiB, WS_X0T = WS_KR + 3 * MiB, WS_YT = WS_X0T + 48 * MiB, WS_DLSE = WS_YT + 48 * MiB;
constexpr size_t WS_SSQP = WS_DLSE + 2 * MiB;
constexpr size_t WS_END = WS_SSQP + 2 * MiB;
constexpr size_t WS_XB = WS_H;
constexpr size_t WS_MIX = WS_KV;
constexpr size_t WS_SSQ = 128 * 1024;
static_assert(WS_MIX + (size_t)TT * DM * 2 == WS_A2 + 768 * MiB && WS_SSQ + 4 * (size_t)TT * 4 <= CTL_ZERO_BYTES, "MIXED overlay / ssq arrays");
static_assert(WS_END <= 2048 * MiB, "workspace map fits 2 GiB");

constexpr int CW_TMO = 0, CW_BAR = 4096;
constexpr int RING_BYTES = 131072, LDSCTL_OFF = RING_BYTES, MISC_OFF = LDSCTL_OFF + 320, WSCR_OFF = RING_BYTES + 1024, PTAB_OFF = RING_BYTES + 2048, KVTAB_OFF = RING_BYTES + 4096  , LDS_BYTES = 147456;

typedef unsigned short bf16;
typedef unsigned v4u __attribute__((ext_vector_type(4)));
typedef unsigned v2u __attribute__((ext_vector_type(2)));
typedef float f32x4 __attribute__((ext_vector_type(4)));
typedef float f32x2v __attribute__((ext_vector_type(2)));
typedef float f32x16 __attribute__((ext_vector_type(16)));
typedef short bf16x8 __attribute__((ext_vector_type(8)));
typedef short s16x4 __attribute__((ext_vector_type(4)));
#define SBAR() __builtin_amdgcn_sched_barrier(0)
struct InTab { const float* const (&t)[31]; __device__ __forceinline__ const float* operator[](int k) const { return t[k]; } };

__device__ __forceinline__ float bf2f(unsigned v) { return __uint_as_float(v << 16); }
__device__ __forceinline__ float bflo(unsigned w) { return __uint_as_float(w << 16); }
__device__ __forceinline__ float bfhi(unsigned w) { return __uint_as_float(w & 0xffff0000u); }
__device__ __forceinline__ int crow_(int r, int hi) { return (r & 3) + 8 * (r >> 2) + 4 * hi; }
__device__ __forceinline__ float wave_sum(float v) {
#pragma unroll
    for (int o = 1; o < 64; o <<= 1) v += __shfl_xor(v, o);
    return v;
}
__device__ __forceinline__ void unpack8(const v4u w, float (&f)[8]) { f[0] = bflo(w.x); f[1] = bfhi(w.x); f[2] = bflo(w.y); f[3] = bfhi(w.y); f[4] = bflo(w.z); f[5] = bfhi(w.z); f[6] = bflo(w.w); f[7] = bfhi(w.w); }
__device__ __forceinline__ v4u pack8(const float (&f)[8]) { v4u w; w.x = pk2(f[0], f[1]); w.y = pk2(f[2], f[3]); w.z = pk2(f[4], f[5]); w.w = pk2(f[6], f[7]); return w; }
__device__ __forceinline__ int seq_pos(int m) { return m < TP ? (m & 2047) : (m - TP); }
__device__ __forceinline__ int seq_len(int m) { return m < TP ? 2048 : 8192; }

__device__ __forceinline__ void transpose_item(const float* W, int ldw, bf16* WT, int K, int k0, int nsrc, int ndst, int dstr  , const float* gk  , LAS float* scr, int lane) {
    float tv[32];
#pragma unroll
    for (int i = 0; i < 32; ++i) tv[i] = W[(size_t)(k0 + 2 * i + (lane >> 5)) * ldw + nsrc + (lane & 31)];
    if (gk) {
#pragma unroll
        for (int i = 0; i < 32; ++i) tv[i] *= gk[k0 + 2 * i + (lane >> 5)]; }
#pragma unroll
    for (int i = 0; i < 32; ++i) scr[(2 * i + (lane >> 5)) * 33 + (lane & 31)] = tv[i];
    LDS_WAIT(); asm volatile("" ::: "memory");
    const int c = lane & 7;
#pragma unroll
    for (int j = 0; j < 4; ++j) { const int n = (lane >> 3) + 8 * j; const LAS float* s = scr + (8 * c) * 33 + n;
        v4u o; o.x = pk2(s[0 * 33], s[1 * 33]); o.y = pk2(s[2 * 33], s[3 * 33]); o.z = pk2(s[4 * 33], s[5 * 33]); o.w = pk2(s[6 * 33], s[7 * 33]);
        *(GAS v4u*)(WT + (size_t)(ndst + n * dstr) * K + k0 + 8 * c) = o; }
    LDS_WAIT(); asm volatile("" ::: "memory");
}
constexpr int I_IN = 64 * 306, I_OUT = 64 * 128, I_UP = 64 * 512, I_DN = 256 * 128, I_QB = 24 * 72, I_KVB = 8 * 96, I_LAYER = I_IN + I_OUT + I_UP + I_DN + I_QB + I_KVB;
__device__ __forceinline__ void p0_weights(const InTab in, unsigned char* ws, LAS float* scr, int gw, int NGW, int lane) {
    for (int it = gw; it < NLAYER * I_LAYER; it += NGW) {
        const int l = it / I_LAYER; int r = it % I_LAYER; unsigned char* wl = ws + WS_WT + (size_t)l * WT_LAYER;
        if (r < I_IN) { const int kb = r / 306, nb = r % 306, n0 = 32 * nb; int nd = n0, ds = 1;
            if (n0 >= 8256) nd = n0 + 192;
            else if (n0 >= 5184) { const int nl = n0 - 5184, d0 = nl & 127; nd = Z_DQ + (nl & ~127) + (d0 < 64 ? 2 * d0 : 2 * (d0 - 64) + 1); ds = 2; }
            transpose_item(in[3] + (size_t)l * DM * INC, INC, (bf16*)(wl + WT_IN), DM, 64 * kb, n0, nd, ds, in[2] + l * DM, scr, lane); continue; } r -= I_IN;
        if (r < I_OUT) { const int kb = r / 128, nb = r % 128; transpose_item(in[27] + (size_t)l * DM * DM, DM, (bf16*)(wl + WT_OUT), DM, 64 * kb, 32 * nb, 32 * nb, 1, nullptr, scr, lane); continue; } r -= I_OUT;
        if (r < I_UP) { const int kb = r / 512, nb = r % 512; transpose_item(in[29] + (size_t)l * DM * DFF, DFF, (bf16*)(wl + WT_UP), DM, 64 * kb, 32 * nb, 32 * nb, 1, in[28] + l * DM, scr, lane); continue; } r -= I_UP;
        if (r < I_DN) { const int kb = r / 128, nb = r % 128; transpose_item(in[30] + (size_t)l * DFF * DM, DM, (bf16*)(wl + WT_DN), DFF, 64 * kb, 32 * nb, 32 * nb, 1, nullptr, scr, lane); continue; } r -= I_DN;
        if (r < I_QB) { const int kb = r / 72, nb = r % 72, n0 = 32 * nb, h = n0 / 192, j = n0 % 192;
            transpose_item(in[17] + (size_t)l * 1536 * QC, QC, (bf16*)(wl + WT_QB), 1536, 64 * kb, n0, j < 128 ? h * 128 + j : 1536 + h * 64 + (j - 128), 1, nullptr, scr, lane); continue; } r -= I_QB;
        { const int kb = r / 96, nb = r % 96; transpose_item(in[19] + (size_t)l * 512 * KVC, KVC, (bf16*)(wl + WT_KVB), 512, 64 * kb, 32 * nb, 32 * nb, 1, nullptr, scr, lane); }
    }
}
__device__ __forceinline__ void p0_misc(unsigned char* ws, int gt, int NGT) {
    for (int i = gt; i < NLAYER * 98304; i += NGT) { const int l = i / 98304, r = i % 98304; *(GAS v4u*)(ws + WS_WT + (size_t)l * WT_LAYER + WT_IN + (size_t)5184 * DM * 2 + (size_t)r * 16) = (v4u){0u, 0u, 0u, 0u}; }
    for (int i = gt; i < 8192 * 96; i += NGT) { const int pos = i / 96, j = i % 96; float sv, cv;
        if (j < 32) { const float inv = 1.0f / powf(10000.0f, (float)(2 * j) / 64.0f); sincosf((float)pos * inv, &sv, &cv); ((GAS f32x2v*)(ws + WS_R64))[pos * 32 + j] = (f32x2v){cv, sv}; }
        else { const int jj = j - 32; const float inv = 1.0f / powf(10000.0f, (float)(2 * jj) / 128.0f); sincosf((float)pos * inv, &sv, &cv); ((GAS f32x2v*)(ws + WS_R128))[pos * 64 + jj] = (f32x2v){cv, sv}; } }
}
constexpr int FI_W1 = 0, FI_W2 = 33 * 64 * 4, FI_W3 = FI_W2 + 16384, FI_B = FI_W3 + 16384  , FI_H0 = FI_B + 1024, FI_H1 = FI_H0 + 16384, FI_H3 = FI_H1 + 16384;
__device__ __forceinline__ void filter_item(const InTab in, unsigned char* ws, int layer, int trunk, int pblk, LAS unsigned char* lds, int tid, int lane, int wave) {
    const int L = trunk ? 8192 : 2048, p0 = pblk * 64, p = p0 + lane;
    bf16* Rg = (bf16*)(ws + WS_FILT + (size_t)layer * FILT_LAYER + (trunk ? FILT_S_OFF : 0));
    const float* w4 = in[12] + (size_t)layer * 64 * 2048; const float* b4 = in[13] + layer * 2048;
    __syncthreads();
    { const float* w1 = in[6] + layer * 33 * 64; const float* w2 = in[8] + layer * 4096; const float* w3 = in[10] + layer * 4096;
      for (int i = tid; i < 33 * 64; i += 512) ((LAS float*)(lds + FI_W1))[i] = w1[i];
      for (int i = tid; i < 4096; i += 512) { ((LAS float*)(lds + FI_W2))[i] = w2[i]; ((LAS float*)(lds + FI_W3))[i] = w3[i]; }
      if (tid < 64) { ((LAS float*)(lds + FI_B))[tid] = in[7][layer * 64 + tid]; ((LAS float*)(lds + FI_B))[64 + tid] = in[9][layer * 64 + tid];
                      ((LAS float*)(lds + FI_B))[128 + tid] = in[11][layer * 64 + tid]; ((LAS float*)(lds + FI_B))[192 + tid] = in[14][layer * 64 + tid]; } }
    const float tp = (float)p / (float)(L - 1), wang = 6.283185307179586f * (float)p / (float)L;
    if (wave == 0) ((LAS float*)(lds + FI_H1))[lane] = tp;
#pragma unroll 1
    for (int jj = 0; jj < 2; ++jj) { const int j = 2 * wave + jj; const float f = 1e-4f + (float)j * ((15.0f - 1e-4f) / 15.0f); float sv, cv; sincosf(f * wang, &sv, &cv);
        ((LAS float*)(lds + FI_H1))[(1 + j) * 64 + lane] = cv; ((LAS float*)(lds + FI_H1))[(17 + j) * 64 + lane] = -sv; }
    __syncthreads();
    const LAS float* Bv = (const LAS float*)(lds + FI_B);
    float hv[64];
#pragma unroll
    for (int k = 0; k < 33; ++k) hv[k] = ((const LAS float*)(lds + FI_H1))[k * 64 + lane];
#pragma unroll 1
    for (int u = 0; u < 8; ++u) { const int k = 8 * wave + u; const LAS float* wc = (const LAS float*)(lds + FI_W1) + k; float a = Bv[k];
#pragma unroll
        for (int j = 0; j < 33; ++j) a += hv[j] * wc[j * 64];
        ((LAS float*)(lds + FI_H0))[k * 64 + lane] = sinf(Bv[192 + k] * a); }
    __syncthreads();
#pragma unroll
    for (int k = 0; k < 64; ++k) hv[k] = ((const LAS float*)(lds + FI_H0))[k * 64 + lane];
#pragma unroll 1
    for (int u = 0; u < 8; ++u) { const int k = 8 * wave + u; const LAS float* wc = (const LAS float*)(lds + FI_W2) + k; float a = Bv[64 + k];
#pragma unroll
        for (int j = 0; j < 64; ++j) a += hv[j] * wc[j * 64];
        ((LAS float*)(lds + FI_H1))[k * 64 + lane] = sinf(Bv[192 + k] * a); }
    __syncthreads();
#pragma unroll
    for (int k = 0; k < 64; ++k) hv[k] = ((const LAS float*)(lds + FI_H1))[k * 64 + lane];
#pragma unroll 1
    for (int u = 0; u < 8; ++u) { const int k = 8 * wave + u; const LAS float* wc = (const LAS float*)(lds + FI_W3) + k; float a = Bv[128 + k];
#pragma unroll
        for (int j = 0; j < 64; ++j) a += hv[j] * wc[j * 64];
        ((LAS bf16*)(lds + FI_H3))[lane * 72 + k] = (bf16)f2bf(sinf(Bv[192 + k] * a)); }
    __syncthreads();
    const int r32 = lane & 31, hi = lane >> 5;
    float tq[2]; int pq[2];
#pragma unroll
    for (int pb = 0; pb < 2; ++pb) { pq[pb] = p0 + pb * 32 + r32; tq[pb] = -1.4426950408889634f * (float)pq[pb] / (float)(L - 1); }
#pragma unroll 1
    for (int cbk = 0; cbk < 8; ++cbk) {
        const int c0 = 256 * wave + 32 * cbk;
        f32x16 acc[2];
#pragma unroll
        for (int pb = 0; pb < 2; ++pb) acc[pb] = (f32x16){0.f, 0.f, 0.f, 0.f, 0.f, 0.f, 0.f, 0.f, 0.f, 0.f, 0.f, 0.f, 0.f, 0.f, 0.f, 0.f};
#pragma unroll 1
        for (int ks = 0; ks < 4; ++ks) {
            const float* wk = w4 + (size_t)(ks * 16 + hi * 8) * 2048 + c0 + r32; float wv[8];
#pragma unroll
            for (int j = 0; j < 8; ++j) wv[j] = wk[j * 2048];
            const bf16x8 b0 = *(const LAS bf16x8*)(lds + FI_H3 + r32 * 144 + (ks * 16 + hi * 8) * 2), b1 = *(const LAS bf16x8*)(lds + FI_H3 + (32 + r32) * 144 + (ks * 16 + hi * 8) * 2);
            v4u aw; aw.x = pk2(wv[0], wv[1]); aw.y = pk2(wv[2], wv[3]); aw.z = pk2(wv[4], wv[5]); aw.w = pk2(wv[6], wv[7]);
            const bf16x8 af = __builtin_bit_cast(bf16x8, aw);
            acc[0] = __builtin_amdgcn_mfma_f32_32x32x16_bf16(af, b0, acc[0], 0, 0, 0); acc[1] = __builtin_amdgcn_mfma_f32_32x32x16_bf16(af, b1, acc[1], 0, 0, 0);
        }
        const bool fwd = wave < 4;
        unsigned nidx[2]; bool zr[2];
#pragma unroll
        for (int pb = 0; pb < 2; ++pb) { zr[pb] = !fwd && pq[pb] == 0; nidx[pb] = fwd ? (unsigned)(L - pq[pb]) : (zr[pb] ? 0u : (unsigned)(L + pq[pb])); }
#pragma unroll
        for (int r = 0; r < 16; ++r) { const unsigned col = (unsigned)(c0 + crow_(r, hi)), ch = col & 1023u;
            const float delta = fabsf(-3.0701134573253944f + (float)ch * ((-15.350567286626972f + 3.0701134573253944f) / 1023.0f)), bb = b4[col];
#pragma unroll
            for (int pb = 0; pb < 2; ++pb) { const float v = (acc[pb][r] + bb) * __builtin_amdgcn_exp2f(tq[pb] * delta);
                Rg[ch * (unsigned)(2 * L) + nidx[pb]] = zr[pb] ? (bf16)0 : (bf16)f2bf(v); }
            if ((r & 3) == 3) asm volatile("" ::: "memory"); }
    }
    __syncthreads();
}
__device__ __forceinline__ void cvt_rows(const float* x0, const float* x1, bf16* XB, float* ssq, int gw, int NGW, int lane) {
    for (int m = gw; m < TT; m += NGW) {
        const GAS f32x4* xr = (const GAS f32x4*)((m < TP ? x0 : x1) + (size_t)m * DM) + lane;
        f32x4 v[16]; float s = 0.f;
#pragma unroll
        for (int j = 0; j < 16; ++j) { v[j] = xr[64 * j]; s += (v[j].x * v[j].x + v[j].y * v[j].y) + (v[j].z * v[j].z + v[j].w * v[j].w); }
        s = wave_sum(s); if (lane == 0) ssq[m] = 1.0f / sqrtf(s * (1.0f / DM) + EPS);
        GAS v2u* o8 = (GAS v2u*)(XB + (size_t)m * DM) + lane;
#pragma unroll
        for (int j = 0; j < 16; ++j) { v2u w; w.x = pk2(v[j].x, v[j].y); w.y = pk2(v[j].z, v[j].w); o8[64 * j] = w; }
    }
}

__device__ __forceinline__ void rstd_rows(const float* ssqp, float* rstd, int gt, int NGT) {
    for (int m = gt; m < TT; m += NGT) { const GAS f32x4* p = (const GAS f32x4*)(ssqp + (size_t)m * 16); const f32x4 a = p[0], b = p[1], c = p[2], d = p[3];
        const float s = (((a.x + a.y) + (a.z + a.w)) + ((b.x + b.y) + (b.z + b.w))) + (((c.x + c.y) + (c.z + c.w)) + ((d.x + d.y) + (d.z + d.w)));
        rstd[m] = 1.0f / sqrtf(s * (1.0f / DM) + EPS); }
}
__device__ __forceinline__ void prep_hyena(const bf16* Z, const float* cw, const float* cb, bf16* UT, bf16* X0T, LAS unsigned char* lds, int tid, int bid, int G) {
    for (int tile = bid; tile < 384 * 8; tile += G) {
        const int tb = tile >> 3, cbk = tile & 7, row = tid >> 3, c8 = (tid & 7) * 8, m = tb * 64 + row;
        const int pos = seq_pos(m), L = seq_len(m); const bool hasm = pos > 0, hasp = pos < L - 1;
        v4u zw[2][3][3];
#pragma unroll
        for (int hc = 0; hc < 2; ++hc)
#pragma unroll
            for (int gI = 0; gI < 3; ++gI) { const bf16* zp = Z + (size_t)m * ZC + gI * 1024 + cbk * 128 + hc * 64 + c8;
                zw[hc][gI][1] = *(const GAS v4u*)zp; zw[hc][gI][0] = hasm ? *(const GAS v4u*)(zp - ZC) : (v4u){0u, 0u, 0u, 0u}; zw[hc][gI][2] = hasp ? *(const GAS v4u*)(zp + ZC) : (v4u){0u, 0u, 0u, 0u}; }
        __syncthreads();
#pragma unroll
        for (int hc = 0; hc < 2; ++hc) {
            const int c0 = cbk * 128 + hc * 64 + c8; float xc[3][8];
#pragma unroll
            for (int gI = 0; gI < 3; ++gI) { float a[8], b[8], c[8]; unpack8(zw[hc][gI][0], a); unpack8(zw[hc][gI][1], b); unpack8(zw[hc][gI][2], c); const float* wp = cw + gI * 1024 + c0;
#pragma unroll
                for (int e = 0; e < 8; ++e) xc[gI][e] = a[e] * wp[e] + b[e] * wp[3072 + e] + c[e] * wp[6144 + e] + cb[gI * 1024 + c0 + e]; }
            LAS bf16* TU = (LAS bf16*)(lds + hc * (2 * 64 * 132)); LAS bf16* TX = TU + 64 * 66;
#pragma unroll
            for (int e = 0; e < 8; ++e) { TU[(c8 + e) * 66 + row] = (bf16)f2bf(xc[1][e] * xc[2][e]); TX[(c8 + e) * 66 + row] = (bf16)f2bf(xc[0][e]); }
        }
        __syncthreads();
#pragma unroll
        for (int hc = 0; hc < 2; ++hc) { const int c = tid >> 3, t8 = (tid & 7) * 8; const LAS bf16* TU = (const LAS bf16*)(lds + hc * (2 * 64 * 132)); const LAS bf16* TX = TU + 64 * 66;
            const LAS unsigned* su = (const LAS unsigned*)(TU + c * 66 + t8); const LAS unsigned* sx = (const LAS unsigned*)(TX + c * 66 + t8);
            const v4u wu = {su[0], su[1], su[2], su[3]}, wx = {sx[0], sx[1], sx[2], sx[3]};
            const size_t o = (size_t)(cbk * 128 + hc * 64 + c) * TT + tb * 64 + t8; *(GAS v4u*)(UT + o) = wu; *(GAS v4u*)(X0T + o) = wx; }
    }
}
__device__ __forceinline__ void prep_tokens(const bf16* Z, const InTab in, int l, unsigned char* ws, int gw, int NGW, int lane) {
    bf16* CQ = (bf16*)(ws + WS_CQ); bf16* CKV = (bf16*)(ws + WS_CKV); bf16* KR = (bf16*)(ws + WS_KR);
    const GAS f32x2v* R64 = (const GAS f32x2v*)(ws + WS_R64); const GAS f32x2v* R128 = (const GAS f32x2v*)(ws + WS_R128);
    const float* gq = in[16] + l * 1536; const float* gkv = in[18] + l * 512; const float* gkr = in[23] + l * 64; const float* gdq = in[24] + l * 128; const float* gdk = in[25] + l * 128;
    for (int m = gw; m < TT; m += NGW) {
        const int pos = seq_pos(m); const bf16* zr = Z + (size_t)m * ZC;
        v4u cqw[3], ckw;
#pragma unroll
        for (int j = 0; j < 3; ++j) cqw[j] = *(const GAS v4u*)(zr + Z_CQ + lane * 8 + 512 * j);
        ckw = *(const GAS v4u*)(zr + Z_CKV + lane * 8); const unsigned krw = zr[Z_KR + lane];
        {
            float x[3][8]; float s = 0.f;
#pragma unroll
            for (int j = 0; j < 3; ++j) { unpack8(cqw[j], x[j]);
#pragma unroll
                for (int e = 0; e < 8; ++e) s += x[j][e] * x[j][e]; }
            const float rs = 1.0f / sqrtf(wave_sum(s) * (1.0f / 1536.0f) + EPS);
#pragma unroll
            for (int j = 0; j < 3; ++j) { const int c = lane * 8 + 512 * j; float y[8];
#pragma unroll
                for (int e = 0; e < 8; ++e) y[e] = x[j][e] * rs * gq[c + e];
                *(GAS v4u*)(CQ + (size_t)m * 1536 + c) = pack8(y); }
        }
        {
            float x[8], y[8]; float s = 0.f; unpack8(ckw, x);
#pragma unroll
            for (int e = 0; e < 8; ++e) s += x[e] * x[e];
            const float rs = 1.0f / sqrtf(wave_sum(s) * (1.0f / 512.0f) + EPS);
#pragma unroll
            for (int e = 0; e < 8; ++e) y[e] = x[e] * rs * gkv[lane * 8 + e];
            *(GAS v4u*)(CKV + (size_t)m * 512 + lane * 8) = pack8(y);
        }
        {
            const float x = bf2f(krw); const float rs = 1.0f / sqrtf(wave_sum(x * x) * (1.0f / 64.0f) + EPS);
            const float y = x * rs * gkr[lane], pr = __shfl_xor(y, 32); const f32x2v cs = R64[pos * 32 + (lane & 31)];
            KR[(size_t)m * 64 + lane] = (bf16)f2bf(lane < 32 ? y * cs.x - pr * cs.y : y * cs.x + pr * cs.y);
        }
    }
}
constexpr int CV_BS = 144;
template <int TRUNK>
__device__ __forceinline__ void conv_unit(int c, const bf16* Rg, const bf16* UT, const bf16* X0T, bf16* YT, float skip, LAS unsigned char* lds, int tid, int lane, int wave,
                                          v4u (&upre)[4], bool pre_valid, const bf16* next_urow, int next_np) {
    constexpr int L = TRUNK ? 8192 : 2048, NB = L / 64, NBAT = TRUNK ? 1 : 8, PADB = TRUNK ? 32 : 8, NBLK = NB + 2 * PADB, UBS = NBLK * CV_BS + (TRUNK ? 0 : 128);
    constexpr int NR = 2  , ENR = TRUNK ? 1 : 2  , TOK0 = TRUNK ? TP : 0, DC0 = TRUNK ? -128 : -32, DC1 = TRUNK ? 128 : 32;
    constexpr int ND = TRUNK ? 32 : 8, NPC = (64 * ND + 64) / 8  , NPR = NPC + 1  , CV_CS = NPC * 16 + 16, CV_RAW = TRUNK ? 28672 : 57344, CV_RSZ = (NPR * 16 + 255) & ~255, CV_FC = CV_RAW + 2 * CV_RSZ;
    static_assert(NBAT * UBS <= CV_RAW && CV_FC + 16 * CV_CS <= RING_BYTES && (CV_CS / 16) % 16 == 9 && NPR <= 512 && DC0 == -4 * ND && DC1 == 4 * ND, "conv LDS map");
    const bf16* urow = UT + (size_t)c * TT + TOK0;
    __syncthreads();
    for (int i = tid; i < NBAT * 2 * PADB * 8; i += 512) { const int b = i / (2 * PADB * 8), r = i % (2 * PADB * 8), pb = r >> 3, o8 = r & 7, blk = pb < PADB ? pb : pb + NB;
        *(LAS v4u*)(lds + b * UBS + blk * CV_BS + o8 * 16) = (v4u){0u, 0u, 0u, 0u}; }
    static_assert(NBAT * L / 8 % 512 == 0 && NBAT * L / 8 / 512 <= 4, "u pieces per thread");
#pragma unroll
    for (int k = 0; k < NBAT * L / 8 / 512; ++k) { const int ci = tid + 512 * k, b = ci / (L / 8), r = ci % (L / 8), blk = r >> 3, o8 = r & 7;
        const v4u uv = pre_valid ? upre[k] : *(const GAS v4u*)(urow + (size_t)ci * 8);
        *(LAS v4u*)(lds + b * UBS + (blk + PADB) * CV_BS + o8 * 16) = uv; }
    if (next_urow) {
#pragma unroll
        for (int k = 0; k < 4; ++k) if (k < next_np) upre[k] = *(const GAS v4u*)(next_urow + (size_t)(tid + 512 * k) * 8); }
    const int n = lane & 31, h = lane >> 5;
    int batch, t1, dlo, dhi, R0;
    const int g = wave & 3;
    if (TRUNK == 0) { const int bh = wave >> 2; batch = 4 * bh + (n >> 3); t1 = 8 * g + (n & 7); dlo = 8 * g - 31; dhi = 8 * g + 7; R0 = 0; }
    else { batch = 0; t1 = 32 * g + n; dlo = 32 * g - 127; dhi = 32 * g + 31; R0 = wave >> 2; }
    const int sl = (8 - (n & 7)) & 7;
    const int abase0 = CV_FC + sl * CV_CS + 2 * (64 * ND - n + 8 * h - sl);
    const int bbase0 = batch * UBS + (t1 + PADB) * CV_BS + 16 * h;
    f32x16 acc[NR];
#pragma unroll
    for (int r = 0; r < NR; ++r) acc[r] = (f32x16){0.f, 0.f, 0.f, 0.f, 0.f, 0.f, 0.f, 0.f, 0.f, 0.f, 0.f, 0.f, 0.f, 0.f, 0.f, 0.f};
    v2u xg[ENR][4];
    { const size_t tokb_ = (size_t)c * TT + TOK0 + batch * 2048 + 64 * t1;
#pragma unroll
      for (int r = 0; r < ENR; ++r)
#pragma unroll
          for (int kq = 0; kq < 4; ++kq) xg[r][kq] = *(const GAS v2u*)(X0T + tokb_ + 32 * (R0 + r) + 8 * kq + 4 * h); }
    v4u rawv[2] = {{0u, 0u, 0u, 0u}, {0u, 0u, 0u, 0u}};
#pragma unroll
    for (int k = 0; k < 2; ++k) { const int ch = k == 0 ? 0 : 5, nn = L - 64 * (DC0 + ND * ch + ND) + 8 * tid; if (tid < NPR && nn + 8 <= 2 * L) rawv[k] = *(const GAS v4u*)(Rg + nn); }
#pragma unroll 1
    for (int j = 0; j < 5; ++j) {
        if (j < 4) {
            __syncthreads();
            if (tid < NPR) { *(LAS v4u*)(lds + CV_RAW + 16 * tid) = rawv[0]; *(LAS v4u*)(lds + CV_RAW + CV_RSZ + 16 * tid) = rawv[1]; }
#pragma unroll
            for (int k = 0; k < 2; ++k) { const int ch = k == 0 ? j + 1 : (j + 1 < 3 ? 6 + j : 4), nn = L - 64 * (DC0 + ND * ch + ND) + 8 * tid; rawv[k] = (v4u){0u, 0u, 0u, 0u};
                if (j + 1 < 4 && tid < NPR && nn + 8 <= 2 * L) rawv[k] = *(const GAS v4u*)(Rg + nn); }
            __syncthreads();
#define CV_D(k) ((k) == 0 ? lo.x : (k) == 1 ? lo.y : (k) == 2 ? lo.z : (k) == 3 ? lo.w : (k) == 4 ? hi.x : (k) == 5 ? hi.y : (k) == 6 ? hi.z : hi.w)
#define CV_EMIT(s) do { v4u w; if ((s) & 1) { w.x = __builtin_amdgcn_alignbyte(CV_D((s) / 2 + 1), CV_D((s) / 2), 2); w.y = __builtin_amdgcn_alignbyte(CV_D((s) / 2 + 2), CV_D((s) / 2 + 1), 2); \
            w.z = __builtin_amdgcn_alignbyte(CV_D((s) / 2 + 3), CV_D((s) / 2 + 2), 2); w.w = __builtin_amdgcn_alignbyte(CV_D((s) / 2 + 4), CV_D((s) / 2 + 3), 2); } \
        else { w.x = CV_D((s) / 2); w.y = CV_D((s) / 2 + 1); w.z = CV_D((s) / 2 + 2); w.w = CV_D((s) / 2 + 3); } *(LAS v4u*)(dst + (s) * CV_CS) = w; } while (0)
            for (int idx = tid; idx < 4 * NPC; idx += 512) { const int q = idx / NPC, i = idx - q * NPC, win = q >> 1, hh = q & 1;
                const LAS unsigned char* rp = lds + CV_RAW + win * CV_RSZ + 16 * i; const v4u lo = *(const LAS v4u*)rp, hi = *(const LAS v4u*)(rp + 16); LAS unsigned char* dst = lds + CV_FC + win * (8 * CV_CS) + 16 * i;
                if (hh == 0) { CV_EMIT(0); CV_EMIT(1); CV_EMIT(2); CV_EMIT(3); } else { CV_EMIT(4); CV_EMIT(5); CV_EMIT(6); CV_EMIT(7); } }
#undef CV_EMIT
#undef CV_D
            __syncthreads();
        }
        const bool lower = j < 3 ? (g <= j) : (j == 3 ? g < 2 : g >= 2);
        const int ch = lower ? (j < 4 ? j : 3) : (j < 3 ? 5 + j : 4), dc = DC0 + ND * ch, abw = abase0 + (lower ? 0 : 8 * CV_CS);
        constexpr int DSTEP = TRUNK ? 2 : 1;
        int ddlo = dlo - dc > 0 ? dlo - dc : 0; const int ddhi = dhi - dc < ND - 1 ? dhi - dc : ND - 1;
        if (TRUNK) ddlo += ((dc + ddlo) ^ R0) & 1;
        if (ddlo <= ddhi) {
            bf16x8 fb[4], fa[4][NR];
            { const int ab = abw - 128 * ddlo, bb = bbase0 - (dc + ddlo) * CV_BS;
#pragma unroll
              for (int kb = 0; kb < 4; ++kb) { fb[kb] = *(const LAS bf16x8*)(lds + bb + 32 * kb);
#pragma unroll
                  for (int r = 0; r < NR; ++r) fa[kb][r] = *(const LAS bf16x8*)(lds + ab - 64 * r + 32 * kb); } }
#pragma unroll 2
            for (int dd = ddlo; dd <= ddhi; dd += DSTEP) {
                const int dn = dd + DSTEP <= ddhi ? dd + DSTEP : dd; const int ab = abw - 128 * dn, bb = bbase0 - (dc + dn) * CV_BS;
                bf16x8 nb[4], na[4][NR];
#pragma unroll
                for (int kb = 0; kb < 4; ++kb) { nb[kb] = *(const LAS bf16x8*)(lds + bb + 32 * kb);
#pragma unroll
                    for (int r = 0; r < NR; ++r) na[kb][r] = *(const LAS bf16x8*)(lds + ab - 64 * r + 32 * kb); }
#pragma unroll
                for (int kb = 0; kb < 4; ++kb)
#pragma unroll
                    for (int r = 0; r < NR; ++r) acc[r] = __builtin_amdgcn_mfma_f32_32x32x16_bf16(fa[kb][r], fb[kb], acc[r], 0, 0, 0);
#pragma unroll
                for (int kb = 0; kb < 4; ++kb) { fb[kb] = nb[kb];
#pragma unroll
                    for (int r = 0; r < NR; ++r) fa[kb][r] = na[kb][r]; }
            }
        }
    }
    if (TRUNK) {
        __syncthreads();
        LAS f32x4* xb = (LAS f32x4*)(lds + CV_FC);
#pragma unroll
        for (int q = 0; q < 4; ++q) { f32x4 v;
#pragma unroll
            for (int e = 0; e < 4; ++e) v[e] = R0 ? acc[0][4 * q + e] : acc[1][4 * q + e];
            xb[wave * 256 + q * 64 + lane] = v; }
        __syncthreads();
#pragma unroll
        for (int q = 0; q < 4; ++q) { const f32x4 v = xb[(wave ^ 4) * 256 + q * 64 + lane];
#pragma unroll
            for (int e = 0; e < 4; ++e) acc[0][4 * q + e] = (R0 ? acc[1][4 * q + e] : acc[0][4 * q + e]) + v[e]; }
    }
    const size_t tokb = (size_t)c * TT + TOK0 + batch * 2048 + 64 * t1;
#pragma unroll
    for (int r = 0; r < ENR; ++r)
#pragma unroll
        for (int kq = 0; kq < 4; ++kq) { const int t0 = 32 * (R0 + r) + 8 * kq + 4 * h;
            const v2u uu = *(const LAS v2u*)(lds + batch * UBS + (t1 + PADB) * CV_BS + 2 * t0); const v2u xx = xg[r][kq];
            const float y0 = bflo(xx.x) * (acc[r][4 * kq + 0] + bflo(uu.x) * skip), y1 = bfhi(xx.x) * (acc[r][4 * kq + 1] + bfhi(uu.x) * skip);
            const float y2 = bflo(xx.y) * (acc[r][4 * kq + 2] + bflo(uu.y) * skip), y3 = bfhi(xx.y) * (acc[r][4 * kq + 3] + bfhi(uu.y) * skip);
            v2u o; o.x = pk2(y0, y1); o.y = pk2(y2, y3); *(GAS v2u*)(YT + tokb + t0) = o; }
}
__device__ __forceinline__ int crow(int r, int hi) { return (r & 3) + 8 * (r >> 2) + 4 * hi; }
__device__ __forceinline__ unsigned cvtpk(float lo, float hi) { unsigned r; asm volatile("v_cvt_pk_bf16_f32 %0, %1, %2" : "=v"(r) : "v"(lo), "v"(hi)); return r; }
__device__ __forceinline__ void glds16(const void* g, LAS unsigned char* l) { __builtin_amdgcn_global_load_lds((const unsigned*)g, (LAS unsigned*)l, 16, 0, 0); }
__device__ __forceinline__ int v_st(int k, int c) { const int kk = (k & ~0xC) | ((k & 4) << 1) | ((k & 8) >> 1); return ((kk >> 3) * 4 + (c >> 5)) * 512 + ((kk & 7) * 32 + (c & 31)) * 2; }
__device__ __forceinline__ int v_rd_base(int lane) { return ((lane & 3) << 3) | (((lane >> 2) & 3) << 6) | (((lane >> 4) & 1) << 5) | (((lane >> 5) & 1) << 8); }
constexpr int v_rd_off(int d0, int ks, int half) { return d0 * 512 + ks * 4096 + half * 2048; }
__device__ __forceinline__ void v_inv(int P, int& k, int& c) { const int sub = P >> 9, w = (P & 511) >> 1, kk = ((sub >> 2) << 3) | (w >> 5); c = ((sub & 3) << 5) | (w & 31); k = (kk & ~0xC) | ((kk & 4) << 1) | ((kk & 8) >> 1); }
template <int OFF> __device__ __forceinline__ s16x4 tr_read(int vb) { s16x4 r; asm volatile("ds_read_b64_tr_b16 %0, %1 offset:%2" : "=&v"(r) : "v"(vb), "i"(OFF) : "memory"); return r; }
template <int D0> __device__ __forceinline__ void pv_one(f32x16& od, int vb, bf16x8 pa0, bf16x8 pa1, bf16x8 pa2, bf16x8 pa3) {
    const s16x4 l0 = tr_read<v_rd_off(D0, 0, 0)>(vb), h0 = tr_read<v_rd_off(D0, 0, 1)>(vb), l1 = tr_read<v_rd_off(D0, 1, 0)>(vb), h1 = tr_read<v_rd_off(D0, 1, 1)>(vb);
    const s16x4 l2 = tr_read<v_rd_off(D0, 2, 0)>(vb), h2 = tr_read<v_rd_off(D0, 2, 1)>(vb), l3 = tr_read<v_rd_off(D0, 3, 0)>(vb), h3 = tr_read<v_rd_off(D0, 3, 1)>(vb);
    asm volatile("s_waitcnt lgkmcnt(0)" ::: "memory"); SBAR();
#define PKV(Lx, Hx) (bf16x8){Lx[0], Lx[1], Lx[2], Lx[3], Hx[0], Hx[1], Hx[2], Hx[3]}
    od = __builtin_amdgcn_mfma_f32_32x32x16_bf16(pa0, PKV(l0, h0), od, 0, 0, 0);
    od = __builtin_amdgcn_mfma_f32_32x32x16_bf16(pa1, PKV(l1, h1), od, 0, 0, 0);
    od = __builtin_amdgcn_mfma_f32_32x32x16_bf16(pa2, PKV(l2, h2), od, 0, 0, 0);
    od = __builtin_amdgcn_mfma_f32_32x32x16_bf16(pa3, PKV(l3, h3), od, 0, 0, 0);
#undef PKV
}
__device__ __forceinline__ void softmax_p(f32x16& p0, f32x16& p1, float& m_reg, float& l_reg, f32x16 (&o)[4], bf16x8& pa0, bf16x8& pa1, bf16x8& pa2, bf16x8& pa3, LAS float* al, float C, int r32, int hi) {
    float pmax = p0[0];
#pragma unroll
    for (int r = 1; r < 16; ++r) pmax = fmaxf(pmax, p0[r]);
#pragma unroll
    for (int r = 0; r < 16; ++r) pmax = fmaxf(pmax, p1[r]);
    { auto rr = __builtin_amdgcn_permlane32_swap(__float_as_uint(pmax), __float_as_uint(pmax), false, false); pmax = fmaxf(__uint_as_float(rr[0]), __uint_as_float(rr[1])); }
    float mn = m_reg, alpha = 1.f; const bool resc = !__all((pmax - m_reg) * C <= 8.0f * 1.4426950408889634f);
    if (resc) { mn = fmaxf(m_reg, pmax); alpha = __builtin_amdgcn_exp2f((m_reg - mn) * C); m_reg = mn; }
    const float mnC = -mn * C;
    float ps = 0.f;
#pragma unroll
    for (int r = 0; r < 16; ++r) { p0[r] = __builtin_amdgcn_exp2f(fmaf(p0[r], C, mnC)); ps += p0[r]; }
#pragma unroll
    for (int r = 0; r < 16; ++r) { p1[r] = __builtin_amdgcn_exp2f(fmaf(p1[r], C, mnC)); ps += p1[r]; }
    { auto rr = __builtin_amdgcn_permlane32_swap(__float_as_uint(ps), __float_as_uint(ps), false, false); ps = __uint_as_float(rr[0]) + __uint_as_float(rr[1]); }
    l_reg = l_reg * alpha + ps;
    if (resc) { if (hi == 0) al[r32] = alpha; asm volatile("s_waitcnt lgkmcnt(0)" ::: "memory");
#pragma unroll
        for (int d = 0; d < 4; ++d)
#pragma unroll
            for (int r = 0; r < 16; ++r) o[d][r] *= al[crow(r, hi)];
    }
#define PK4(P, BASE, OUT) do { unsigned a0 = cvtpk(P[BASE + 0], P[BASE + 1]), a1 = cvtpk(P[BASE + 2], P[BASE + 3]);   \
    unsigned b0 = cvtpk(P[BASE + 4], P[BASE + 5]), b1 = cvtpk(P[BASE + 6], P[BASE + 7]);                              \
    auto r0 = __builtin_amdgcn_permlane32_swap(a0, b0, false, false); auto r1 = __builtin_amdgcn_permlane32_swap(a1, b1, false, false); \
    v4u w = {r0[0], r1[0], r0[1], r1[1]}; OUT = __builtin_bit_cast(bf16x8, w); } while (0)
    PK4(p0, 0, pa0); PK4(p0, 8, pa1); PK4(p1, 0, pa2); PK4(p1, 8, pa3);
#undef PK4
}
struct VF8 { s16x4 l0, h0, l1, h1, l2, h2, l3, h3; };
template <int D0> __device__ __forceinline__ void vf8_read(VF8& f, int vb) {
    f.l0 = tr_read<v_rd_off(D0, 0, 0)>(vb); f.h0 = tr_read<v_rd_off(D0, 0, 1)>(vb); f.l1 = tr_read<v_rd_off(D0, 1, 0)>(vb); f.h1 = tr_read<v_rd_off(D0, 1, 1)>(vb);
    f.l2 = tr_read<v_rd_off(D0, 2, 0)>(vb); f.h2 = tr_read<v_rd_off(D0, 2, 1)>(vb); f.l3 = tr_read<v_rd_off(D0, 3, 0)>(vb); f.h3 = tr_read<v_rd_off(D0, 3, 1)>(vb); }
__device__ __forceinline__ void vf8_mma(f32x16& od, const VF8& f, bf16x8 pa0, bf16x8 pa1, bf16x8 pa2, bf16x8 pa3) {
#define PKV(Lx, Hx) (bf16x8){Lx[0], Lx[1], Lx[2], Lx[3], Hx[0], Hx[1], Hx[2], Hx[3]}
    od = __builtin_amdgcn_mfma_f32_32x32x16_bf16(pa0, PKV(f.l0, f.h0), od, 0, 0, 0);
    od = __builtin_amdgcn_mfma_f32_32x32x16_bf16(pa1, PKV(f.l1, f.h1), od, 0, 0, 0);
    od = __builtin_amdgcn_mfma_f32_32x32x16_bf16(pa2, PKV(f.l2, f.h2), od, 0, 0, 0);
    od = __builtin_amdgcn_mfma_f32_32x32x16_bf16(pa3, PKV(f.l3, f.h3), od, 0, 0, 0);
#undef PKV
}
__device__ __forceinline__ void pv_all(f32x16 (&o)[4], int vb, bf16x8 pa0, bf16x8 pa1, bf16x8 pa2, bf16x8 pa3) {
    VF8 fa, fb;
    SBAR(); __builtin_amdgcn_s_setprio(1);
    vf8_read<0>(fa, vb); asm volatile("s_waitcnt lgkmcnt(0)" ::: "memory"); SBAR();
    vf8_read<1>(fb, vb); vf8_mma(o[0], fa, pa0, pa1, pa2, pa3); asm volatile("s_waitcnt lgkmcnt(0)" ::: "memory"); SBAR();
    vf8_read<2>(fa, vb); vf8_mma(o[1], fb, pa0, pa1, pa2, pa3); asm volatile("s_waitcnt lgkmcnt(0)" ::: "memory"); SBAR();
    vf8_read<3>(fb, vb); vf8_mma(o[2], fa, pa0, pa1, pa2, pa3); asm volatile("s_waitcnt lgkmcnt(0)" ::: "memory"); SBAR();
    vf8_mma(o[3], fb, pa0, pa1, pa2, pa3);
    __builtin_amdgcn_s_setprio(0);
}
__device__ __forceinline__ void softmax_pv(f32x16& p0, f32x16& p1, float& m_reg, float& l_reg, f32x16 (&o)[4], int vb, LAS float* al, float C, int r32, int hi) {
    bf16x8 pa0, pa1, pa2, pa3; softmax_p(p0, p1, m_reg, l_reg, o, pa0, pa1, pa2, pa3, al, C, r32, hi); pv_all(o, vb, pa0, pa1, pa2, pa3);
}
#define ATTN_STORE_O(ROWPTR_EXPR) do { if (hi == 0) al[r32] = l_reg; asm volatile("s_waitcnt lgkmcnt(0)" ::: "memory"); \
    _Pragma("unroll") for (int r = 0; r < 16; ++r) { const int qi = crow(r, hi); const float rl = __builtin_amdgcn_rcpf(al[qi]); bf16* op = (ROWPTR_EXPR); \
        _Pragma("unroll") for (int d0 = 0; d0 < 4; ++d0) op[d0 * 32 + r32] = (bf16)f2bf(o[d0][r] * rl); } } while (0)

constexpr int MLA_KB = 32768, MLA_VB = 16384, MLA_BUF = MLA_KB + MLA_VB;
__device__ __forceinline__ void mla_stage(const bf16* KV, const bf16* KR, int krow0, int head, LAS unsigned char* buf, int tid, int wave) {
#pragma unroll
    for (int i = 0; i < 4; ++i) { const int P = i * 512 + tid, row = P >> 5, c = (P & 31) ^ (row & 15);
        const bf16* src = c < 16 ? KV + (size_t)(krow0 + row) * KVC + head * 256 + c * 8 : KR + (size_t)(krow0 + row) * 64 + (c < 24 ? (c - 16) * 8 : 0);
        glds16(src, buf + (i * 512 + wave * 64) * 16); }
#pragma unroll
    for (int i = 0; i < 2; ++i) { const int P = (i * 512 + tid) * 16; int k, c; v_inv(P, k, c);
        glds16(KV + (size_t)(krow0 + k) * KVC + head * 256 + 128 + c, buf + MLA_KB + (i * 512 + wave * 64) * 16); }
}
struct MlaSrc { unsigned o[6]; unsigned kvm; };
__device__ __forceinline__ void mla_src_init(MlaSrc& s, const bf16* KV, const bf16* KR, int krow0, int head, int tid) {
    const unsigned dkr = (unsigned)((const char*)KR - (const char*)KV);
    s.kvm = 0u;
#pragma unroll
    for (int i = 0; i < 4; ++i) { const int P = i * 512 + tid, row = P >> 5, c = (P & 31) ^ (row & 15);
        s.o[i] = c < 16 ? (unsigned)(((krow0 + row) * KVC + head * 256 + c * 8) * 2) : dkr + (unsigned)(((krow0 + row) * 64 + (c < 24 ? (c - 16) * 8 : 0)) * 2); s.kvm |= (c < 16 ? 1u : 0u) << i; }
#pragma unroll
    for (int i = 0; i < 2; ++i) { const int P = (i * 512 + tid) * 16; int k, c; v_inv(P, k, c); s.o[4 + i] = (unsigned)(((krow0 + k) * KVC + head * 256 + 128 + c) * 2); }
}
__device__ __forceinline__ void mla_stage_adv(MlaSrc& s, const bf16* KV, LAS unsigned char* buf, int wave) {
#pragma unroll
    for (int i = 0; i < 4; ++i) { glds16((const char*)KV + s.o[i], buf + (i * 512 + wave * 64) * 16); s.o[i] += ((s.kvm >> i) & 1u) ? 64u * KVC * 2u : 64u * 64u * 2u; }
#pragma unroll
    for (int i = 0; i < 2; ++i) { glds16((const char*)KV + s.o[4 + i], buf + MLA_KB + (i * 512 + wave * 64) * 16); s.o[4 + i] += 64u * KVC * 2u; }
}
__device__ __forceinline__ void mla_unit(const bf16* Q, const bf16* KV, const bf16* KR, const float* gqn, const float* gqr, const GAS f32x2v* R64, bf16* O, int opitch, int row0  , int L, int head, int qb, LAS unsigned char* lds, int tid, int lane, int wave) {
    const int r32 = lane & 31, hi = lane >> 5; constexpr float C = 0.07216878364870322f * 1.4426950408889634f;
    LAS float* al = (LAS float*)(lds + WSCR_OFF + wave * 128);
    const int qrow = row0 + qb * 256 + wave * 32 + r32;
    __syncthreads();
    MlaSrc src; mla_src_init(src, KV, KR, row0, head, tid);
    mla_stage_adv(src, KV, lds, wave);
    bf16x8 qr[12];
    {   const bf16* qn_p = Q + (size_t)qrow * QC + head * 128 + hi * 8; const bf16* qr_p = Q + (size_t)qrow * QC + 1536 + head * 64 + hi * 8;
        float sn = 0.f, sr = 0.f;
#pragma unroll
        for (int d0 = 0; d0 < 12; ++d0) { float x[8]; unpack8(*(const GAS v4u*)(d0 < 8 ? qn_p + d0 * 16 : qr_p + (d0 - 8) * 16), x); float s = 0.f;
#pragma unroll
            for (int e = 0; e < 8; ++e) s += x[e] * x[e];
            if (d0 < 8) sn += s; else sr += s; }
        sn += __shfl_xor(sn, 32); sr += __shfl_xor(sr, 32);
        const float rn = 1.0f / sqrtf(sn * (1.0f / 128.0f) + EPS), rr = 1.0f / sqrtf(sr * (1.0f / 64.0f) + EPS);
#pragma unroll
        for (int d0 = 0; d0 < 8; ++d0) { float x[8], y[8]; unpack8(*(const GAS v4u*)(qn_p + d0 * 16), x); const GAS f32x4* gp = (const GAS f32x4*)(gqn + d0 * 16 + hi * 8); const f32x4 g0 = gp[0], g1 = gp[1];
            y[0] = x[0] * rn * g0.x; y[1] = x[1] * rn * g0.y; y[2] = x[2] * rn * g0.z; y[3] = x[3] * rn * g0.w; y[4] = x[4] * rn * g1.x; y[5] = x[5] * rn * g1.y; y[6] = x[6] * rn * g1.z; y[7] = x[7] * rn * g1.w;
            qr[d0] = __builtin_bit_cast(bf16x8, pack8(y)); asm volatile("" ::: "memory"); }
        const int pos = qb * 256 + wave * 32 + r32;
#pragma unroll
        for (int d0 = 0; d0 < 2; ++d0) {
            float x1[8], x2[8], y1[8], y2[8]; unpack8(*(const GAS v4u*)(qr_p + d0 * 16), x1); unpack8(*(const GAS v4u*)(qr_p + (d0 + 2) * 16), x2); const int i0 = d0 * 16 + hi * 8;
            const GAS f32x4* ct = (const GAS f32x4*)(R64 + pos * 32 + i0); const f32x4 c01 = ct[0], c23 = ct[1], c45 = ct[2], c67 = ct[3];
            const float cs[16] = {c01.x, c01.y, c01.z, c01.w, c23.x, c23.y, c23.z, c23.w, c45.x, c45.y, c45.z, c45.w, c67.x, c67.y, c67.z, c67.w};
#pragma unroll
            for (int e = 0; e < 8; ++e) { const float a = x1[e] * rr * gqr[i0 + e], b = x2[e] * rr * gqr[32 + i0 + e]; y1[e] = a * cs[2 * e] - b * cs[2 * e + 1]; y2[e] = b * cs[2 * e] + a * cs[2 * e + 1]; }
            qr[8 + d0] = __builtin_bit_cast(bf16x8, pack8(y1)); qr[10 + d0] = __builtin_bit_cast(bf16x8, pack8(y2)); asm volatile("" ::: "memory"); }
    }
    float m_reg = -1e30f, l_reg = 0.f; f32x16 o[4];
#pragma unroll
    for (int d = 0; d < 4; ++d) o[d] = (f32x16){0.f, 0.f, 0.f, 0.f, 0.f, 0.f, 0.f, 0.f, 0.f, 0.f, 0.f, 0.f, 0.f, 0.f, 0.f, 0.f};
    const int NT = L / 64;
#pragma unroll 1
    for (int j = 0; j < NT; ++j) {
        LAS unsigned char* cur = lds + (j & 1) * MLA_BUF;
        asm volatile("s_waitcnt vmcnt(0)" ::: "memory"); __syncthreads();
        if (j + 1 < NT) mla_stage_adv(src, KV, lds + ((j + 1) & 1) * MLA_BUF, wave);
        f32x16 p0 = (f32x16){0.f, 0.f, 0.f, 0.f, 0.f, 0.f, 0.f, 0.f, 0.f, 0.f, 0.f, 0.f, 0.f, 0.f, 0.f, 0.f}, p1 = p0;
        __builtin_amdgcn_s_setprio(1);
#pragma unroll
        for (int d0 = 0; d0 < 12; ++d0) { const int c = 2 * d0 + hi;
            const bf16x8 b0 = *(const LAS bf16x8*)(cur + r32 * 512 + ((c ^ (r32 & 15)) << 4));
            const bf16x8 b1 = *(const LAS bf16x8*)(cur + (32 + r32) * 512 + ((c ^ (r32 & 15)) << 4));
            p0 = __builtin_amdgcn_mfma_f32_32x32x16_bf16(b0, qr[d0], p0, 0, 0, 0);
            p1 = __builtin_amdgcn_mfma_f32_32x32x16_bf16(b1, qr[d0], p1, 0, 0, 0); }
        __builtin_amdgcn_s_setprio(0);
        softmax_pv(p0, p1, m_reg, l_reg, o, (int)(unsigned)(uintptr_t)(cur + MLA_KB) + v_rd_base(lane), al, C, r32, hi);
    }
    ATTN_STORE_O(O + (size_t)(row0 + qb * 256 + wave * 32 + qi) * opitch + head * 128);
}
__device__ __forceinline__ void mla_phase(const bf16* Q, const bf16* KV, const bf16* KR, const float* gqn, const float* gqr, const GAS f32x2v* R64, bf16* O, int opitch, LAS unsigned char* lds, int tid, int lane, int wave, int bid, int G) {
    const bool bal = (G == 256); const int x = bid & 7, li = bid >> 3;
    const int nS = bal ? (li < 16 ? 2 : 1) : (bid < 384 ? (384 - bid + G - 1) / G : 0), nP = bal ? (li < 16 ? 1 : 5) : (bid < 768 ? (768 - bid + G - 1) / G : 0);
#pragma unroll 1
    for (int i = 0; i < nS + nP; ++i) {
        int row0, L, head, qb;
        if (i < nS) { const int u = bal ? 48 * x + (li < 16 ? 2 * li + i : 16 + li) : bid + i * G; row0 = TP; L = 8192; head = u / 32; qb = u % 32; }
        else { const int k = i - nS, u = bal ? 96 * x + (li < 16 ? li : 16 + 5 * (li - 16) + k) : bid + k * G; row0 = (u / 96) * 2048; L = 2048; head = (u % 96) / 8; qb = u % 8; }
        mla_unit(Q, KV, KR, gqn, gqr, R64, O, opitch, row0, L, head, qb, lds, tid, lane, wave);
    }
}
__device__ __forceinline__ void dil_unit(const bf16* Z, bf16* O, int opitch, float* DLSE, int wu, LAS unsigned char* lds, int tid, int lane, int wave) {
    const int r32 = lane & 31, hi = lane >> 5, sub = wave >> 1, tl = tid & 127; constexpr float C = 0.08838834764831845f * 1.4426950408889634f;
    const int hd = wu % 12, quad = wu / 12, gb = quad * 4 + sub, grp = hd >> 2, dil = grp == 0 ? 1 : (grp == 1 ? 4 : 16);
    const int row0 = gb < 256 ? (gb >> 5) * 2048 : TP, L = gb < 256 ? 2048 : 8192, bi = gb < 256 ? (gb & 31) : gb - 256;
    const int res = bi % dil, blk = bi / dil, nblk = L / 64 / dil;
    LAS unsigned char* kb = lds + sub * 32768; LAS unsigned char* vbuf = kb + 16384;
    LAS float* al = (LAS float*)(lds + WSCR_OFF + wave * 128);
    const int qi_l = 32 * (wave & 1) + r32; const size_t qrow = (size_t)(row0 + (blk * 64 + qi_l) * dil + res);
    bf16x8 qr[8];
#pragma unroll
    for (int d0 = 0; d0 < 8; ++d0) qr[d0] = *(const GAS bf16x8*)(Z + qrow * ZC + Z_DQ + hd * 128 + d0 * 16 + hi * 8);
    float m_reg = -1e30f, l_reg = 0.f; f32x16 o[4];
#pragma unroll
    for (int d = 0; d < 4; ++d) o[d] = (f32x16){0.f, 0.f, 0.f, 0.f, 0.f, 0.f, 0.f, 0.f, 0.f, 0.f, 0.f, 0.f, 0.f, 0.f, 0.f, 0.f};
#pragma unroll 1
    for (int ti = 0; ti < 3; ++ti) {
        const int dt = ti == 0 ? 0 : (ti == 1 ? -1 : 1); const int kblk = blk + dt; const bool tvalid = kblk >= 0 && kblk < nblk; const int kbc = tvalid ? kblk : blk;
        __syncthreads();
#pragma unroll
        for (int i = 0; i < 8; ++i) { const int P = (i * 128 + tl) * 16, row = P >> 8, cb = (P & 255) ^ ((row & 7) << 4);
            glds16(Z + (size_t)(row0 + (kbc * 64 + row) * dil + res) * ZC + Z_DK + hd * 128 + (cb >> 1), kb + (i * 128 + (wave & 1) * 64) * 16); }
#pragma unroll
        for (int i = 0; i < 8; ++i) { const int P = (i * 128 + tl) * 16; int k, c; v_inv(P, k, c);
            glds16(Z + (size_t)(row0 + (kbc * 64 + k) * dil + res) * ZC + Z_DV + hd * 128 + c, vbuf + (i * 128 + (wave & 1) * 64) * 16); }
        asm volatile("s_waitcnt vmcnt(0)" ::: "memory"); __syncthreads();
        f32x16 p0 = (f32x16){0.f, 0.f, 0.f, 0.f, 0.f, 0.f, 0.f, 0.f, 0.f, 0.f, 0.f, 0.f, 0.f, 0.f, 0.f, 0.f}, p1 = p0;
#pragma unroll
        for (int d0 = 0; d0 < 8; ++d0) { const int cb = d0 * 32 + hi * 16;
            const bf16x8 b0 = *(const LAS bf16x8*)(kb + r32 * 256 + (cb ^ ((r32 & 7) << 4)));
            const bf16x8 b1 = *(const LAS bf16x8*)(kb + (32 + r32) * 256 + (cb ^ ((r32 & 7) << 4)));
            p0 = __builtin_amdgcn_mfma_f32_32x32x16_bf16(b0, qr[d0], p0, 0, 0, 0);
            p1 = __builtin_amdgcn_mfma_f32_32x32x16_bf16(b1, qr[d0], p1, 0, 0, 0); }
        if (ti != 0) {
#pragma unroll
            for (int r = 0; r < 16; ++r) { const int k0 = crow(r, hi), k1 = 32 + k0;
                const bool v0 = tvalid && (dt < 0 ? k0 >= qi_l : k0 <= qi_l), v1 = tvalid && (dt < 0 ? k1 >= qi_l : k1 <= qi_l);
                p0[r] = v0 ? p0[r] : -1e30f; p1[r] = v1 ? p1[r] : -1e30f; }
        }
        softmax_pv(p0, p1, m_reg, l_reg, o, (int)(unsigned)(uintptr_t)vbuf + v_rd_base(lane), al, C, r32, hi);
    }
    if (hi == 0) DLSE[(qrow) * 12 + hd] = m_reg * 0.08838834764831845f + logf(l_reg);
    __syncthreads();
    ATTN_STORE_O(O + (size_t)(row0 + (blk * 64 + 32 * (wave & 1) + qi) * dil + res) * opitch + hd * 128);
}
__device__ __forceinline__ void mixnorm_hyena(int tb, const bf16* YT, const float* gout, bf16* MX, LAS unsigned char* lds, int tid, int lane, int wave) {
    LAS float* ssq = (LAS float*)(lds);
    LAS float* rstd = (LAS float*)(lds + 2048);
    LAS bf16* tile = (LAS bf16*)(lds + 4096);
    const int c = tid >> 3, t8 = (tid & 7) * 8, m0 = tb * 64;
    v4u xw[16];
#pragma unroll
    for (int ck = 0; ck < 16; ++ck) xw[ck] = *(const GAS v4u*)(YT + (size_t)(ck * 64 + c) * TT + m0 + t8);
    __syncthreads();
    float ps[8];
#pragma unroll
    for (int e = 0; e < 8; ++e) ps[e] = 0.f;
#pragma unroll
    for (int ck = 0; ck < 16; ++ck) { float x[8]; unpack8(xw[ck], x);
#pragma unroll
        for (int e = 0; e < 8; ++e) ps[e] += x[e] * x[e]; }
#pragma unroll
    for (int e = 0; e < 8; ++e) { ps[e] += __shfl_xor(ps[e], 8); ps[e] += __shfl_xor(ps[e], 16); ps[e] += __shfl_xor(ps[e], 32); }
    if (lane < 8) {
#pragma unroll
        for (int e = 0; e < 8; ++e) ssq[wave * 64 + lane * 8 + e] = ps[e]; }
    __syncthreads();
    if (tid < 64) { float s = 0.f;
#pragma unroll
        for (int w = 0; w < 8; ++w) s += ssq[w * 64 + tid];
        rstd[tid] = 1.0f / sqrtf(s * (1.0f / 1024.0f) + EPS); }
    __syncthreads();
    float rt[8];
#pragma unroll
    for (int e = 0; e < 8; ++e) rt[e] = rstd[t8 + e];
#pragma unroll
    for (int half = 0; half < 2; ++half) {
#pragma unroll
        for (int k = 0; k < 8; ++k) { const int ck = half * 8 + k; float x[8]; unpack8(xw[ck], x); const float gg = gout[ck * 64 + c];
#pragma unroll
            for (int e = 0; e < 8; ++e) tile[k * (64 * 66) + c * 66 + t8 + e] = (bf16)f2bf(x[e] * rt[e] * gg); }
        __syncthreads();
        { const int t = tid >> 3, c8 = (tid & 7) * 8;
#pragma unroll
          for (int k = 0; k < 8; ++k) { const LAS bf16* tk = tile + k * (64 * 66); v4u w;
              w.x = (unsigned)tk[(c8 + 0) * 66 + t] | ((unsigned)tk[(c8 + 1) * 66 + t] << 16); w.y = (unsigned)tk[(c8 + 2) * 66 + t] | ((unsigned)tk[(c8 + 3) * 66 + t] << 16);
              w.z = (unsigned)tk[(c8 + 4) * 66 + t] | ((unsigned)tk[(c8 + 5) * 66 + t] << 16); w.w = (unsigned)tk[(c8 + 6) * 66 + t] | ((unsigned)tk[(c8 + 7) * 66 + t] << 16);
              *(GAS v4u*)(MX + (size_t)(m0 + t) * DM + (half * 8 + k) * 64 + c8) = w; } }
        __syncthreads();
    }
}
__device__ __forceinline__ void mixnorm_tokens(const bf16* Q, const bf16* Z, const float* DLSE, const float* gout, bf16* MX, int gw, int NGW, int lane) {
    for (int m = gw; m < TT; m += NGW) {
        v4u qw[3], zw[3];
#pragma unroll
        for (int j = 0; j < 3; ++j) { qw[j] = *(const GAS v4u*)(Q + (size_t)m * QC + lane * 8 + 512 * j); zw[j] = *(const GAS v4u*)(Z + (size_t)m * ZC + Z_DQ + lane * 8 + 512 * j); }
        {   float x[3][8]; float s = 0.f;
#pragma unroll
            for (int j = 0; j < 3; ++j) { unpack8(qw[j], x[j]);
#pragma unroll
                for (int e = 0; e < 8; ++e) s += x[j][e] * x[j][e]; }
            const float rs = 1.0f / sqrtf(wave_sum(s) * (1.0f / 1536.0f) + EPS);
#pragma unroll
            for (int j = 0; j < 3; ++j) { const int cc = lane * 8 + 512 * j; float y[8];
#pragma unroll
                for (int e = 0; e < 8; ++e) y[e] = x[j][e] * rs * gout[1024 + cc + e];
                *(GAS v4u*)(MX + (size_t)m * DM + 1024 + cc) = pack8(y); }
        }
        {   float x[3][8]; float s = 0.f;
#pragma unroll
            for (int j = 0; j < 3; ++j) { const int cc = lane * 8 + 512 * j, hd = cc >> 7, slot = hd & 3;
                const float l0 = DLSE[(size_t)m * 12 + slot], l1 = DLSE[(size_t)m * 12 + 4 + slot], l2 = DLSE[(size_t)m * 12 + 8 + slot], lm = fmaxf(l0, fmaxf(l1, l2));
                const float e0 = expf(l0 - lm), e1 = expf(l1 - lm), e2 = expf(l2 - lm), mine = (hd >> 2) == 0 ? e0 : ((hd >> 2) == 1 ? e1 : e2), alpha = mine / (e0 + e1 + e2);
                unpack8(zw[j], x[j]);
#pragma unroll
                for (int e = 0; e < 8; ++e) { x[j][e] *= alpha; s += x[j][e] * x[j][e]; } }
            const float rs = 1.0f / sqrtf(wave_sum(s) * (1.0f / 1536.0f) + EPS);
#pragma unroll
            for (int j = 0; j < 3; ++j) { const int cc = lane * 8 + 512 * j; float y[8];
#pragma unroll
                for (int e = 0; e < 8; ++e) y[e] = x[j][e] * rs * gout[2560 + cc + e];
                *(GAS v4u*)(MX + (size_t)m * DM + 2560 + cc) = pack8(y); }
        }
    }
}
#ifndef MK_N_LAUNCHES
#define MK_N_LAUNCHES 1
#endif
struct Args { const float* in[31]; float* out; unsigned char* ws; int ph_lo, ph_hi, li, pad; };
__global__ void __launch_bounds__(NWAVES * 64, 2) fwd(Args args) {
    extern __shared__ __attribute__((aligned(16))) unsigned char lds_raw[];
    LAS unsigned char* lds = (LAS unsigned char*)lds_raw;
    const int tid = threadIdx.x, wave = __builtin_amdgcn_readfirstlane(tid >> 6), G = gridDim.x, bid = blockIdx.x;
    const int NGW = G * NWAVES, NGT = G * NWAVES * 64;
    for (int u = tid; u < (PTAB_OFF - LDSCTL_OFF) / 4; u += NWAVES * 64) ((LAS unsigned*)(lds + LDSCTL_OFF))[u] = 0u;
    __syncthreads();
    const int lo = args.ph_lo, hi = args.ph_hi;
    XcdBarrier bar; bar.bar = (unsigned*)(args.ws + WS_CTL) + CW_BAR; bar.x = 0; bar.st = nullptr;
    if (hi - lo > 1) bar = xcd_barrier_post((unsigned*)(args.ws + WS_CTL) + CW_BAR, (volatile LAS unsigned*)(lds + MISC_OFF) + 8);
#define IN(k) (lo <= (k) && (k) < hi)
#define SEAM(k) do { if (IN(k) && IN((k) + 1)) xcd_barrier(bar); } while (0)
#define OPQ() int tid_ = tid, wave_ = wave; asm volatile("" : "+v"(tid_), "+s"(wave_)); tid_ &= 511; wave_ &= 7; const InTab in_{args.in}; unsigned char* const ws_ = args.ws; float* const out_ = args.out; (void)ws_; (void)out_; \
    const int lane_ = tid_ & 63, gw_ = bid * NWAVES + wave_, gt_ = bid * (NWAVES * 64) + tid_; (void)lane_; (void)gw_; (void)gt_
#define P_MIX ((bf16*)(ws_ + WS_MIX))
#define P_Z ((bf16*)(ws_ + WS_Z))
#define P_Q ((bf16*)(ws_ + WS_Q))
#define P_KV ((bf16*)(ws_ + WS_KV))
#define P_UT ((bf16*)(ws_ + WS_UT))
#define P_A2 ((bf16*)(ws_ + WS_A2))
#define P_CQ ((bf16*)(ws_ + WS_CQ))
#define P_CKV ((bf16*)(ws_ + WS_CKV))
#define P_KR ((bf16*)(ws_ + WS_KR))
#define P_X0T ((bf16*)(ws_ + WS_X0T))
#define P_YT ((bf16*)(ws_ + WS_YT))
#define P_DLSE ((float*)(ws_ + WS_DLSE))
#define P_XP (in_[0])
#define P_XS (in_[1] - (size_t)TP * DM)
#define P_WL (ws_ + WS_WT + (size_t)l * WT_LAYER)
#define P_XB ((bf16*)(ws_ + WS_XB))
#define P_SSQ(i) ((float*)(ws_ + WS_SSQ) + (size_t)(i) * TT)
#define P_SSQP ((float*)(ws_ + WS_SSQP))

    if (IN(0)) {
        OPQ();
        for (int it = bid; it < NLAYER * 160; it += G) { const int layer = it / 160, r = it % 160; filter_item(in_, ws_, layer, r >= 32 ? 1 : 0, r >= 32 ? r - 32 : r, lds, tid_, lane_, wave_); }
        p0_weights(in_, ws_, (LAS float*)(lds + wave_ * 16384), gw_, NGW, lane_);
        p0_misc(ws_, gt_, NGT);
        cvt_rows(P_XP, P_XS, P_XB, P_SSQ(0), gw_, NGW, lane_);
    }
    SEAM(0);
#pragma unroll 1
    for (int l = 0; l < NLAYER; ++l) {
        const int pb = 1 + l * NPH_LAYER;
        if (IN(pb + 0)) {
            OPQ(); pg8::Gemm g{P_XB, (const bf16*)(P_WL + WT_IN), TT, ZC, DM}; pg8::StaticOrder S; S.init(TT, ZC, G, bid);
            pg8::EpiInProj E{P_Z, ZC, P_SSQ(2 * l), in_[24] + l * 128, in_[25] + l * 128, (const float*)(ws_ + WS_R128), (LAS float*)(lds + KVTAB_OFF)};
            pg8::gemm_phase<pg8::EpiInProj, pg8::StaticOrder, true, true>(lds, g, S, E);
        }
        SEAM(pb + 0);
        if (IN(pb + 1)) {
            OPQ();
            prep_hyena(P_Z, in_[4] + (size_t)l * 3 * 3072, in_[5] + (size_t)l * 3072, P_UT, P_X0T, lds, tid_, bid, G);
            prep_tokens(P_Z, in_, l, ws_, gw_, NGW, lane_);
        }
        SEAM(pb + 1);
        if (IN(pb + 2)) {
            { OPQ(); pg8::Gemm g{P_CQ, (const bf16*)(P_WL + WT_QB), TT, QC, 1536}; pg8::StaticOrder S; S.init(TT, QC, G, bid); pg8::EpiBf16<0> E{P_Q, QC, nullptr};
              pg8::gemm_phase<pg8::EpiBf16<0>, pg8::StaticOrder, true, true>(lds, g, S, E); }
            { OPQ(); pg8::Gemm g{P_CKV, (const bf16*)(P_WL + WT_KVB), TT, KVC, 512}; pg8::StaticOrder S; S.init(TT, KVC, G, (bid + (G >> 1)) % G);     pg8::EpiKv E{P_KV, KVC, in_[22] + l * 128, (LAS float*)(lds + KVTAB_OFF)};
              pg8::gemm_phase<pg8::EpiKv, pg8::StaticOrder, true, true>(lds, g, S, E); }
            { OPQ(); const unsigned char* fl = ws_ + WS_FILT + (size_t)l * FILT_LAYER;
              v4u upre[4] = {{0u, 0u, 0u, 0u}, {0u, 0u, 0u, 0u}, {0u, 0u, 0u, 0u}, {0u, 0u, 0u, 0u}}; bool pv = false;
              for (int u = bid; u < 2048; u += G) {
                  const int c = u & 1023; const float skip = in_[15][l * 1024 + c];
                  const int un = u + G; const bf16* nxt = un < 2048 ? P_UT + (size_t)(un & 1023) * TT + (un >= 1024 ? TP : 0) : nullptr; const int nnp = un >= 1024 ? 2 : 4;
                  if (u < 1024) conv_unit<0>(c, (const bf16*)fl + (size_t)c * 4096, P_UT, P_X0T, P_YT, skip, lds, tid_, lane_, wave_, upre, pv, nxt, nnp);
                  else conv_unit<1>(c, (const bf16*)(fl + FILT_S_OFF) + (size_t)c * 16384, P_UT, P_X0T, P_YT, skip, lds, tid_, lane_, wave_, upre, pv, nxt, nnp);
                  pv = nxt != nullptr;
              } }
            { OPQ(); for (int wu = (bid + (G >> 1)) % G; wu < 1152; wu += G) dil_unit(P_Z, P_Z + Z_DQ, ZC, P_DLSE, wu, lds, tid_, lane_, wave_); }
        }
        SEAM(pb + 2);
        if (IN(pb + 3)) { OPQ(); mla_phase(P_Q, P_KV, P_KR, in_[20] + l * 128, in_[21] + l * 64, (const GAS f32x2v*)(ws_ + WS_R64), P_Q, QC, lds, tid_, lane_, wave_, bid, G); }
        SEAM(pb + 3);
        if (IN(pb + 4)) { OPQ(); for (int tb = bid; tb < 384; tb += G) mixnorm_hyena(tb, P_YT, in_[26] + (size_t)l * DM, P_MIX, lds, tid_, lane_, wave_);
            mixnorm_tokens(P_Q, P_Z, P_DLSE, in_[26] + (size_t)l * DM, P_MIX, gw_, NGW, lane_); }
        SEAM(pb + 4);
        if (IN(pb + 5)) {
            OPQ(); pg8::Gemm g{P_MIX, (const bf16*)(P_WL + WT_OUT), TT, DM, DM}; pg8::StaticOrder S; S.init(TT, DM, G, bid);
            { pg8::EpiRes<false, false> E{nullptr, nullptr, 0, P_XB, P_SSQP, nullptr, (LAS float*)(lds + KVTAB_OFF)}; pg8::gemm_phase<pg8::EpiRes<false, false>, pg8::StaticOrder, true, true>(lds, g, S, E); }
        }
        SEAM(pb + 5);
        if (IN(pb + 6)) { OPQ(); rstd_rows(P_SSQP, P_SSQ(2 * l + 1), gt_, NGT); }
        SEAM(pb + 6);
        if (IN(pb + 7)) {
            OPQ(); pg8::Gemm g{P_XB, (const bf16*)(P_WL + WT_UP), TT, DFF, DM}; pg8::StaticOrder S; S.init(TT, DFF, G, bid); pg8::EpiBf16<1> E{P_A2, DFF, P_SSQ(2 * l + 1)};
            pg8::gemm_phase<pg8::EpiBf16<1>, pg8::StaticOrder, true, true>(lds, g, S, E);
        }
        SEAM(pb + 7);
        if (IN(pb + 8)) {
            OPQ(); pg8::Gemm g{P_A2, (const bf16*)(P_WL + WT_DN), TT, DM, DFF}; pg8::StaticOrder S; S.init(TT, DM, G, bid);
            if (l + 1 < NLAYER) { pg8::EpiRes<false, false> E{nullptr, nullptr, 0, P_XB, P_SSQP, nullptr, (LAS float*)(lds + KVTAB_OFF)}; pg8::gemm_phase<pg8::EpiRes<false, false>, pg8::StaticOrder, true, true>(lds, g, S, E); }
            else { pg8::EpiRes<false, true> E{nullptr, nullptr, 0, P_XB, nullptr, out_, (LAS float*)(lds + KVTAB_OFF)}; pg8::gemm_phase<pg8::EpiRes<false, true>, pg8::StaticOrder, true, true>(lds, g, S, E); }
        }
        if (l + 1 < NLAYER) SEAM(pb + 8);
        if (IN(pb + 9) && l + 1 < NLAYER) { OPQ(); rstd_rows(P_SSQP, P_SSQ(2 * l + 2), gt_, NGT); }
        SEAM(pb + 9);
    }
#undef IN
#undef SEAM
}

extern "C" void kernel_launch(void* const* d_in, const int* in_sizes, int n_in, void* d_out, int out_size, void* d_ws, size_t ws_size, hipStream_t stream) {
    static int grid = 0;
    if (grid == 0) {
        if (n_in != 31 || in_sizes[0] != TP * DM || in_sizes[1] != TS * DM || out_size != TT * DM || ws_size < WS_END) {
            fprintf(stderr, "kernel_launch: shape mismatch: n_in %d in0 %d in1 %d out %d ws %zu (need >= %zu); nothing launched\n", n_in, n_in > 0 ? in_sizes[0] : -1, n_in > 1 ? in_sizes[1] : -1, out_size, ws_size, (size_t)WS_END); grid = -1; return; }
        int dev = 0, cus = 0, per_cu = 0;
        if (hipGetDevice(&dev) != hipSuccess || hipDeviceGetAttribute(&cus, hipDeviceAttributeMultiprocessorCount, dev) != hipSuccess) { fprintf(stderr, "kernel_launch: device query failed\n"); grid = -1; return; }
        if (hipFuncSetAttribute((const void*)fwd, hipFuncAttributeMaxDynamicSharedMemorySize, LDS_BYTES) != hipSuccess) { fprintf(stderr, "kernel_launch: hipFuncSetAttribute failed\n"); grid = -1; return; }
        if (hipOccupancyMaxActiveBlocksPerMultiprocessor(&per_cu, (const void*)fwd, NWAVES * 64, LDS_BYTES) != hipSuccess || per_cu < 1) fprintf(stderr, "kernel_launch: occupancy query says %d\n", per_cu);
        (void)hipGetLastError();
        grid = cus;
    }
    if (grid < 0) return;
    if (hipMemsetAsync((char*)d_ws + WS_CTL, 0, CTL_ZERO_BYTES, stream) != hipSuccess) { fprintf(stderr, "kernel_launch: memset failed\n"); return; }
    Args a{};
    for (int i = 0; i < 31; ++i) a.in[i] = (const float*)d_in[i];
    a.out = (float*)d_out; a.ws = (unsigned char*)d_ws;
    if (MK_N_LAUNCHES == 1) { a.ph_lo = 0; a.ph_hi = NPHASES; a.li = 0; hipLaunchKernelGGL(fwd, dim3(grid), dim3(NWAVES * 64), LDS_BYTES, stream, a); }
    else for (int p = 0; p < NPHASES; ++p) { a.ph_lo = p; a.ph_hi = p + 1; a.li = p; hipLaunchKernelGGL(fwd, dim3(grid), dim3(NWAVES * 64), LDS_BYTES, stream, a); }
    const hipError_t le = hipPeekAtLastError();
    if (le != hipSuccess) fprintf(stderr, "kernel_launch: launch failed: %s\n", hipGetErrorName(le));
}
```

```cpp
#include <hip/hip_runtime.h>
#include <cstdio>
#include <cstdint>
#define MK_N_LAUNCHES 1
namespace pg8 {
#define PG8_LAS __attribute__((address_space(3)))
typedef unsigned short bf16_t;
typedef short bf16x8 __attribute__((ext_vector_type(8)));
typedef float f32x4 __attribute__((ext_vector_type(4)));
typedef unsigned u32x4 __attribute__((ext_vector_type(4)));
constexpr int BM = 256, BK = 64, HALF = 128, HTB = HALF * BK * 2  , STAGE_BYTES = 8 * HTB, NXCD = 8, WGM = 8;

__host__ __device__ __forceinline__ int lds_byte(int r, int c) { const int st = (r >> 4) * 2 + (c >> 5), rr = r & 15, cc = c & 31, ob = rr * 64 + cc * 2; return st * 1024 + (ob ^ (((ob >> 9) & 1) << 5)); }
__host__ __device__ __forceinline__ void stage_rc(int b, int& R, int& C) { const int st = b / 1024, sb = b % 1024, swz = sb ^ (((sb >> 9) & 1) << 5); R = (st >> 1) * 16 + swz / 64; C = (st & 1) * 32 + (swz % 64) / 2; }
__host__ __device__ __forceinline__ int perm32(int rho) { const int n = rho >> 4, i = rho & 15; return 8 * (i >> 2) + 4 * n + (i & 3); }

struct Unit { int pm, pn; };
struct Gemm { const bf16_t* A; const bf16_t* Bt; int M, N, K; };

struct StaticOrder {
    int nM, nN, nwg, G, c;
    __host__ __device__ void init(int M, int N, int G_, int c_) { nM = M / BM; nN = N / BM; nwg = nM * nN; G = G_; c = c_; }
    __host__ __device__ bool next(int i, Unit& u) const {
        const long L = (long)i * G + c; if (L >= nwg) return false;
        int wgid = (int)L; { const int q = nwg / NXCD, r = nwg % NXCD, xcd = wgid % NXCD, off = wgid / NXCD; wgid = (xcd < r ? xcd * (q + 1) : r * (q + 1) + (xcd - r) * q) + off; }
        const int nig = WGM * nN, gid = wgid / nig, fm = gid * WGM, gsz = (nM - fm) < WGM ? (nM - fm) : WGM;
        u.pm = fm + ((wgid % nig) % gsz); u.pn = (wgid % nig) / gsz; return true;
    }
    __device__ __forceinline__ void a_ready(const Unit&) const {}
    __device__ __forceinline__ void done(const Unit&) const {}
};

__device__ __forceinline__ unsigned cvt_pk_bf16(float lo, float hi) { unsigned r; asm volatile("v_cvt_pk_bf16_f32 %0, %1, %2" : "=v"(r) : "v"(lo), "v"(hi)); return r; }
typedef float f32x2 __attribute__((ext_vector_type(2)));
#ifndef EPI_NT
#define EPI_NT 0
#endif
template <int ACT  > struct EpiBf16 {
    static constexpr bool PERM = true, AFTER_DRAIN = false;
    bf16_t* O; int ldc; const float* ssq;
    __device__ __forceinline__ void operator()(const f32x4 (&acc)[2][2][4][2], const Unit& u, int wr, int wc, int fr, int fq) const {
        const int row0 = u.pm * BM + wr * 64 + fr, col0 = u.pn * BM + wc * 32 + 8 * fq;
        float rs[2][4];
#pragma unroll
        for (int ai = 0; ai < 2; ++ai)
#pragma unroll
            for (int m = 0; m < 4; ++m) rs[ai][m] = ssq ? ssq[row0 + ai * HALF + m * 16] : 1.0f;
#pragma unroll
        for (int ai = 0; ai < 2; ++ai)
#pragma unroll
            for (int m = 0; m < 4; ++m) { bf16_t* rowp = O + (size_t)(row0 + ai * HALF + m * 16) * ldc + col0;
#pragma unroll
                for (int bj = 0; bj < 2; ++bj) { f32x4 v0 = acc[ai][bj][m][0] * rs[ai][m], v1 = acc[ai][bj][m][1] * rs[ai][m];
                    if (ACT == 1) {
#pragma unroll
                        for (int j = 0; j < 4; ++j) { const float a = fmaxf(v0[j], 0.f), b = fmaxf(v1[j], 0.f); v0[j] = a * a; v1[j] = b * b; } }
                    u32x4 w; w.x = cvt_pk_bf16(v0[0], v0[1]); w.y = cvt_pk_bf16(v0[2], v0[3]); w.z = cvt_pk_bf16(v1[0], v1[1]); w.w = cvt_pk_bf16(v1[2], v1[3]);
                    if (EPI_NT) __builtin_nontemporal_store(w, (u32x4*)(rowp + bj * HALF)); else *(u32x4*)(rowp + bj * HALF) = w; } }
    }
};
template <bool RES32, bool OUT32> struct EpiRes {
    static constexpr bool PERM = false, AFTER_DRAIN = false;
    const float* r0; const float* r1; int pm_split; bf16_t* xb; float* ssq  ; float* out; PG8_LAS float* tab  ;
    __device__ __forceinline__ void operator()(const f32x4 (&acc)[2][2][4][2], const Unit& u, int wr, int wc, int fr, int fq) const {
        typedef unsigned u32x2e __attribute__((ext_vector_type(2)));
        const int row0 = u.pm * BM + wr * 64 + fr, col0 = u.pn * BM + wc * 32 + 4 * fq;
        const float* rb = (u.pm < pm_split) ? r0 : r1;
#pragma unroll
        for (int ai = 0; ai < 2; ++ai)
#pragma unroll
            for (int m = 0; m < 4; ++m) { const size_t off = (size_t)(row0 + ai * HALF + m * 16) * 4096 + col0;
                f32x4 x[2][2];
#pragma unroll
                for (int bj = 0; bj < 2; ++bj)
#pragma unroll
                    for (int n = 0; n < 2; ++n) {
                        if (RES32) x[bj][n] = *(const f32x4*)(rb + off + bj * HALF + n * 16);
                        else { const u32x2e w = *(const u32x2e*)(xb + off + bj * HALF + n * 16); x[bj][n] = (f32x4){__uint_as_float(w.x << 16), __uint_as_float(w.x & 0xffff0000u), __uint_as_float(w.y << 16), __uint_as_float(w.y & 0xffff0000u)}; } }
                float sq = 0.f;
#pragma unroll
                for (int bj = 0; bj < 2; ++bj)
#pragma unroll
                    for (int n = 0; n < 2; ++n) { const f32x4 v = x[bj][n] + acc[ai][bj][m][n];
                        if (OUT32) *(f32x4*)(out + off + bj * HALF + n * 16) = v;
                        else { sq += (v[0] * v[0] + v[1] * v[1]) + (v[2] * v[2] + v[3] * v[3]); u32x2e w; w.x = cvt_pk_bf16(v[0], v[1]); w.y = cvt_pk_bf16(v[2], v[3]); *(u32x2e*)(xb + off + bj * HALF + n * 16) = w; } }
                if (!OUT32) { sq += __shfl_xor(sq, 16); sq += __shfl_xor(sq, 32); if (fq == 0) tab[(ai * HALF + wr * 64 + m * 16 + fr) * 4 + wc] = sq; }
                asm volatile("" ::: "memory"); }
        if (!OUT32) {
            asm volatile("s_waitcnt lgkmcnt(0)" ::: "memory"); __builtin_amdgcn_s_barrier(); asm volatile("" ::: "memory");
            const int t = (wr * 4 + wc) * 64 + fq * 16 + fr;
            if (t < 256) { const f32x4 p = *(const PG8_LAS f32x4*)(tab + t * 4); ssq[(size_t)(u.pm * BM + t) * 16 + u.pn] = (p[0] + p[1]) + (p[2] + p[3]); }
        }
    }
};

struct EpiKv {
    static constexpr bool PERM = true, AFTER_DRAIN = false;
    bf16_t* O; int ldc; const float* gain; PG8_LAS float* tab;
    __device__ __forceinline__ void operator()(const f32x4 (&acc)[2][2][4][2], const Unit& u, int wr, int wc, int fr, int fq) const {
        const int row0 = u.pm * BM + wr * 64 + fr, col0 = u.pn * BM + wc * 32 + 8 * fq;
#pragma unroll
        for (int ai = 0; ai < 2; ++ai)
#pragma unroll
            for (int m = 0; m < 4; ++m) { const f32x4 a = acc[ai][0][m][0], b = acc[ai][0][m][1]; float s = (a[0] * a[0] + a[1] * a[1]) + (a[2] * a[2] + a[3] * a[3]) + (b[0] * b[0] + b[1] * b[1]) + (b[2] * b[2] + b[3] * b[3]);
                s += __shfl_xor(s, 16); s += __shfl_xor(s, 32);
                if (fq == 0) tab[(ai * HALF + wr * 64 + m * 16 + fr) * 4 + wc] = s; }
        asm volatile("s_waitcnt lgkmcnt(0)" ::: "memory"); __builtin_amdgcn_s_barrier(); asm volatile("" ::: "memory");
        const f32x4 g0 = *(const f32x4*)(gain + wc * 32 + 8 * fq), g1 = *(const f32x4*)(gain + wc * 32 + 8 * fq + 4);
#pragma unroll
        for (int ai = 0; ai < 2; ++ai)
#pragma unroll
            for (int m = 0; m < 4; ++m) { bf16_t* rowp = O + (size_t)(row0 + ai * HALF + m * 16) * ldc + col0;
                const f32x4 t = *(const PG8_LAS f32x4*)(tab + (ai * HALF + wr * 64 + m * 16 + fr) * 4); const float rs = 1.0f / sqrtf(((t[0] + t[1]) + (t[2] + t[3])) * (1.0f / 128.0f) + 1e-6f);
                { const f32x4 v0 = acc[ai][0][m][0] * rs * g0, v1 = acc[ai][0][m][1] * rs * g1; u32x4 w; w.x = cvt_pk_bf16(v0[0], v0[1]); w.y = cvt_pk_bf16(v0[2], v0[3]); w.z = cvt_pk_bf16(v1[0], v1[1]); w.w = cvt_pk_bf16(v1[2], v1[3]); *(u32x4*)rowp = w; }
                { const f32x4 v0 = acc[ai][1][m][0], v1 = acc[ai][1][m][1]; u32x4 w; w.x = cvt_pk_bf16(v0[0], v0[1]); w.y = cvt_pk_bf16(v0[2], v0[3]); w.z = cvt_pk_bf16(v1[0], v1[1]); w.w = cvt_pk_bf16(v1[2], v1[3]); *(u32x4*)(rowp + HALF) = w; } }
    }
};

struct EpiInProj {
    static constexpr bool PERM = true, AFTER_DRAIN = false;
    bf16_t* O; int ldc; const float* ssq; const float* gq; const float* gk; const float* rope  ; PG8_LAS float* tab;
    __device__ __forceinline__ void operator()(const f32x4 (&acc)[2][2][4][2], const Unit& u, int wr, int wc, int fr, int fq) const {
        const int row0 = u.pm * BM + wr * 64 + fr, col0 = u.pn * BM + wc * 32 + 8 * fq;
        if (u.pn >= 21 && u.pn < 33) {
#pragma unroll
            for (int ai = 0; ai < 2; ++ai)
#pragma unroll
                for (int m = 0; m < 4; ++m)
#pragma unroll
                    for (int bj = 0; bj < 2; ++bj) { const f32x4 a = acc[ai][bj][m][0], b = acc[ai][bj][m][1]; float s = (a[0] * a[0] + a[1] * a[1]) + (a[2] * a[2] + a[3] * a[3]) + (b[0] * b[0] + b[1] * b[1]) + (b[2] * b[2] + b[3] * b[3]);
                        s += __shfl_xor(s, 16); s += __shfl_xor(s, 32);
                        if (fq == 0) tab[((ai * HALF + wr * 64 + m * 16 + fr) * 2 + bj) * 4 + wc] = s; }
            asm volatile("s_waitcnt lgkmcnt(0)" ::: "memory"); __builtin_amdgcn_s_barrier(); asm volatile("" ::: "memory");
            const float* gg = u.pn < 27 ? gq : gk; const int i0 = 16 * wc + 4 * fq;
            const f32x4 g1 = *(const f32x4*)(gg + i0), g2 = *(const f32x4*)(gg + 64 + i0);
#pragma unroll
            for (int ai = 0; ai < 2; ++ai)
#pragma unroll
                for (int m = 0; m < 4; ++m) { const int row = row0 + ai * HALF + m * 16, pos = row < 16384 ? (row & 2047) : row - 16384; bf16_t* rowp = O + (size_t)row * ldc + col0;
                    const f32x4 cs0 = *(const f32x4*)(rope + (size_t)(pos * 64 + i0) * 2), cs1 = *(const f32x4*)(rope + (size_t)(pos * 64 + i0) * 2 + 4);
#pragma unroll
                    for (int bj = 0; bj < 2; ++bj) { const f32x4 t = *(const PG8_LAS f32x4*)(tab + ((ai * HALF + wr * 64 + m * 16 + fr) * 2 + bj) * 4); const float rs = 1.0f / sqrtf(((t[0] + t[1]) + (t[2] + t[3])) * (1.0f / 128.0f) + 1e-6f);
                        const f32x4 v0 = acc[ai][bj][m][0], v1 = acc[ai][bj][m][1];
                        const float a0 = v0[0] * rs * g1[0], b0 = v0[1] * rs * g2[0], a1 = v0[2] * rs * g1[1], b1 = v0[3] * rs * g2[1], a2 = v1[0] * rs * g1[2], b2 = v1[1] * rs * g2[2], a3 = v1[2] * rs * g1[3], b3 = v1[3] * rs * g2[3];
                        u32x4 w; w.x = cvt_pk_bf16(a0 * cs0[0] - b0 * cs0[1], b0 * cs0[0] + a0 * cs0[1]); w.y = cvt_pk_bf16(a1 * cs0[2] - b1 * cs0[3], b1 * cs0[2] + a1 * cs0[3]);
                        w.z = cvt_pk_bf16(a2 * cs1[0] - b2 * cs1[1], b2 * cs1[0] + a2 * cs1[1]); w.w = cvt_pk_bf16(a3 * cs1[2] - b3 * cs1[3], b3 * cs1[2] + a3 * cs1[3]);
                        *(u32x4*)(rowp + bj * HALF) = w; } }
        } else {
            float rs[2][4];
#pragma unroll
            for (int ai = 0; ai < 2; ++ai)
#pragma unroll
                for (int m = 0; m < 4; ++m) rs[ai][m] = ssq[row0 + ai * HALF + m * 16];
#pragma unroll
            for (int ai = 0; ai < 2; ++ai)
#pragma unroll
                for (int m = 0; m < 4; ++m) { bf16_t* rowp = O + (size_t)(row0 + ai * HALF + m * 16) * ldc + col0;
#pragma unroll
                    for (int bj = 0; bj < 2; ++bj) { const f32x4 v0 = acc[ai][bj][m][0] * rs[ai][m], v1 = acc[ai][bj][m][1] * rs[ai][m];
                        u32x4 w; w.x = cvt_pk_bf16(v0[0], v0[1]); w.y = cvt_pk_bf16(v0[2], v0[3]); w.z = cvt_pk_bf16(v1[0], v1[1]); w.w = cvt_pk_bf16(v1[2], v1[3]);
                        *(u32x4*)(rowp + bj * HALF) = w; } }
        }
    }
};
__device__ __forceinline__ const char* pg8_uni(const char* p) { const unsigned long long v = (unsigned long long)p;
    const unsigned lo = (unsigned)__builtin_amdgcn_readfirstlane((int)(unsigned)v), hi = (unsigned)__builtin_amdgcn_readfirstlane((int)(unsigned)(v >> 32)); return (const char*)(((unsigned long long)hi << 32) | lo); }
template <class Epi, class Sched, bool ALIGN_EPI = false, bool SP2 = false>
__device__ __forceinline__ void gemm_phase(PG8_LAS unsigned char* lds, const Gemm g, const Sched& S, const Epi& E) {
    int tid_o = threadIdx.x; asm volatile("" : "+v"(tid_o));
    const int tid = tid_o & 511, wid = __builtin_amdgcn_readfirstlane(tid >> 6), lane = tid & 63, wr = wid >> 2, wc = wid & 3, fr = lane & 15, fq = lane >> 4;
    const int K = g.K, nt = K / BK;
    unsigned voffA[2], voffB[2];
#pragma unroll
    for (int i = 0; i < 2; ++i) { int R, C; stage_rc(tid * 16 + i * 8192, R, C); const int Rb = Epi::PERM ? ((R & ~31) + perm32(R & 31)) : R;
        voffA[i] = (unsigned)(R * K + C) * 2u; voffB[i] = (unsigned)(Rb * K + C) * 2u; }
    const size_t kstep = (size_t)(BK * 2);
    const size_t hstep = (size_t)HALF * K * 2;
    const size_t tstep = 2 * hstep;
    const unsigned ldsw = (unsigned)wid * 1024u;
    const int aoff = lds_byte(wr * 64 + fr, fq * 8), boff = lds_byte(wc * 32 + fr, fq * 8);
#define PG8_SA(b, h) (((b) * 2 + (h)) * HTB)
#define PG8_SB(b, h) ((4 + (b) * 2 + (h)) * HTB)
#define PG8_STAGE(bufoff, gbase, voff) do { _Pragma("unroll") for (int _i = 0; _i < 2; ++_i) { asm volatile("" : "+v"((voff)[_i])); \
        __builtin_amdgcn_global_load_lds((const unsigned*)(pg8_uni((const char*)(gbase)) + (voff)[_i]), (PG8_LAS unsigned*)(lds + (bufoff) + ldsw + _i * 8192), 16, 0, 0); } } while (0)
#define PG8_LDA(dst, b, h) do { _Pragma("unroll") for (int m = 0; m < 4; ++m) _Pragma("unroll") for (int k = 0; k < 2; ++k) dst[m][k] = *(const PG8_LAS bf16x8*)(lds + PG8_SA(b, h) + aoff + m * 2048 + k * 1024); } while (0)
#define PG8_LDB(dst, b, h) do { _Pragma("unroll") for (int n = 0; n < 2; ++n) _Pragma("unroll") for (int k = 0; k < 2; ++k) dst[n][k] = *(const PG8_LAS bf16x8*)(lds + PG8_SB(b, h) + boff + n * 2048 + k * 1024); } while (0)
#define PG8_MMA(ai, bj, At, Bt) do { __builtin_amdgcn_s_setprio(1); _Pragma("unroll") for (int m = 0; m < 4; ++m) _Pragma("unroll") for (int n = 0; n < 2; ++n) _Pragma("unroll") for (int k = 0; k < 2; ++k) \
        acc[ai][bj][m][n] = __builtin_amdgcn_mfma_f32_16x16x32_bf16(Bt[n][k], At[m][k], acc[ai][bj][m][n], 0, 0, 0); __builtin_amdgcn_s_setprio(0); } while (0)
#define PG8_WAIT_V(n) asm volatile("s_waitcnt vmcnt(" #n ")" ::: "memory")
#define PG8_WAIT_L(n) asm volatile("s_waitcnt lgkmcnt(" #n ")" ::: "memory")
#define PG8_BAR __builtin_amdgcn_s_barrier()
#define PG8_SCHED __builtin_amdgcn_sched_barrier(0)
    Unit cur, nxt; int ui = 0;
    if (!S.next(0, cur)) return;
    f32x4 acc[2][2][4][2];
#pragma unroll
    for (int a = 0; a < 2; ++a)
#pragma unroll
        for (int b = 0; b < 2; ++b)
#pragma unroll
            for (int m = 0; m < 4; ++m)
#pragma unroll
                for (int n = 0; n < 2; ++n) acc[a][b][m][n] = (f32x4){0.f, 0.f, 0.f, 0.f};
    bf16x8 At[4][2], B0[2][2], B1[2][2];
    const char* cA = (const char*)g.A + (size_t)cur.pm * tstep; const char* cB = (const char*)g.Bt + (size_t)cur.pn * tstep;
    S.a_ready(cur);
    if constexpr (SP2) {
        PG8_STAGE(PG8_SB(0, 0), cB, voffB); PG8_STAGE(PG8_SB(0, 1), cB + hstep, voffB); PG8_STAGE(PG8_SA(0, 0), cA, voffA); PG8_STAGE(PG8_SA(0, 1), cA + hstep, voffA);
        if (wr == 1) PG8_BAR;
        PG8_WAIT_V(2); PG8_BAR;
        PG8_STAGE(PG8_SB(1, 0), cB + kstep, voffB); PG8_STAGE(PG8_SA(1, 0), cA + kstep, voffA); PG8_STAGE(PG8_SB(1, 1), cB + hstep + kstep, voffB);
        PG8_WAIT_V(6); PG8_BAR;
    } else {
        PG8_STAGE(PG8_SB(0, 0), cB, voffB); PG8_STAGE(PG8_SA(0, 0), cA, voffA); PG8_STAGE(PG8_SB(0, 1), cB + hstep, voffB); PG8_STAGE(PG8_SA(0, 1), cA + hstep, voffA);
        if (wr == 1) PG8_BAR;
        PG8_WAIT_V(4); PG8_BAR;
        PG8_STAGE(PG8_SB(1, 0), cB + kstep, voffB); PG8_STAGE(PG8_SA(1, 0), cA + kstep, voffA); PG8_STAGE(PG8_SB(1, 1), cB + hstep + kstep, voffB);
        PG8_WAIT_V(6); PG8_BAR;
    }
    for (;;) {
        const bool has_next = S.next(ui + 1, nxt);
        const char* nA = has_next ? (const char*)g.A + (size_t)nxt.pm * tstep : cA; const char* nB = has_next ? (const char*)g.Bt + (size_t)nxt.pn * tstep : cB;
        for (int t = 0; t < nt; t += 2) {
            const bool last = (t == nt - 2);
            const char* a1 = cA + (size_t)(t + 1) * kstep;
            const char* a2 = last ? nA : cA + (size_t)(t + 2) * kstep; const char* b2 = last ? nB : cB + (size_t)(t + 2) * kstep;
            const char* a3 = a2 + kstep; const char* b3 = b2 + kstep;
            if (last && has_next) S.a_ready(nxt);
            if constexpr (SP2) {
            PG8_LDB(B0, 0, 0); PG8_LDB(B1, 0, 1); PG8_SCHED; PG8_LDA(At, 0, 0); PG8_STAGE(PG8_SA(1, 1), a1 + hstep, voffA);
            PG8_WAIT_V(8); PG8_WAIT_L(0); PG8_BAR; PG8_MMA(0, 0, At, B0); PG8_MMA(0, 1, At, B1); PG8_BAR; PG8_SCHED;
            PG8_LDA(At, 0, 1); PG8_STAGE(PG8_SB(0, 0), b2, voffB); PG8_STAGE(PG8_SB(0, 1), b2 + hstep, voffB); PG8_STAGE(PG8_SA(0, 0), a2, voffA);
            PG8_WAIT_V(8); PG8_WAIT_L(0); PG8_BAR; PG8_MMA(1, 0, At, B0); PG8_MMA(1, 1, At, B1); PG8_BAR; PG8_SCHED;
            PG8_LDB(B0, 1, 0); PG8_LDB(B1, 1, 1); PG8_SCHED; PG8_LDA(At, 1, 0); PG8_STAGE(PG8_SA(0, 1), a2 + hstep, voffA);
            PG8_WAIT_V(8); PG8_WAIT_L(0); PG8_BAR; PG8_MMA(0, 0, At, B0); PG8_MMA(0, 1, At, B1); PG8_BAR; PG8_SCHED;
            PG8_LDA(At, 1, 1); PG8_STAGE(PG8_SB(1, 0), b3, voffB); PG8_STAGE(PG8_SB(1, 1), b3 + hstep, voffB); PG8_STAGE(PG8_SA(1, 0), a3, voffA);
            PG8_WAIT_V(8); PG8_WAIT_L(0); PG8_BAR; PG8_MMA(1, 0, At, B0); PG8_MMA(1, 1, At, B1); PG8_BAR; PG8_SCHED;
            } else {
            PG8_LDB(B0, 0, 0); PG8_SCHED; PG8_LDA(At, 0, 0); PG8_STAGE(PG8_SA(1, 1), a1 + hstep, voffA);
            PG8_WAIT_L(8); PG8_BAR; PG8_WAIT_L(0); PG8_MMA(0, 0, At, B0); PG8_BAR; PG8_SCHED;
            PG8_LDB(B1, 0, 1); PG8_STAGE(PG8_SB(0, 0), b2, voffB);
            PG8_BAR; PG8_WAIT_L(0); PG8_MMA(0, 1, At, B1); PG8_BAR;
            PG8_LDA(At, 0, 1); PG8_STAGE(PG8_SA(0, 0), a2, voffA);
            PG8_BAR; PG8_WAIT_L(0); PG8_MMA(1, 0, At, B0); PG8_BAR; PG8_SCHED;
            PG8_STAGE(PG8_SB(0, 1), b2 + hstep, voffB);
            PG8_WAIT_V(6); PG8_BAR; PG8_MMA(1, 1, At, B1); PG8_BAR;
            PG8_LDB(B0, 1, 0); PG8_SCHED; PG8_LDA(At, 1, 0); PG8_STAGE(PG8_SA(0, 1), a2 + hstep, voffA);
            PG8_WAIT_L(8); PG8_BAR; PG8_WAIT_L(0); PG8_MMA(0, 0, At, B0); PG8_BAR; PG8_SCHED;
            PG8_LDB(B1, 1, 1); PG8_STAGE(PG8_SB(1, 0), b3, voffB);
            PG8_BAR; PG8_WAIT_L(0); PG8_MMA(0, 1, At, B1); PG8_BAR;
            PG8_LDA(At, 1, 1); PG8_STAGE(PG8_SA(1, 0), a3, voffA);
            PG8_BAR; PG8_WAIT_L(0); PG8_MMA(1, 0, At, B0); PG8_BAR; PG8_SCHED;
            PG8_STAGE(PG8_SB(1, 1), b3 + hstep, voffB);
            PG8_WAIT_V(6); PG8_BAR; PG8_MMA(1, 1, At, B1); PG8_BAR;
            }
        }
        if constexpr (ALIGN_EPI) { if (wr == 0) PG8_BAR; }
        if constexpr (!Epi::AFTER_DRAIN) { E(acc, cur, wr, wc, fr, fq); S.done(cur); }
        if (!has_next) break;
#pragma unroll
        for (int a = 0; a < 2; ++a)
#pragma unroll
            for (int b = 0; b < 2; ++b)
#pragma unroll
                for (int m = 0; m < 4; ++m)
#pragma unroll
                    for (int n = 0; n < 2; ++n) acc[a][b][m][n] = (f32x4){0.f, 0.f, 0.f, 0.f};
        cur = nxt; cA = nA; cB = nB; ++ui;
        if constexpr (ALIGN_EPI) { if (wr == 1) PG8_BAR; }
    }
    PG8_WAIT_V(0);
    if constexpr (!ALIGN_EPI) { if (wr == 0) PG8_BAR; }
    PG8_BAR;
    if constexpr (Epi::AFTER_DRAIN) { E.fused(acc, cur, wr, wc, fr, fq, lds, wid, lane); S.done(cur); }
#undef PG8_SA
#undef PG8_SB
#undef PG8_STAGE
#undef PG8_LDA
#undef PG8_LDB
#undef PG8_MMA
#undef PG8_WAIT_V
#undef PG8_WAIT_L
#undef PG8_BAR
#undef PG8_SCHED
}
}
#define GAS __attribute__((address_space(1)))
#define LAS __attribute__((address_space(3)))
typedef unsigned short bf16;
typedef unsigned v4u __attribute__((ext_vector_type(4)));
typedef float f32x4 __attribute__((ext_vector_type(4)));
typedef short bf16x8 __attribute__((ext_vector_type(8)));
typedef GAS unsigned gu32;
typedef GAS unsigned long long gu64;
#define RLX_AGENT __ATOMIC_RELAXED, __HIP_MEMORY_SCOPE_AGENT
#define LDS_WAIT() asm volatile("s_waitcnt lgkmcnt(0)" ::: "memory")
#define VM_WAIT() asm volatile("s_waitcnt vmcnt(0)" ::: "memory")
__device__ __forceinline__ unsigned long long rt() { return __builtin_amdgcn_s_memrealtime(); }
__device__ __forceinline__ unsigned f2bf(float f) { unsigned u = __builtin_bit_cast(unsigned, f); return (u + 0x7fffu + ((u >> 16) & 1u)) >> 16; }
typedef float f32x2_t __attribute__((ext_vector_type(2)));
typedef __bf16 bf16x2_t __attribute__((ext_vector_type(2)));
__device__ __forceinline__ unsigned pk2(float lo, float hi) { f32x2_t v = {lo, hi}; bf16x2_t b = __builtin_convertvector(v, bf16x2_t); return __builtin_bit_cast(unsigned, b); }
#define XB_TMO      128
#define XB_XCNT(j)  (256  + 64 * (j))
#define XB_XSUB(j)  (1280 + 64 * (j))
#define XB_XGEN(j)  (2304 + 64 * (j))
#define XB_TOP      3328
#define XB_TOPGEN   3392
#define XCD_BAR_WORDS 3456
#define XB_SPIN_CAP (1u << 18)

__device__ __forceinline__ unsigned xb_ld(unsigned* p)              { return __hip_atomic_load(p, __ATOMIC_RELAXED, __HIP_MEMORY_SCOPE_AGENT); }
__device__ __forceinline__ unsigned xb_add(unsigned* p, unsigned v) { return __hip_atomic_fetch_add(p, v, __ATOMIC_RELAXED, __HIP_MEMORY_SCOPE_AGENT); }
__device__ __forceinline__ unsigned xb_xcc_id() { return (unsigned)__builtin_amdgcn_s_getreg((3 << 11) | 20) & 0xFu; }
#define XB_SPIN(cond, bar) do { unsigned _sp = 0; while (cond) { __builtin_amdgcn_s_sleep(1); \
    if ((++_sp & 255u) == 0u) { if (xb_ld(&(bar)[XB_TMO])) break; if (_sp > XB_SPIN_CAP) { atomicAdd(&(bar)[XB_TMO], 1u); break; } } } } while (0)

struct XcdBarrier {
    unsigned* bar; unsigned x;
    volatile LAS unsigned* st;
};

__device__ __forceinline__ XcdBarrier xcd_barrier_post(unsigned* bar, volatile LAS unsigned* st) {
    XcdBarrier b; b.bar = bar; b.x = xb_xcc_id(); b.st = st;
    if (threadIdx.x == 0) (void)xb_add(&bar[XB_XCNT(b.x)], 1u);
    return b;
}
__device__ __forceinline__ void xcd_barrier_complete(unsigned* bar, unsigned x, unsigned& nloc, unsigned& nx) {
    const unsigned G = gridDim.x * gridDim.y * gridDim.z;
    unsigned sum, cnt, mine, sp = 0u;
    for (;;) {
        sum = 0u; cnt = 0u; mine = 0u;
#pragma unroll
        for (unsigned j = 0; j < 16; ++j) { const unsigned c = xb_ld(&bar[XB_XCNT(j)]); sum += c; cnt += (c > 0u) ? 1u : 0u; mine = (j == x) ? c : mine; }
        if (sum == G) break;
        __builtin_amdgcn_s_sleep(1);
        if ((++sp & 255u) == 0u) { if (xb_ld(&bar[XB_TMO])) break; if (sp > XB_SPIN_CAP) { atomicAdd(&bar[XB_TMO], 1u); break; } }
    }
    nloc = mine > 0u ? mine : 1u; nx = cnt > 0u ? cnt : 1u;
}

__device__ __forceinline__ void xcd_barrier(const XcdBarrier& b) {
    asm volatile("s_waitcnt vmcnt(0)" ::: "memory");
    __syncthreads();
    if (threadIdx.x == 0) {
        unsigned* bar = b.bar;
        __builtin_amdgcn_s_waitcnt(0);
        unsigned nloc = b.st[0], nx = b.st[1];
        if (nloc == 0u) { xcd_barrier_complete(bar, b.x, nloc, nx); b.st[0] = nloc; b.st[1] = nx; }
        const unsigned old = xb_add(&bar[XB_XSUB(b.x)], 1u);
        const unsigned gen = old / nloc;
        if (old + 1u == (gen + 1u) * nloc) {
            __builtin_amdgcn_fence(__ATOMIC_RELEASE, "agent");
            asm volatile("s_waitcnt vmcnt(0)" ::: "memory");
            const unsigned og = xb_add(&bar[XB_TOP], 1u);
            const unsigned tg = og / nx;
            if (og + 1u == (tg + 1u) * nx) xb_add(&bar[XB_TOPGEN], 1u);
            else XB_SPIN(xb_ld(&bar[XB_TOPGEN]) == tg, bar);
            __builtin_amdgcn_fence(__ATOMIC_ACQUIRE, "agent");
            xb_add(&bar[XB_XGEN(b.x)], 1u);
            asm volatile("s_waitcnt vmcnt(0)" ::: "memory");
        } else {
            XB_SPIN(xb_ld(&bar[XB_XGEN(b.x)]) == gen, bar);
            __builtin_amdgcn_fence(__ATOMIC_ACQUIRE, "agent");
            asm volatile("s_waitcnt vmcnt(0)" ::: "memory");
        }
    }
    __syncthreads();
}
constexpr int NWAVES = 8;
constexpr int DM = 4096, TP = 16384, TS = 8192, TT = 24576, NLAYER = 2;
constexpr int INC = 9792, ZC = 9984;
constexpr int Z_CQ = 3072, Z_CKV = 4608, Z_KR = 5120, Z_DQ = 5376, Z_DK = 6912, Z_DV = 8448;
constexpr int QC = 2304, KVC = 3072, DFF = 16384;
constexpr float EPS = 1e-6f;
constexpr int NPH_LAYER = 10, NPHASES = 1 + NLAYER * NPH_LAYER;

constexpr size_t MiB = 1u << 20;
constexpr size_t WS_CTL = 0, CTL_ZERO_BYTES = 1 * MiB;
constexpr size_t WS_R64 = 1 * MiB, WS_R128 = 3 * MiB;
constexpr size_t WS_FILT = 7 * MiB, FILT_LAYER = 40 * MiB, FILT_S_OFF = 8 * MiB;
constexpr size_t WS_WT = 87 * MiB;
constexpr size_t WT_IN = 0, WT_OUT = 78 * MiB, WT_UP = 110 * MiB, WT_DN = 238 * MiB, WT_QB = 366 * MiB, WT_KVB = WT_QB + 7077888, WT_LAYER = WT_KVB + 3 * MiB;
constexpr size_t WS_H = WS_WT + 2 * WT_LAYER;
constexpr size_t WS_A2 = WS_H + 192 * MiB;
constexpr size_t WS_Z = WS_A2, WS_Q = WS_Z + 468 * MiB, WS_KV = WS_Q + 108 * MiB, WS_UT = WS_KV + 144 * MiB;
constexpr size_t WS_CQ = WS_A2 + 768 * MiB, WS_CKV = WS_CQ + 72 * MiB, WS_KR = WS_CKV + 24 * MiB, WS_X0T = WS_KR + 3 * MiB, WS_YT = WS_X0T + 48 * MiB, WS_DLSE = WS_YT + 48 * MiB;
constexpr size_t WS_SSQP = WS_DLSE + 2 * MiB;
constexpr size_t WS_END = WS_SSQP + 2 * MiB;
constexpr size_t WS_XB = WS_H;
constexpr size_t WS_MIX = WS_KV;
constexpr size_t WS_SSQ = 128 * 1024;
static_assert(WS_MIX + (size_t)TT * DM * 2 == WS_A2 + 768 * MiB && WS_SSQ + 4 * (size_t)TT * 4 <= CTL_ZERO_BYTES, "MIXED overlay / ssq arrays");
static_assert(WS_END <= 2048 * MiB, "workspace map fits 2 GiB");

constexpr int CW_TMO = 0, CW_BAR = 4096;
constexpr int RING_BYTES = 131072, LDSCTL_OFF = RING_BYTES, MISC_OFF = LDSCTL_OFF + 320, WSCR_OFF = RING_BYTES + 1024, PTAB_OFF = RING_BYTES + 2048, KVTAB_OFF = RING_BYTES + 4096  , LDS_BYTES = 147456;

typedef unsigned short bf16;
typedef unsigned v4u __attribute__((ext_vector_type(4)));
typedef unsigned v2u __attribute__((ext_vector_type(2)));
typedef float f32x4 __attribute__((ext_vector_type(4)));
typedef float f32x2v __attribute__((ext_vector_type(2)));
typedef float f32x16 __attribute__((ext_vector_type(16)));
typedef short bf16x8 __attribute__((ext_vector_type(8)));
typedef short s16x4 __attribute__((ext_vector_type(4)));
#define SBAR() __builtin_amdgcn_sched_barrier(0)
struct InTab { const float* const (&t)[31]; __device__ __forceinline__ const float* operator[](int k) const { return t[k]; } };

__device__ __forceinline__ float bf2f(unsigned v) { return __uint_as_float(v << 16); }
__device__ __forceinline__ float bflo(unsigned w) { return __uint_as_float(w << 16); }
__device__ __forceinline__ float bfhi(unsigned w) { return __uint_as_float(w & 0xffff0000u); }
__device__ __forceinline__ int crow_(int r, int hi) { return (r & 3) + 8 * (r >> 2) + 4 * hi; }
__device__ __forceinline__ float wave_sum(float v) {
#pragma unroll
    for (int o = 1; o < 64; o <<= 1) v += __shfl_xor(v, o);
    return v;
}
__device__ __forceinline__ void unpack8(const v4u w, float (&f)[8]) { f[0] = bflo(w.x); f[1] = bfhi(w.x); f[2] = bflo(w.y); f[3] = bfhi(w.y); f[4] = bflo(w.z); f[5] = bfhi(w.z); f[6] = bflo(w.w); f[7] = bfhi(w.w); }
__device__ __forceinline__ v4u pack8(const float (&f)[8]) { v4u w; w.x = pk2(f[0], f[1]); w.y = pk2(f[2], f[3]); w.z = pk2(f[4], f[5]); w.w = pk2(f[6], f[7]); return w; }
__device__ __forceinline__ int seq_pos(int m) { return m < TP ? (m & 2047) : (m - TP); }
__device__ __forceinline__ int seq_len(int m) { return m < TP ? 2048 : 8192; }

__device__ __forceinline__ void transpose_item(const float* W, int ldw, bf16* WT, int K, int k0, int nsrc, int ndst, int dstr  , const float* gk  , LAS float* scr, int lane) {
    float tv[32];
#pragma unroll
    for (int i = 0; i < 32; ++i) tv[i] = W[(size_t)(k0 + 2 * i + (lane >> 5)) * ldw + nsrc + (lane & 31)];
    if (gk) {
#pragma unroll
        for (int i = 0; i < 32; ++i) tv[i] *= gk[k0 + 2 * i + (lane >> 5)]; }
#pragma unroll
    for (int i = 0; i < 32; ++i) scr[(2 * i + (lane >> 5)) * 33 + (lane & 31)] = tv[i];
    LDS_WAIT(); asm volatile("" ::: "memory");
    const int c = lane & 7;
#pragma unroll
    for (int j = 0; j < 4; ++j) { const int n = (lane >> 3) + 8 * j; const LAS float* s = scr + (8 * c) * 33 + n;
        v4u o; o.x = pk2(s[0 * 33], s[1 * 33]); o.y = pk2(s[2 * 33], s[3 * 33]); o.z = pk2(s[4 * 33], s[5 * 33]); o.w = pk2(s[6 * 33], s[7 * 33]);
        *(GAS v4u*)(WT + (size_t)(ndst + n * dstr) * K + k0 + 8 * c) = o; }
    LDS_WAIT(); asm volatile("" ::: "memory");
}
constexpr int I_IN = 64 * 306, I_OUT = 64 * 128, I_UP = 64 * 512, I_DN = 256 * 128, I_QB = 24 * 72, I_KVB = 8 * 96, I_LAYER = I_IN + I_OUT + I_UP + I_DN + I_QB + I_KVB;
__device__ __forceinline__ void p0_weights(const InTab in, unsigned char* ws, LAS float* scr, int gw, int NGW, int lane) {
    for (int it = gw; it < NLAYER * I_LAYER; it += NGW) {
        const int l = it / I_LAYER; int r = it % I_LAYER; unsigned char* wl = ws + WS_WT + (size_t)l * WT_LAYER;
        if (r < I_IN) { const int kb = r / 306, nb = r % 306, n0 = 32 * nb; int nd = n0, ds = 1;
            if (n0 >= 8256) nd = n0 + 192;
            else if (n0 >= 5184) { const int nl = n0 - 5184, d0 = nl & 127; nd = Z_DQ + (nl & ~127) + (d0 < 64 ? 2 * d0 : 2 * (d0 - 64) + 1); ds = 2; }
            transpose_item(in[3] + (size_t)l * DM * INC, INC, (bf16*)(wl + WT_IN), DM, 64 * kb, n0, nd, ds, in[2] + l * DM, scr, lane); continue; } r -= I_IN;
        if (r < I_OUT) { const int kb = r / 128, nb = r % 128; transpose_item(in[27] + (size_t)l * DM * DM, DM, (bf16*)(wl + WT_OUT), DM, 64 * kb, 32 * nb, 32 * nb, 1, nullptr, scr, lane); continue; } r -= I_OUT;
        if (r < I_UP) { const int kb = r / 512, nb = r % 512; transpose_item(in[29] + (size_t)l * DM * DFF, DFF, (bf16*)(wl + WT_UP), DM, 64 * kb, 32 * nb, 32 * nb, 1, in[28] + l * DM, scr, lane); continue; } r -= I_UP;
        if (r < I_DN) { const int kb = r / 128, nb = r % 128; transpose_item(in[30] + (size_t)l * DFF * DM, DM, (bf16*)(wl + WT_DN), DFF, 64 * kb, 32 * nb, 32 * nb, 1, nullptr, scr, lane); continue; } r -= I_DN;
        if (r < I_QB) { const int kb = r / 72, nb = r % 72, n0 = 32 * nb, h = n0 / 192, j = n0 % 192;
            transpose_item(in[17] + (size_t)l * 1536 * QC, QC, (bf16*)(wl + WT_QB), 1536, 64 * kb, n0, j < 128 ? h * 128 + j : 1536 + h * 64 + (j - 128), 1, nullptr, scr, lane); continue; } r -= I_QB;
        { const int kb = r / 96, nb = r % 96; transpose_item(in[19] + (size_t)l * 512 * KVC, KVC, (bf16*)(wl + WT_KVB), 512, 64 * kb, 32 * nb, 32 * nb, 1, nullptr, scr, lane); }
    }
}
__device__ __forceinline__ void p0_misc(unsigned char* ws, int gt, int NGT) {
    for (int i = gt; i < NLAYER * 98304; i += NGT) { const int l = i / 98304, r = i % 98304; *(GAS v4u*)(ws + WS_WT + (size_t)l * WT_LAYER + WT_IN + (size_t)5184 * DM * 2 + (size_t)r * 16) = (v4u){0u, 0u, 0u, 0u}; }
    for (int i = gt; i < 8192 * 96; i += NGT) { const int pos = i / 96, j = i % 96; float sv, cv;
        if (j < 32) { const float inv = 1.0f / powf(10000.0f, (float)(2 * j) / 64.0f); sincosf((float)pos * inv, &sv, &cv); ((GAS f32x2v*)(ws + WS_R64))[pos * 32 + j] = (f32x2v){cv, sv}; }
        else { const int jj = j - 32; const float inv = 1.0f / powf(10000.0f, (float)(2 * jj) / 128.0f); sincosf((float)pos * inv, &sv, &cv); ((GAS f32x2v*)(ws + WS_R128))[pos * 64 + jj] = (f32x2v){cv, sv}; } }
}
constexpr int FI_W1 = 0, FI_W2 = 33 * 64 * 4, FI_W3 = FI_W2 + 16384, FI_B = FI_W3 + 16384  , FI_H0 = FI_B + 1024, FI_H1 = FI_H0 + 16384, FI_H3 = FI_H1 + 16384;
__device__ __forceinline__ void filter_item(const InTab in, unsigned char* ws, int layer, int trunk, int pblk, LAS unsigned char* lds, int tid, int lane, int wave) {
    const int L = trunk ? 8192 : 2048, p0 = pblk * 64, p = p0 + lane;
    bf16* Rg = (bf16*)(ws + WS_FILT + (size_t)layer * FILT_LAYER + (trunk ? FILT_S_OFF : 0));
    const float* w4 = in[12] + (size_t)layer * 64 * 2048; const float* b4 = in[13] + layer * 2048;
    __syncthreads();
    { const float* w1 = in[6] + layer * 33 * 64; const float* w2 = in[8] + layer * 4096; const float* w3 = in[10] + layer * 4096;
      for (int i = tid; i < 33 * 64; i += 512) ((LAS float*)(lds + FI_W1))[i] = w1[i];
      for (int i = tid; i < 4096; i += 512) { ((LAS float*)(lds + FI_W2))[i] = w2[i]; ((LAS float*)(lds + FI_W3))[i] = w3[i]; }
      if (tid < 64) { ((LAS float*)(lds + FI_B))[tid] = in[7][layer * 64 + tid]; ((LAS float*)(lds + FI_B))[64 + tid] = in[9][layer * 64 + tid];
                      ((LAS float*)(lds + FI_B))[128 + tid] = in[11][layer * 64 + tid]; ((LAS float*)(lds + FI_B))[192 + tid] = in[14][layer * 64 + tid]; } }
    const float tp = (float)p / (float)(L - 1), wang = 6.283185307179586f * (float)p / (float)L;
    if (wave == 0) ((LAS float*)(lds + FI_H1))[lane] = tp;
#pragma unroll 1
    for (int jj = 0; jj < 2; ++jj) { const int j = 2 * wave + jj; const float f = 1e-4f + (float)j * ((15.0f - 1e-4f) / 15.0f); float sv, cv; sincosf(f * wang, &sv, &cv);
        ((LAS float*)(lds + FI_H1))[(1 + j) * 64 + lane] = cv; ((LAS float*)(lds + FI_H1))[(17 + j) * 64 + lane] = -sv; }
    __syncthreads();
    const LAS float* Bv = (const LAS float*)(lds + FI_B);
    float hv[64];
#pragma unroll
    for (int k = 0; k < 33; ++k) hv[k] = ((const LAS float*)(lds + FI_H1))[k * 64 + lane];
#pragma unroll 1
    for (int u = 0; u < 8; ++u) { const int k = 8 * wave + u; const LAS float* wc = (const LAS float*)(lds + FI_W1) + k; float a = Bv[k];
#pragma unroll
        for (int j = 0; j < 33; ++j) a += hv[j] * wc[j * 64];
        ((LAS float*)(lds + FI_H0))[k * 64 + lane] = sinf(Bv[192 + k] * a); }
    __syncthreads();
#pragma unroll
    for (int k = 0; k < 64; ++k) hv[k] = ((const LAS float*)(lds + FI_H0))[k * 64 + lane];
#pragma unroll 1
    for (int u = 0; u < 8; ++u) { const int k = 8 * wave + u; const LAS float* wc = (const LAS float*)(lds + FI_W2) + k; float a = Bv[64 + k];
#pragma unroll
        for (int j = 0; j < 64; ++j) a += hv[j] * wc[j * 64];
        ((LAS float*)(lds + FI_H1))[k * 64 + lane] = sinf(Bv[192 + k] * a); }
    __syncthreads();
#pragma unroll
    for (int k = 0; k < 64; ++k) hv[k] = ((const LAS float*)(lds + FI_H1))[k * 64 + lane];
#pragma unroll 1
    for (int u = 0; u < 8; ++u) { const int k = 8 * wave + u; const LAS float* wc = (const LAS float*)(lds + FI_W3) + k; float a = Bv[128 + k];
#pragma unroll
        for (int j = 0; j < 64; ++j) a += hv[j] * wc[j * 64];
        ((LAS bf16*)(lds + FI_H3))[lane * 72 + k] = (bf16)f2bf(sinf(Bv[192 + k] * a)); }
    __syncthreads();
    const int r32 = lane & 31, hi = lane >> 5;
    float tq[2]; int pq[2];
#pragma unroll
    for (int pb = 0; pb < 2; ++pb) { pq[pb] = p0 + pb * 32 + r32; tq[pb] = -1.4426950408889634f * (float)pq[pb] / (float)(L - 1); }
#pragma unroll 1
    for (int cbk = 0; cbk < 8; ++cbk) {
        const int c0 = 256 * wave + 32 * cbk;
        f32x16 acc[2];
#pragma unroll
        for (int pb = 0; pb < 2; ++pb) acc[pb] = (f32x16){0.f, 0.f, 0.f, 0.f, 0.f, 0.f, 0.f, 0.f, 0.f, 0.f, 0.f, 0.f, 0.f, 0.f, 0.f, 0.f};
#pragma unroll 1
        for (int ks = 0; ks < 4; ++ks) {
            const float* wk = w4 + (size_t)(ks * 16 + hi * 8) * 2048 + c0 + r32; float wv[8];
#pragma unroll
            for (int j = 0; j < 8; ++j) wv[j] = wk[j * 2048];
            const bf16x8 b0 = *(const LAS bf16x8*)(lds + FI_H3 + r32 * 144 + (ks * 16 + hi * 8) * 2), b1 = *(const LAS bf16x8*)(lds + FI_H3 + (32 + r32) * 144 + (ks * 16 + hi * 8) * 2);
            v4u aw; aw.x = pk2(wv[0], wv[1]); aw.y = pk2(wv[2], wv[3]); aw.z = pk2(wv[4], wv[5]); aw.w = pk2(wv[6], wv[7]);
            const bf16x8 af = __builtin_bit_cast(bf16x8, aw);
            acc[0] = __builtin_amdgcn_mfma_f32_32x32x16_bf16(af, b0, acc[0], 0, 0, 0); acc[1] = __builtin_amdgcn_mfma_f32_32x32x16_bf16(af, b1, acc[1], 0, 0, 0);
        }
        const bool fwd = wave < 4;
        unsigned nidx[2]; bool zr[2];
#pragma unroll
        for (int pb = 0; pb < 2; ++pb) { zr[pb] = !fwd && pq[pb] == 0; nidx[pb] = fwd ? (unsigned)(L - pq[pb]) : (zr[pb] ? 0u : (unsigned)(L + pq[pb])); }
#pragma unroll
        for (int r = 0; r < 16; ++r) { const unsigned col = (unsigned)(c0 + crow_(r, hi)), ch = col & 1023u;
            const float delta = fabsf(-3.0701134573253944f + (float)ch * ((-15.350567286626972f + 3.0701134573253944f) / 1023.0f)), bb = b4[col];
#pragma unroll
            for (int pb = 0; pb < 2; ++pb) { const float v = (acc[pb][r] + bb) * __builtin_amdgcn_exp2f(tq[pb] * delta);
                Rg[ch * (unsigned)(2 * L) + nidx[pb]] = zr[pb] ? (bf16)0 : (bf16)f2bf(v); }
            if ((r & 3) == 3) asm volatile("" ::: "memory"); }
    }
    __syncthreads();
}
__device__ __forceinline__ void cvt_rows(const float* x0, const float* x1, bf16* XB, float* ssq, int gw, int NGW, int lane) {
    for (int m = gw; m < TT; m += NGW) {
        const GAS f32x4* xr = (const GAS f32x4*)((m < TP ? x0 : x1) + (size_t)m * DM) + lane;
        f32x4 v[16]; float s = 0.f;
#pragma unroll
        for (int j = 0; j < 16; ++j) { v[j] = xr[64 * j]; s += (v[j].x * v[j].x + v[j].y * v[j].y) + (v[j].z * v[j].z + v[j].w * v[j].w); }
        s = wave_sum(s); if (lane == 0) ssq[m] = 1.0f / sqrtf(s * (1.0f / DM) + EPS);
        GAS v2u* o8 = (GAS v2u*)(XB + (size_t)m * DM) + lane;
#pragma unroll
        for (int j = 0; j < 16; ++j) { v2u w; w.x = pk2(v[j].x, v[j].y); w.y = pk2(v[j].z, v[j].w); o8[64 * j] = w; }
    }
}

__device__ __forceinline__ void rstd_rows(const float* ssqp, float* rstd, int gt, int NGT) {
    for (int m = gt; m < TT; m += NGT) { const GAS f32x4* p = (const GAS f32x4*)(ssqp + (size_t)m * 16); const f32x4 a = p[0], b = p[1], c = p[2], d = p[3];
        const float s = (((a.x + a.y) + (a.z + a.w)) + ((b.x + b.y) + (b.z + b.w))) + (((c.x + c.y) + (c.z + c.w)) + ((d.x + d.y) + (d.z + d.w)));
        rstd[m] = 1.0f / sqrtf(s * (1.0f / DM) + EPS); }
}
__device__ __forceinline__ void prep_hyena(const bf16* Z, const float* cw, const float* cb, bf16* UT, bf16* X0T, LAS unsigned char* lds, int tid, int bid, int G) {
    for (int tile = bid; tile < 384 * 8; tile += G) {
        const int tb = tile >> 3, cbk = tile & 7, row = tid >> 3, c8 = (tid & 7) * 8, m = tb * 64 + row;
        const int pos = seq_pos(m), L = seq_len(m); const bool hasm = pos > 0, hasp = pos < L - 1;
        v4u zw[2][3][3];
#pragma unroll
        for (int hc = 0; hc < 2; ++hc)
#pragma unroll
            for (int gI = 0; gI < 3; ++gI) { const bf16* zp = Z + (size_t)m * ZC + gI * 1024 + cbk * 128 + hc * 64 + c8;
                zw[hc][gI][1] = *(const GAS v4u*)zp; zw[hc][gI][0] = hasm ? *(const GAS v4u*)(zp - ZC) : (v4u){0u, 0u, 0u, 0u}; zw[hc][gI][2] = hasp ? *(const GAS v4u*)(zp + ZC) : (v4u){0u, 0u, 0u, 0u}; }
        __syncthreads();
#pragma unroll
        for (int hc = 0; hc < 2; ++hc) {
            const int c0 = cbk * 128 + hc * 64 + c8; float xc[3][8];
#pragma unroll
            for (int gI = 0; gI < 3; ++gI) { float a[8], b[8], c[8]; unpack8(zw[hc][gI][0], a); unpack8(zw[hc][gI][1], b); unpack8(zw[hc][gI][2], c); const float* wp = cw + gI * 1024 + c0;
#pragma unroll
                for (int e = 0; e < 8; ++e) xc[gI][e] = a[e] * wp[e] + b[e] * wp[3072 + e] + c[e] * wp[6144 + e] + cb[gI * 1024 + c0 + e]; }
            LAS bf16* TU = (LAS bf16*)(lds + hc * (2 * 64 * 132)); LAS bf16* TX = TU + 64 * 66;
#pragma unroll
            for (int e = 0; e < 8; ++e) { TU[(c8 + e) * 66 + row] = (bf16)f2bf(xc[1][e] * xc[2][e]); TX[(c8 + e) * 66 + row] = (bf16)f2bf(xc[0][e]); }
        }
        __syncthreads();
#pragma unroll
        for (int hc = 0; hc < 2; ++hc) { const int c = tid >> 3, t8 = (tid & 7) * 8; const LAS bf16* TU = (const LAS bf16*)(lds + hc * (2 * 64 * 132)); const LAS bf16* TX = TU + 64 * 66;
            const LAS unsigned* su = (const LAS unsigned*)(TU + c * 66 + t8); const LAS unsigned* sx = (const LAS unsigned*)(TX + c * 66 + t8);
            const v4u wu = {su[0], su[1], su[2], su[3]}, wx = {sx[0], sx[1], sx[2], sx[3]};
            const size_t o = (size_t)(cbk * 128 + hc * 64 + c) * TT + tb * 64 + t8; *(GAS v4u*)(UT + o) = wu; *(GAS v4u*)(X0T + o) = wx; }
    }
}
__device__ __forceinline__ void prep_tokens(const bf16* Z, const InTab in, int l, unsigned char* ws, int gw, int NGW, int lane) {
    bf16* CQ = (bf16*)(ws + WS_CQ); bf16* CKV = (bf16*)(ws + WS_CKV); bf16* KR = (bf16*)(ws + WS_KR);
    const GAS f32x2v* R64 = (const GAS f32x2v*)(ws + WS_R64); const GAS f32x2v* R128 = (const GAS f32x2v*)(ws + WS_R128);
    const float* gq = in[16] + l * 1536; const float* gkv = in[18] + l * 512; const float* gkr = in[23] + l * 64; const float* gdq = in[24] + l * 128; const float* gdk = in[25] + l * 128;
    for (int m = gw; m < TT; m += NGW) {
        const int pos = seq_pos(m); const bf16* zr = Z + (size_t)m * ZC;
        v4u cqw[3], ckw;
#pragma unroll
        for (int j = 0; j < 3; ++j) cqw[j] = *(const GAS v4u*)(zr + Z_CQ + lane * 8 + 512 * j);
        ckw = *(const GAS v4u*)(zr + Z_CKV + lane * 8); const unsigned krw = zr[Z_KR + lane];
        {
            float x[3][8]; float s = 0.f;
#pragma unroll
            for (int j = 0; j < 3; ++j) { unpack8(cqw[j], x[j]);
#pragma unroll
                for (int e = 0; e < 8; ++e) s += x[j][e] * x[j][e]; }
            const float rs = 1.0f / sqrtf(wave_sum(s) * (1.0f / 1536.0f) + EPS);
#pragma unroll
            for (int j = 0; j < 3; ++j) { const int c = lane * 8 + 512 * j; float y[8];
#pragma unroll
                for (int e = 0; e < 8; ++e) y[e] = x[j][e] * rs * gq[c + e];
                *(GAS v4u*)(CQ + (size_t)m * 1536 + c) = pack8(y); }
        }
        {
            float x[8], y[8]; float s = 0.f; unpack8(ckw, x);
#pragma unroll
            for (int e = 0; e < 8; ++e) s += x[e] * x[e];
            const float rs = 1.0f / sqrtf(wave_sum(s) * (1.0f / 512.0f) + EPS);
#pragma unroll
            for (int e = 0; e < 8; ++e) y[e] = x[e] * rs * gkv[lane * 8 + e];
            *(GAS v4u*)(CKV + (size_t)m * 512 + lane * 8) = pack8(y);
        }
        {
            const float x = bf2f(krw); const float rs = 1.0f / sqrtf(wave_sum(x * x) * (1.0f / 64.0f) + EPS);
            const float y = x * rs * gkr[lane], pr = __shfl_xor(y, 32); const f32x2v cs = R64[pos * 32 + (lane & 31)];
            KR[(size_t)m * 64 + lane] = (bf16)f2bf(lane < 32 ? y * cs.x - pr * cs.y : y * cs.x + pr * cs.y);
        }
    }
}
constexpr int CV_BS = 144;
template <int TRUNK>
__device__ __forceinline__ void conv_unit(int c, const bf16* Rg, const bf16* UT, const bf16* X0T, bf16* YT, float skip, LAS unsigned char* lds, int tid, int lane, int wave,
                                          v4u (&upre)[4], bool pre_valid, const bf16* next_urow, int next_np) {
    constexpr int L = TRUNK ? 8192 : 2048, NB = L / 64, NBAT = TRUNK ? 1 : 8, PADB = TRUNK ? 32 : 8, NBLK = NB + 2 * PADB, UBS = NBLK * CV_BS + (TRUNK ? 0 : 128);
    constexpr int NR = 2  , ENR = TRUNK ? 1 : 2  , TOK0 = TRUNK ? TP : 0, DC0 = TRUNK ? -128 : -32, DC1 = TRUNK ? 128 : 32;
    constexpr int ND = TRUNK ? 32 : 8, NPC = (64 * ND + 64) / 8  , NPR = NPC + 1  , CV_CS = NPC * 16 + 16, CV_RAW = TRUNK ? 28672 : 57344, CV_RSZ = (NPR * 16 + 255) & ~255, CV_FC = CV_RAW + 2 * CV_RSZ;
    static_assert(NBAT * UBS <= CV_RAW && CV_FC + 16 * CV_CS <= RING_BYTES && (CV_CS / 16) % 16 == 9 && NPR <= 512 && DC0 == -4 * ND && DC1 == 4 * ND, "conv LDS map");
    const bf16* urow = UT + (size_t)c * TT + TOK0;
    __syncthreads();
    for (int i = tid; i < NBAT * 2 * PADB * 8; i += 512) { const int b = i / (2 * PADB * 8), r = i % (2 * PADB * 8), pb = r >> 3, o8 = r & 7, blk = pb < PADB ? pb : pb + NB;
        *(LAS v4u*)(lds + b * UBS + blk * CV_BS + o8 * 16) = (v4u){0u, 0u, 0u, 0u}; }
    static_assert(NBAT * L / 8 % 512 == 0 && NBAT * L / 8 / 512 <= 4, "u pieces per thread");
#pragma unroll
    for (int k = 0; k < NBAT * L / 8 / 512; ++k) { const int ci = tid + 512 * k, b = ci / (L / 8), r = ci % (L / 8), blk = r >> 3, o8 = r & 7;
        const v4u uv = pre_valid ? upre[k] : *(const GAS v4u*)(urow + (size_t)ci * 8);
        *(LAS v4u*)(lds + b * UBS + (blk + PADB) * CV_BS + o8 * 16) = uv; }
    if (next_urow) {
#pragma unroll
        for (int k = 0; k < 4; ++k) if (k < next_np) upre[k] = *(const GAS v4u*)(next_urow + (size_t)(tid + 512 * k) * 8); }
    const int n = lane & 31, h = lane >> 5;
    int batch, t1, dlo, dhi, R0;
    const int g = wave & 3;
    if (TRUNK == 0) { const int bh = wave >> 2; batch = 4 * bh + (n >> 3); t1 = 8 * g + (n & 7); dlo = 8 * g - 31; dhi = 8 * g + 7; R0 = 0; }
    else { batch = 0; t1 = 32 * g + n; dlo = 32 * g - 127; dhi = 32 * g + 31; R0 = wave >> 2; }
    const int sl = (8 - (n & 7)) & 7;
    const int abase0 = CV_FC + sl * CV_CS + 2 * (64 * ND - n + 8 * h - sl);
    const int bbase0 = batch * UBS + (t1 + PADB) * CV_BS + 16 * h;
    f32x16 acc[NR];
#pragma unroll
    for (int r = 0; r < NR; ++r) acc[r] = (f32x16){0.f, 0.f, 0.f, 0.f, 0.f, 0.f, 0.f, 0.f, 0.f, 0.f, 0.f, 0.f, 0.f, 0.f, 0.f, 0.f};
    v2u xg[ENR][4];
    { const size_t tokb_ = (size_t)c * TT + TOK0 + batch * 2048 + 64 * t1;
#pragma unroll
      for (int r = 0; r < ENR; ++r)
#pragma unroll
          for (int kq = 0; kq < 4; ++kq) xg[r][kq] = *(const GAS v2u*)(X0T + tokb_ + 32 * (R0 + r) + 8 * kq + 4 * h); }
    v4u rawv[2] = {{0u, 0u, 0u, 0u}, {0u, 0u, 0u, 0u}};
#pragma unroll
    for (int k = 0; k < 2; ++k) { const int ch = k == 0 ? 0 : 5, nn = L - 64 * (DC0 + ND * ch + ND) + 8 * tid; if (tid < NPR && nn + 8 <= 2 * L) rawv[k] = *(const GAS v4u*)(Rg + nn); }
#pragma unroll 1
    for (int j = 0; j < 5; ++j) {
        if (j < 4) {
            __syncthreads();
            if (tid < NPR) { *(LAS v4u*)(lds + CV_RAW + 16 * tid) = rawv[0]; *(LAS v4u*)(lds + CV_RAW + CV_RSZ + 16 * tid) = rawv[1]; }
#pragma unroll
            for (int k = 0; k < 2; ++k) { const int ch = k == 0 ? j + 1 : (j + 1 < 3 ? 6 + j : 4), nn = L - 64 * (DC0 + ND * ch + ND) + 8 * tid; rawv[k] = (v4u){0u, 0u, 0u, 0u};
                if (j + 1 < 4 && tid < NPR && nn + 8 <= 2 * L) rawv[k] = *(const GAS v4u*)(Rg + nn); }
            __syncthreads();
#define CV_D(k) ((k) == 0 ? lo.x : (k) == 1 ? lo.y : (k) == 2 ? lo.z : (k) == 3 ? lo.w : (k) == 4 ? hi.x : (k) == 5 ? hi.y : (k) == 6 ? hi.z : hi.w)
#define CV_EMIT(s) do { v4u w; if ((s) & 1) { w.x = __builtin_amdgcn_alignbyte(CV_D((s) / 2 + 1), CV_D((s) / 2), 2); w.y = __builtin_amdgcn_alignbyte(CV_D((s) / 2 + 2), CV_D((s) / 2 + 1), 2); \
            w.z = __builtin_amdgcn_alignbyte(CV_D((s) / 2 + 3), CV_D((s) / 2 + 2), 2); w.w = __builtin_amdgcn_alignbyte(CV_D((s) / 2 + 4), CV_D((s) / 2 + 3), 2); } \
        else { w.x = CV_D((s) / 2); w.y = CV_D((s) / 2 + 1); w.z = CV_D((s) / 2 + 2); w.w = CV_D((s) / 2 + 3); } *(LAS v4u*)(dst + (s) * CV_CS) = w; } while (0)
            for (int idx = tid; idx < 4 * NPC; idx += 512) { const int q = idx / NPC, i = idx - q * NPC, win = q >> 1, hh = q & 1;
                const LAS unsigned char* rp = lds + CV_RAW + win * CV_RSZ + 16 * i; const v4u lo = *(const LAS v4u*)rp, hi = *(const LAS v4u*)(rp + 16); LAS unsigned char* dst = lds + CV_FC + win * (8 * CV_CS) + 16 * i;
                if (hh == 0) { CV_EMIT(0); CV_EMIT(1); CV_EMIT(2); CV_EMIT(3); } else { CV_EMIT(4); CV_EMIT(5); CV_EMIT(6); CV_EMIT(7); } }
#undef CV_EMIT
#undef CV_D
            __syncthreads();
        }
        const bool lower = j < 3 ? (g <= j) : (j == 3 ? g < 2 : g >= 2);
        const int ch = lower ? (j < 4 ? j : 3) : (j < 3 ? 5 + j : 4), dc = DC0 + ND * ch, abw = abase0 + (lower ? 0 : 8 * CV_CS);
        constexpr int DSTEP = TRUNK ? 2 : 1;
        int ddlo = dlo - dc > 0 ? dlo - dc : 0; const int ddhi = dhi - dc < ND - 1 ? dhi - dc : ND - 1;
        if (TRUNK) ddlo += ((dc + ddlo) ^ R0) & 1;
        if (ddlo <= ddhi) {
            bf16x8 fb[4], fa[4][NR];
            { const int ab = abw - 128 * ddlo, bb = bbase0 - (dc + ddlo) * CV_BS;
#pragma unroll
              for (int kb = 0; kb < 4; ++kb) { fb[kb] = *(const LAS bf16x8*)(lds + bb + 32 * kb);
#pragma unroll
                  for (int r = 0; r < NR; ++r) fa[kb][r] = *(const LAS bf16x8*)(lds + ab - 64 * r + 32 * kb); } }
#pragma unroll 2
            for (int dd = ddlo; dd <= ddhi; dd += DSTEP) {
                const int dn = dd + DSTEP <= ddhi ? dd + DSTEP : dd; const int ab = abw - 128 * dn, bb = bbase0 - (dc + dn) * CV_BS;
                bf16x8 nb[4], na[4][NR];
#pragma unroll
                for (int kb = 0; kb < 4; ++kb) { nb[kb] = *(const LAS bf16x8*)(lds + bb + 32 * kb);
#pragma unroll
                    for (int r = 0; r < NR; ++r) na[kb][r] = *(const LAS bf16x8*)(lds + ab - 64 * r + 32 * kb); }
#pragma unroll
                for (int kb = 0; kb < 4; ++kb)
#pragma unroll
                    for (int r = 0; r < NR; ++r) acc[r] = __builtin_amdgcn_mfma_f32_32x32x16_bf16(fa[kb][r], fb[kb], acc[r], 0, 0, 0);
#pragma unroll
                for (int kb = 0; kb < 4; ++kb) { fb[kb] = nb[kb];
#pragma unroll
                    for (int r = 0; r < NR; ++r) fa[kb][r] = na[kb][r]; }
            }
        }
    }
    if (TRUNK) {
        __syncthreads();
        LAS f32x4* xb = (LAS f32x4*)(lds + CV_FC);
#pragma unroll
        for (int q = 0; q < 4; ++q) { f32x4 v;
#pragma unroll
            for (int e = 0; e < 4; ++e) v[e] = R0 ? acc[0][4 * q + e] : acc[1][4 * q + e];
            xb[wave * 256 + q * 64 + lane] = v; }
        __syncthreads();
#pragma unroll
        for (int q = 0; q < 4; ++q) { const f32x4 v = xb[(wave ^ 4) * 256 + q * 64 + lane];
#pragma unroll
            for (int e = 0; e < 4; ++e) acc[0][4 * q + e] = (R0 ? acc[1][4 * q + e] : acc[0][4 * q + e]) + v[e]; }
    }
    const size_t tokb = (size_t)c * TT + TOK0 + batch * 2048 + 64 * t1;
#pragma unroll
    for (int r = 0; r < ENR; ++r)
#pragma unroll
        for (int kq = 0; kq < 4; ++kq) { const int t0 = 32 * (R0 + r) + 8 * kq + 4 * h;
            const v2u uu = *(const LAS v2u*)(lds + batch * UBS + (t1 + PADB) * CV_BS + 2 * t0); const v2u xx = xg[r][kq];
            const float y0 = bflo(xx.x) * (acc[r][4 * kq + 0] + bflo(uu.x) * skip), y1 = bfhi(xx.x) * (acc[r][4 * kq + 1] + bfhi(uu.x) * skip);
            const float y2 = bflo(xx.y) * (acc[r][4 * kq + 2] + bflo(uu.y) * skip), y3 = bfhi(xx.y) * (acc[r][4 * kq + 3] + bfhi(uu.y) * skip);
            v2u o; o.x = pk2(y0, y1); o.y = pk2(y2, y3); *(GAS v2u*)(YT + tokb + t0) = o; }
}
__device__ __forceinline__ int crow(int r, int hi) { return (r & 3) + 8 * (r >> 2) + 4 * hi; }
__device__ __forceinline__ unsigned cvtpk(float lo, float hi) { unsigned r; asm volatile("v_cvt_pk_bf16_f32 %0, %1, %2" : "=v"(r) : "v"(lo), "v"(hi)); return r; }
__device__ __forceinline__ void glds16(const void* g, LAS unsigned char* l) { __builtin_amdgcn_global_load_lds((const unsigned*)g, (LAS unsigned*)l, 16, 0, 0); }
__device__ __forceinline__ int v_st(int k, int c) { const int kk = (k & ~0xC) | ((k & 4) << 1) | ((k & 8) >> 1); return ((kk >> 3) * 4 + (c >> 5)) * 512 + ((kk & 7) * 32 + (c & 31)) * 2; }
__device__ __forceinline__ int v_rd_base(int lane) { return ((lane & 3) << 3) | (((lane >> 2) & 3) << 6) | (((lane >> 4) & 1) << 5) | (((lane >> 5) & 1) << 8); }
constexpr int v_rd_off(int d0, int ks, int half) { return d0 * 512 + ks * 4096 + half * 2048; }
__device__ __forceinline__ void v_inv(int P, int& k, int& c) { const int sub = P >> 9, w = (P & 511) >> 1, kk = ((sub >> 2) << 3) | (w >> 5); c = ((sub & 3) << 5) | (w & 31); k = (kk & ~0xC) | ((kk & 4) << 1) | ((kk & 8) >> 1); }
template <int OFF> __device__ __forceinline__ s16x4 tr_read(int vb) { s16x4 r; asm volatile("ds_read_b64_tr_b16 %0, %1 offset:%2" : "=&v"(r) : "v"(vb), "i"(OFF) : "memory"); return r; }
template <int D0> __device__ __forceinline__ void pv_one(f32x16& od, int vb, bf16x8 pa0, bf16x8 pa1, bf16x8 pa2, bf16x8 pa3) {
    const s16x4 l0 = tr_read<v_rd_off(D0, 0, 0)>(vb), h0 = tr_read<v_rd_off(D0, 0, 1)>(vb), l1 = tr_read<v_rd_off(D0, 1, 0)>(vb), h1 = tr_read<v_rd_off(D0, 1, 1)>(vb);
    const s16x4 l2 = tr_read<v_rd_off(D0, 2, 0)>(vb), h2 = tr_read<v_rd_off(D0, 2, 1)>(vb), l3 = tr_read<v_rd_off(D0, 3, 0)>(vb), h3 = tr_read<v_rd_off(D0, 3, 1)>(vb);
    asm volatile("s_waitcnt lgkmcnt(0)" ::: "memory"); SBAR();
#define PKV(Lx, Hx) (bf16x8){Lx[0], Lx[1], Lx[2], Lx[3], Hx[0], Hx[1], Hx[2], Hx[3]}
    od = __builtin_amdgcn_mfma_f32_32x32x16_bf16(pa0, PKV(l0, h0), od, 0, 0, 0);
    od = __builtin_amdgcn_mfma_f32_32x32x16_bf16(pa1, PKV(l1, h1), od, 0, 0, 0);
    od = __builtin_amdgcn_mfma_f32_32x32x16_bf16(pa2, PKV(l2, h2), od, 0, 0, 0);
    od = __builtin_amdgcn_mfma_f32_32x32x16_bf16(pa3, PKV(l3, h3), od, 0, 0, 0);
#undef PKV
}
__device__ __forceinline__ void softmax_p(f32x16& p0, f32x16& p1, float& m_reg, float& l_reg, f32x16 (&o)[4], bf16x8& pa0, bf16x8& pa1, bf16x8& pa2, bf16x8& pa3, LAS float* al, float C, int r32, int hi) {
    float pmax = p0[0];
#pragma unroll
    for (int r = 1; r < 16; ++r) pmax = fmaxf(pmax, p0[r]);
#pragma unroll
    for (int r = 0; r < 16; ++r) pmax = fmaxf(pmax, p1[r]);
    { auto rr = __builtin_amdgcn_permlane32_swap(__float_as_uint(pmax), __float_as_uint(pmax), false, false); pmax = fmaxf(__uint_as_float(rr[0]), __uint_as_float(rr[1])); }
    float mn = m_reg, alpha = 1.f; const bool resc = !__all((pmax - m_reg) * C <= 8.0f * 1.4426950408889634f);
    if (resc) { mn = fmaxf(m_reg, pmax); alpha = __builtin_amdgcn_exp2f((m_reg - mn) * C); m_reg = mn; }
    const float mnC = -mn * C;
    float ps = 0.f;
#pragma unroll
    for (int r = 0; r < 16; ++r) { p0[r] = __builtin_amdgcn_exp2f(fmaf(p0[r], C, mnC)); ps += p0[r]; }
#pragma unroll
    for (int r = 0; r < 16; ++r) { p1[r] = __builtin_amdgcn_exp2f(fmaf(p1[r], C, mnC)); ps += p1[r]; }
    { auto rr = __builtin_amdgcn_permlane32_swap(__float_as_uint(ps), __float_as_uint(ps), false, false); ps = __uint_as_float(rr[0]) + __uint_as_float(rr[1]); }
    l_reg = l_reg * alpha + ps;
    if (resc) { if (hi == 0) al[r32] = alpha; asm volatile("s_waitcnt lgkmcnt(0)" ::: "memory");
#pragma unroll
        for (int d = 0; d < 4; ++d)
#pragma unroll
            for (int r = 0; r < 16; ++r) o[d][r] *= al[crow(r, hi)];
    }
#define PK4(P, BASE, OUT) do { unsigned a0 = cvtpk(P[BASE + 0], P[BASE + 1]), a1 = cvtpk(P[BASE + 2], P[BASE + 3]);   \
    unsigned b0 = cvtpk(P[BASE + 4], P[BASE + 5]), b1 = cvtpk(P[BASE + 6], P[BASE + 7]);                              \
    auto r0 = __builtin_amdgcn_permlane32_swap(a0, b0, false, false); auto r1 = __builtin_amdgcn_permlane32_swap(a1, b1, false, false); \
    v4u w = {r0[0], r1[0], r0[1], r1[1]}; OUT = __builtin_bit_cast(bf16x8, w); } while (0)
    PK4(p0, 0, pa0); PK4(p0, 8, pa1); PK4(p1, 0, pa2); PK4(p1, 8, pa3);
#undef PK4
}
struct VF8 { s16x4 l0, h0, l1, h1, l2, h2, l3, h3; };
template <int D0> __device__ __forceinline__ void vf8_read(VF8& f, int vb) {
    f.l0 = tr_read<v_rd_off(D0, 0, 0)>(vb); f.h0 = tr_read<v_rd_off(D0, 0, 1)>(vb); f.l1 = tr_read<v_rd_off(D0, 1, 0)>(vb); f.h1 = tr_read<v_rd_off(D0, 1, 1)>(vb);
    f.l2 = tr_read<v_rd_off(D0, 2, 0)>(vb); f.h2 = tr_read<v_rd_off(D0, 2, 1)>(vb); f.l3 = tr_read<v_rd_off(D0, 3, 0)>(vb); f.h3 = tr_read<v_rd_off(D0, 3, 1)>(vb); }
__device__ __forceinline__ void vf8_mma(f32x16& od, const VF8& f, bf16x8 pa0, bf16x8 pa1, bf16x8 pa2, bf16x8 pa3) {
#define PKV(Lx, Hx) (bf16x8){Lx[0], Lx[1], Lx[2], Lx[3], Hx[0], Hx[1], Hx[2], Hx[3]}
    od = __builtin_amdgcn_mfma_f32_32x32x16_bf16(pa0, PKV(f.l0, f.h0), od, 0, 0, 0);
    od = __builtin_amdgcn_mfma_f32_32x32x16_bf16(pa1, PKV(f.l1, f.h1), od, 0, 0, 0);
    od = __builtin_amdgcn_mfma_f32_32x32x16_bf16(pa2, PKV(f.l2, f.h2), od, 0, 0, 0);
    od = __builtin_amdgcn_mfma_f32_32x32x16_bf16(pa3, PKV(f.l3, f.h3), od, 0, 0, 0);
#undef PKV
}
__device__ __forceinline__ void pv_all(f32x16 (&o)[4], int vb, bf16x8 pa0, bf16x8 pa1, bf16x8 pa2, bf16x8 pa3) {
    VF8 fa, fb;
    SBAR(); __builtin_amdgcn_s_setprio(1);
    vf8_read<0>(fa, vb); asm volatile("s_waitcnt lgkmcnt(0)" ::: "memory"); SBAR();
    vf8_read<1>(fb, vb); vf8_mma(o[0], fa, pa0, pa1, pa2, pa3); asm volatile("s_waitcnt lgkmcnt(0)" ::: "memory"); SBAR();
    vf8_read<2>(fa, vb); vf8_mma(o[1], fb, pa0, pa1, pa2, pa3); asm volatile("s_waitcnt lgkmcnt(0)" ::: "memory"); SBAR();
    vf8_read<3>(fb, vb); vf8_mma(o[2], fa, pa0, pa1, pa2, pa3); asm volatile("s_waitcnt lgkmcnt(0)" ::: "memory"); SBAR();
    vf8_mma(o[3], fb, pa0, pa1, pa2, pa3);
    __builtin_amdgcn_s_setprio(0);
}
__device__ __forceinline__ void softmax_pv(f32x16& p0, f32x16& p1, float& m_reg, float& l_reg, f32x16 (&o)[4], int vb, LAS float* al, float C, int r32, int hi) {
    bf16x8 pa0, pa1, pa2, pa3; softmax_p(p0, p1, m_reg, l_reg, o, pa0, pa1, pa2, pa3, al, C, r32, hi); pv_all(o, vb, pa0, pa1, pa2, pa3);
}
#define ATTN_STORE_O(ROWPTR_EXPR) do { if (hi == 0) al[r32] = l_reg; asm volatile("s_waitcnt lgkmcnt(0)" ::: "memory"); \
    _Pragma("unroll") for (int r = 0; r < 16; ++r) { const int qi = crow(r, hi); const float rl = __builtin_amdgcn_rcpf(al[qi]); bf16* op = (ROWPTR_EXPR); \
        _Pragma("unroll") for (int d0 = 0; d0 < 4; ++d0) op[d0 * 32 + r32] = (bf16)f2bf(o[d0][r] * rl); } } while (0)

constexpr int MLA_KB = 32768, MLA_VB = 16384, MLA_BUF = MLA_KB + MLA_VB;
__device__ __forceinline__ void mla_stage(const bf16* KV, const bf16* KR, int krow0, int head, LAS unsigned char* buf, int tid, int wave) {
#pragma unroll
    for (int i = 0; i < 4; ++i) { const int P = i * 512 + tid, row = P >> 5, c = (P & 31) ^ (row & 15);
        const bf16* src = c < 16 ? KV + (size_t)(krow0 + row) * KVC + head * 256 + c * 8 : KR + (size_t)(krow0 + row) * 64 + (c < 24 ? (c - 16) * 8 : 0);
        glds16(src, buf + (i * 512 + wave * 64) * 16); }
#pragma unroll
    for (int i = 0; i < 2; ++i) { const int P = (i * 512 + tid) * 16; int k, c; v_inv(P, k, c);
        glds16(KV + (size_t)(krow0 + k) * KVC + head * 256 + 128 + c, buf + MLA_KB + (i * 512 + wave * 64) * 16); }
}
struct MlaSrc { unsigned o[6]; unsigned kvm; };
__device__ __forceinline__ void mla_src_init(MlaSrc& s, const bf16* KV, const bf16* KR, int krow0, int head, int tid) {
    const unsigned dkr = (unsigned)((const char*)KR - (const char*)KV);
    s.kvm = 0u;
#pragma unroll
    for (int i = 0; i < 4; ++i) { const int P = i * 512 + tid, row = P >> 5, c = (P & 31) ^ (row & 15);
        s.o[i] = c < 16 ? (unsigned)(((krow0 + row) * KVC + head * 256 + c * 8) * 2) : dkr + (unsigned)(((krow0 + row) * 64 + (c < 24 ? (c - 16) * 8 : 0)) * 2); s.kvm |= (c < 16 ? 1u : 0u) << i; }
#pragma unroll
    for (int i = 0; i < 2; ++i) { const int P = (i * 512 + tid) * 16; int k, c; v_inv(P, k, c); s.o[4 + i] = (unsigned)(((krow0 + k) * KVC + head * 256 + 128 + c) * 2); }
}
__device__ __forceinline__ void mla_stage_adv(MlaSrc& s, const bf16* KV, LAS unsigned char* buf, int wave) {
#pragma unroll
    for (int i = 0; i < 4; ++i) { glds16((const char*)KV + s.o[i], buf + (i * 512 + wave * 64) * 16); s.o[i] += ((s.kvm >> i) & 1u) ? 64u * KVC * 2u : 64u * 64u * 2u; }
#pragma unroll
    for (int i = 0; i < 2; ++i) { glds16((const char*)KV + s.o[4 + i], buf + MLA_KB + (i * 512 + wave * 64) * 16); s.o[4 + i] += 64u * KVC * 2u; }
}
__device__ __forceinline__ void mla_unit(const bf16* Q, const bf16* KV, const bf16* KR, const float* gqn, const float* gqr, const GAS f32x2v* R64, bf16* O, int opitch, int row0  , int L, int head, int qb, LAS unsigned char* lds, int tid, int lane, int wave) {
    const int r32 = lane & 31, hi = lane >> 5; constexpr float C = 0.07216878364870322f * 1.4426950408889634f;
    LAS float* al = (LAS float*)(lds + WSCR_OFF + wave * 128);
    const int qrow = row0 + qb * 256 + wave * 32 + r32;
    __syncthreads();
    MlaSrc src; mla_src_init(src, KV, KR, row0, head, tid);
    mla_stage_adv(src, KV, lds, wave);
    bf16x8 qr[12];
    {   const bf16* qn_p = Q + (size_t)qrow * QC + head * 128 + hi * 8; const bf16* qr_p = Q + (size_t)qrow * QC + 1536 + head * 64 + hi * 8;
        float sn = 0.f, sr = 0.f;
#pragma unroll
        for (int d0 = 0; d0 < 12; ++d0) { float x[8]; unpack8(*(const GAS v4u*)(d0 < 8 ? qn_p + d0 * 16 : qr_p + (d0 - 8) * 16), x); float s = 0.f;
#pragma unroll
            for (int e = 0; e < 8; ++e) s += x[e] * x[e];
            if (d0 < 8) sn += s; else sr += s; }
        sn += __shfl_xor(sn, 32); sr += __shfl_xor(sr, 32);
        const float rn = 1.0f / sqrtf(sn * (1.0f / 128.0f) + EPS), rr = 1.0f / sqrtf(sr * (1.0f / 64.0f) + EPS);
#pragma unroll
        for (int d0 = 0; d0 < 8; ++d0) { float x[8], y[8]; unpack8(*(const GAS v4u*)(qn_p + d0 * 16), x); const GAS f32x4* gp = (const GAS f32x4*)(gqn + d0 * 16 + hi * 8); const f32x4 g0 = gp[0], g1 = gp[1];
            y[0] = x[0] * rn * g0.x; y[1] = x[1] * rn * g0.y; y[2] = x[2] * rn * g0.z; y[3] = x[3] * rn * g0.w; y[4] = x[4] * rn * g1.x; y[5] = x[5] * rn * g1.y; y[6] = x[6] * rn * g1.z; y[7] = x[7] * rn * g1.w;
            qr[d0] = __builtin_bit_cast(bf16x8, pack8(y)); asm volatile("" ::: "memory"); }
        const int pos = qb * 256 + wave * 32 + r32;
#pragma unroll
        for (int d0 = 0; d0 < 2; ++d0) {
            float x1[8], x2[8], y1[8], y2[8]; unpack8(*(const GAS v4u*)(qr_p + d0 * 16), x1); unpack8(*(const GAS v4u*)(qr_p + (d0 + 2) * 16), x2); const int i0 = d0 * 16 + hi * 8;
            const GAS f32x4* ct = (const GAS f32x4*)(R64 + pos * 32 + i0); const f32x4 c01 = ct[0], c23 = ct[1], c45 = ct[2], c67 = ct[3];
            const float cs[16] = {c01.x, c01.y, c01.z, c01.w, c23.x, c23.y, c23.z, c23.w, c45.x, c45.y, c45.z, c45.w, c67.x, c67.y, c67.z, c67.w};
#pragma unroll
            for (int e = 0; e < 8; ++e) { const float a = x1[e] * rr * gqr[i0 + e], b = x2[e] * rr * gqr[32 + i0 + e]; y1[e] = a * cs[2 * e] - b * cs[2 * e + 1]; y2[e] = b * cs[2 * e] + a * cs[2 * e + 1]; }
            qr[8 + d0] = __builtin_bit_cast(bf16x8, pack8(y1)); qr[10 + d0] = __builtin_bit_cast(bf16x8, pack8(y2)); asm volatile("" ::: "memory"); }
    }
    float m_reg = -1e30f, l_reg = 0.f; f32x16 o[4];
#pragma unroll
    for (int d = 0; d < 4; ++d) o[d] = (f32x16){0.f, 0.f, 0.f, 0.f, 0.f, 0.f, 0.f, 0.f, 0.f, 0.f, 0.f, 0.f, 0.f, 0.f, 0.f, 0.f};
    const int NT = L / 64;
#pragma unroll 1
    for (int j = 0; j < NT; ++j) {
        LAS unsigned char* cur = lds + (j & 1) * MLA_BUF;
        asm volatile("s_waitcnt vmcnt(0)" ::: "memory"); __syncthreads();
        if (j + 1 < NT) mla_stage_adv(src, KV, lds + ((j + 1) & 1) * MLA_BUF, wave);
        f32x16 p0 = (f32x16){0.f, 0.f, 0.f, 0.f, 0.f, 0.f, 0.f, 0.f, 0.f, 0.f, 0.f, 0.f, 0.f, 0.f, 0.f, 0.f}, p1 = p0;
        __builtin_amdgcn_s_setprio(1);
#pragma unroll
        for (int d0 = 0; d0 < 12; ++d0) { const int c = 2 * d0 + hi;
            const bf16x8 b0 = *(const LAS bf16x8*)(cur + r32 * 512 + ((c ^ (r32 & 15)) << 4));
            const bf16x8 b1 = *(const LAS bf16x8*)(cur + (32 + r32) * 512 + ((c ^ (r32 & 15)) << 4));
            p0 = __builtin_amdgcn_mfma_f32_32x32x16_bf16(b0, qr[d0], p0, 0, 0, 0);
            p1 = __builtin_amdgcn_mfma_f32_32x32x16_bf16(b1, qr[d0], p1, 0, 0, 0); }
        __builtin_amdgcn_s_setprio(0);
        softmax_pv(p0, p1, m_reg, l_reg, o, (int)(unsigned)(uintptr_t)(cur + MLA_KB) + v_rd_base(lane), al, C, r32, hi);
    }
    ATTN_STORE_O(O + (size_t)(row0 + qb * 256 + wave * 32 + qi) * opitch + head * 128);
}
__device__ __forceinline__ void mla_phase(const bf16* Q, const bf16* KV, const bf16* KR, const float* gqn, const float* gqr, const GAS f32x2v* R64, bf16* O, int opitch, LAS unsigned char* lds, int tid, int lane, int wave, int bid, int G) {
    const bool bal = (G == 256); const int x = bid & 7, li = bid >> 3;
    const int nS = bal ? (li < 16 ? 2 : 1) : (bid < 384 ? (384 - bid + G - 1) / G : 0), nP = bal ? (li < 16 ? 1 : 5) : (bid < 768 ? (768 - bid + G - 1) / G : 0);
#pragma unroll 1
    for (int i = 0; i < nS + nP; ++i) {
        int row0, L, head, qb;
        if (i < nS) { const int u = bal ? 48 * x + (li < 16 ? 2 * li + i : 16 + li) : bid + i * G; row0 = TP; L = 8192; head = u / 32; qb = u % 32; }
        else { const int k = i - nS, u = bal ? 96 * x + (li < 16 ? li : 16 + 5 * (li - 16) + k) : bid + k * G; row0 = (u / 96) * 2048; L = 2048; head = (u % 96) / 8; qb = u % 8; }
        mla_unit(Q, KV, KR, gqn, gqr, R64, O, opitch, row0, L, head, qb, lds, tid, lane, wave);
    }
}
__device__ __forceinline__ void dil_unit(const bf16* Z, bf16* O, int opitch, float* DLSE, int wu, LAS unsigned char* lds, int tid, int lane, int wave) {
    const int r32 = lane & 31, hi = lane >> 5, sub = wave >> 1, tl = tid & 127; constexpr float C = 0.08838834764831845f * 1.4426950408889634f;
    const int hd = wu % 12, quad = wu / 12, gb = quad * 4 + sub, grp = hd >> 2, dil = grp == 0 ? 1 : (grp == 1 ? 4 : 16);
    const int row0 = gb < 256 ? (gb >> 5) * 2048 : TP, L = gb < 256 ? 2048 : 8192, bi = gb < 256 ? (gb & 31) : gb - 256;
    const int res = bi % dil, blk = bi / dil, nblk = L / 64 / dil;
    LAS unsigned char* kb = lds + sub * 32768; LAS unsigned char* vbuf = kb + 16384;
    LAS float* al = (LAS float*)(lds + WSCR_OFF + wave * 128);
    const int qi_l = 32 * (wave & 1) + r32; const size_t qrow = (size_t)(row0 + (blk * 64 + qi_l) * dil + res);
    bf16x8 qr[8];
#pragma unroll
    for (int d0 = 0; d0 < 8; ++d0) qr[d0] = *(const GAS bf16x8*)(Z + qrow * ZC + Z_DQ + hd * 128 + d0 * 16 + hi * 8);
    float m_reg = -1e30f, l_reg = 0.f; f32x16 o[4];
#pragma unroll
    for (int d = 0; d < 4; ++d) o[d] = (f32x16){0.f, 0.f, 0.f, 0.f, 0.f, 0.f, 0.f, 0.f, 0.f, 0.f, 0.f, 0.f, 0.f, 0.f, 0.f, 0.f};
#pragma unroll 1
    for (int ti = 0; ti < 3; ++ti) {
        const int dt = ti == 0 ? 0 : (ti == 1 ? -1 : 1); const int kblk = blk + dt; const bool tvalid = kblk >= 0 && kblk < nblk; const int kbc = tvalid ? kblk : blk;
        __syncthreads();
#pragma unroll
        for (int i = 0; i < 8; ++i) { const int P = (i * 128 + tl) * 16, row = P >> 8, cb = (P & 255) ^ ((row & 7) << 4);
            glds16(Z + (size_t)(row0 + (kbc * 64 + row) * dil + res) * ZC + Z_DK + hd * 128 + (cb >> 1), kb + (i * 128 + (wave & 1) * 64) * 16); }
#pragma unroll
        for (int i = 0; i < 8; ++i) { const int P = (i * 128 + tl) * 16; int k, c; v_inv(P, k, c);
            glds16(Z + (size_t)(row0 + (kbc * 64 + k) * dil + res) * ZC + Z_DV + hd * 128 + c, vbuf + (i * 128 + (wave & 1) * 64) * 16); }
        asm volatile("s_waitcnt vmcnt(0)" ::: "memory"); __syncthreads();
        f32x16 p0 = (f32x16){0.f, 0.f, 0.f, 0.f, 0.f, 0.f, 0.f, 0.f, 0.f, 0.f, 0.f, 0.f, 0.f, 0.f, 0.f, 0.f}, p1 = p0;
#pragma unroll
        for (int d0 = 0; d0 < 8; ++d0) { const int cb = d0 * 32 + hi * 16;
            const bf16x8 b0 = *(const LAS bf16x8*)(kb + r32 * 256 + (cb ^ ((r32 & 7) << 4)));
            const bf16x8 b1 = *(const LAS bf16x8*)(kb + (32 + r32) * 256 + (cb ^ ((r32 & 7) << 4)));
            p0 = __builtin_amdgcn_mfma_f32_32x32x16_bf16(b0, qr[d0], p0, 0, 0, 0);
            p1 = __builtin_amdgcn_mfma_f32_32x32x16_bf16(b1, qr[d0], p1, 0, 0, 0); }
        if (ti != 0) {
#pragma unroll
            for (int r = 0; r < 16; ++r) { const int k0 = crow(r, hi), k1 = 32 + k0;
                const bool v0 = tvalid && (dt < 0 ? k0 >= qi_l : k0 <= qi_l), v1 = tvalid && (dt < 0 ? k1 >= qi_l : k1 <= qi_l);
                p0[r] = v0 ? p0[r] : -1e30f; p1[r] = v1 ? p1[r] : -1e30f; }
        }
        softmax_pv(p0, p1, m_reg, l_reg, o, (int)(unsigned)(uintptr_t)vbuf + v_rd_base(lane), al, C, r32, hi);
    }
    if (hi == 0) DLSE[(qrow) * 12 + hd] = m_reg * 0.08838834764831845f + logf(l_reg);
    __syncthreads();
    ATTN_STORE_O(O + (size_t)(row0 + (blk * 64 + 32 * (wave & 1) + qi) * dil + res) * opitch + hd * 128);
}
__device__ __forceinline__ void mixnorm_hyena(int tb, const bf16* YT, const float* gout, bf16* MX, LAS unsigned char* lds, int tid, int lane, int wave) {
    LAS float* ssq = (LAS float*)(lds);
    LAS float* rstd = (LAS float*)(lds + 2048);
    LAS bf16* tile = (LAS bf16*)(lds + 4096);
    const int c = tid >> 3, t8 = (tid & 7) * 8, m0 = tb * 64;
    v4u xw[16];
#pragma unroll
    for (int ck = 0; ck < 16; ++ck) xw[ck] = *(const GAS v4u*)(YT + (size_t)(ck * 64 + c) * TT + m0 + t8);
    __syncthreads();
    float ps[8];
#pragma unroll
    for (int e = 0; e < 8; ++e) ps[e] = 0.f;
#pragma unroll
    for (int ck = 0; ck < 16; ++ck) { float x[8]; unpack8(xw[ck], x);
#pragma unroll
        for (int e = 0; e < 8; ++e) ps[e] += x[e] * x[e]; }
#pragma unroll
    for (int e = 0; e < 8; ++e) { ps[e] += __shfl_xor(ps[e], 8); ps[e] += __shfl_xor(ps[e], 16); ps[e] += __shfl_xor(ps[e], 32); }
    if (lane < 8) {
#pragma unroll
        for (int e = 0; e < 8; ++e) ssq[wave * 64 + lane * 8 + e] = ps[e]; }
    __syncthreads();
    if (tid < 64) { float s = 0.f;
#pragma unroll
        for (int w = 0; w < 8; ++w) s += ssq[w * 64 + tid];
        rstd[tid] = 1.0f / sqrtf(s * (1.0f / 1024.0f) + EPS); }
    __syncthreads();
    float rt[8];
#pragma unroll
    for (int e = 0; e < 8; ++e) rt[e] = rstd[t8 + e];
#pragma unroll
    for (int half = 0; half < 2; ++half) {
#pragma unroll
        for (int k = 0; k < 8; ++k) { const int ck = half * 8 + k; float x[8]; unpack8(xw[ck], x); const float gg = gout[ck * 64 + c];
#pragma unroll
            for (int e = 0; e < 8; ++e) tile[k * (64 * 66) + c * 66 + t8 + e] = (bf16)f2bf(x[e] * rt[e] * gg); }
        __syncthreads();
        { const int t = tid >> 3, c8 = (tid & 7) * 8;
#pragma unroll
          for (int k = 0; k < 8; ++k) { const LAS bf16* tk = tile + k * (64 * 66); v4u w;
              w.x = (unsigned)tk[(c8 + 0) * 66 + t] | ((unsigned)tk[(c8 + 1) * 66 + t] << 16); w.y = (unsigned)tk[(c8 + 2) * 66 + t] | ((unsigned)tk[(c8 + 3) * 66 + t] << 16);
              w.z = (unsigned)tk[(c8 + 4) * 66 + t] | ((unsigned)tk[(c8 + 5) * 66 + t] << 16); w.w = (unsigned)tk[(c8 + 6) * 66 + t] | ((unsigned)tk[(c8 + 7) * 66 + t] << 16);
              *(GAS v4u*)(MX + (size_t)(m0 + t) * DM + (half * 8 + k) * 64 + c8) = w; } }
        __syncthreads();
    }
}
__device__ __forceinline__ void mixnorm_tokens(const bf16* Q, const bf16* Z, const float* DLSE, const float* gout, bf16* MX, int gw, int NGW, int lane) {
    for (int m = gw; m < TT; m += NGW) {
        v4u qw[3], zw[3];
#pragma unroll
        for (int j = 0; j < 3; ++j) { qw[j] = *(const GAS v4u*)(Q + (size_t)m * QC + lane * 8 + 512 * j); zw[j] = *(const GAS v4u*)(Z + (size_t)m * ZC + Z_DQ + lane * 8 + 512 * j); }
        {   float x[3][8]; float s = 0.f;
#pragma unroll
            for (int j = 0; j < 3; ++j) { unpack8(qw[j], x[j]);
#pragma unroll
                for (int e = 0; e < 8; ++e) s += x[j][e] * x[j][e]; }
            const float rs = 1.0f / sqrtf(wave_sum(s) * (1.0f / 1536.0f) + EPS);
#pragma unroll
            for (int j = 0; j < 3; ++j) { const int cc = lane * 8 + 512 * j; float y[8];
#pragma unroll
                for (int e = 0; e < 8; ++e) y[e] = x[j][e] * rs * gout[1024 + cc + e];
                *(GAS v4u*)(MX + (size_t)m * DM + 1024 + cc) = pack8(y); }
        }
        {   float x[3][8]; float s = 0.f;
#pragma unroll
            for (int j = 0; j < 3; ++j) { const int cc = lane * 8 + 512 * j, hd = cc >> 7, slot = hd & 3;
                const float l0 = DLSE[(size_t)m * 12 + slot], l1 = DLSE[(size_t)m * 12 + 4 + slot], l2 = DLSE[(size_t)m * 12 + 8 + slot], lm = fmaxf(l0, fmaxf(l1, l2));
                const float e0 = expf(l0 - lm), e1 = expf(l1 - lm), e2 = expf(l2 - lm), mine = (hd >> 2) == 0 ? e0 : ((hd >> 2) == 1 ? e1 : e2), alpha = mine / (e0 + e1 + e2);
                unpack8(zw[j], x[j]);
#pragma unroll
                for (int e = 0; e < 8; ++e) { x[j][e] *= alpha; s += x[j][e] * x[j][e]; } }
            const float rs = 1.0f / sqrtf(wave_sum(s) * (1.0f / 1536.0f) + EPS);
#pragma unroll
            for (int j = 0; j < 3; ++j) { const int cc = lane * 8 + 512 * j; float y[8];
#pragma unroll
                for (int e = 0; e < 8; ++e) y[e] = x[j][e] * rs * gout[2560 + cc + e];
                *(GAS v4u*)(MX + (size_t)m * DM + 2560 + cc) = pack8(y); }
        }
    }
}
#ifndef MK_N_LAUNCHES
#define MK_N_LAUNCHES 1
#endif
struct Args { const float* in[31]; float* out; unsigned char* ws; int ph_lo, ph_hi, li, pad; };
__global__ void __launch_bounds__(NWAVES * 64, 2) fwd(Args args) {
    extern __shared__ __attribute__((aligned(16))) unsigned char lds_raw[];
    LAS unsigned char* lds = (LAS unsigned char*)lds_raw;
    const int tid = threadIdx.x, wave = __builtin_amdgcn_readfirstlane(tid >> 6), G = gridDim.x, bid = blockIdx.x;
    const int NGW = G * NWAVES, NGT = G * NWAVES * 64;
    for (int u = tid; u < (PTAB_OFF - LDSCTL_OFF) / 4; u += NWAVES * 64) ((LAS unsigned*)(lds + LDSCTL_OFF))[u] = 0u;
    __syncthreads();
    const int lo = args.ph_lo, hi = args.ph_hi;
    XcdBarrier bar; bar.bar = (unsigned*)(args.ws + WS_CTL) + CW_BAR; bar.x = 0; bar.st = nullptr;
    if (hi - lo > 1) bar = xcd_barrier_post((unsigned*)(args.ws + WS_CTL) + CW_BAR, (volatile LAS unsigned*)(lds + MISC_OFF) + 8);
#define IN(k) (lo <= (k) && (k) < hi)
#define SEAM(k) do { if (IN(k) && IN((k) + 1)) xcd_barrier(bar); } while (0)
#define OPQ() int tid_ = tid, wave_ = wave; asm volatile("" : "+v"(tid_), "+s"(wave_)); tid_ &= 511; wave_ &= 7; const InTab in_{args.in}; unsigned char* const ws_ = args.ws; float* const out_ = args.out; (void)ws_; (void)out_; \
    const int lane_ = tid_ & 63, gw_ = bid * NWAVES + wave_, gt_ = bid * (NWAVES * 64) + tid_; (void)lane_; (void)gw_; (void)gt_
#define P_MIX ((bf16*)(ws_ + WS_MIX))
#define P_Z ((bf16*)(ws_ + WS_Z))
#define P_Q ((bf16*)(ws_ + WS_Q))
#define P_KV ((bf16*)(ws_ + WS_KV))
#define P_UT ((bf16*)(ws_ + WS_UT))
#define P_A2 ((bf16*)(ws_ + WS_A2))
#define P_CQ ((bf16*)(ws_ + WS_CQ))
#define P_CKV ((bf16*)(ws_ + WS_CKV))
#define P_KR ((bf16*)(ws_ + WS_KR))
#define P_X0T ((bf16*)(ws_ + WS_X0T))
#define P_YT ((bf16*)(ws_ + WS_YT))
#define P_DLSE ((float*)(ws_ + WS_DLSE))
#define P_XP (in_[0])
#define P_XS (in_[1] - (size_t)TP * DM)
#define P_WL (ws_ + WS_WT + (size_t)l * WT_LAYER)
#define P_XB ((bf16*)(ws_ + WS_XB))
#define P_SSQ(i) ((float*)(ws_ + WS_SSQ) + (size_t)(i) * TT)
#define P_SSQP ((float*)(ws_ + WS_SSQP))

    if (IN(0)) {
        OPQ();
        for (int it = bid; it < NLAYER * 160; it += G) { const int layer = it / 160, r = it % 160; filter_item(in_, ws_, layer, r >= 32 ? 1 : 0, r >= 32 ? r - 32 : r, lds, tid_, lane_, wave_); }
        p0_weights(in_, ws_, (LAS float*)(lds + wave_ * 16384), gw_, NGW, lane_);
        p0_misc(ws_, gt_, NGT);
        cvt_rows(P_XP, P_XS, P_XB, P_SSQ(0), gw_, NGW, lane_);
    }
    SEAM(0);
#pragma unroll 1
    for (int l = 0; l < NLAYER; ++l) {
        const int pb = 1 + l * NPH_LAYER;
        if (IN(pb + 0)) {
            OPQ(); pg8::Gemm g{P_XB, (const bf16*)(P_WL + WT_IN), TT, ZC, DM}; pg8::StaticOrder S; S.init(TT, ZC, G, bid);
            pg8::EpiInProj E{P_Z, ZC, P_SSQ(2 * l), in_[24] + l * 128, in_[25] + l * 128, (const float*)(ws_ + WS_R128), (LAS float*)(lds + KVTAB_OFF)};
            pg8::gemm_phase<pg8::EpiInProj, pg8::StaticOrder, true, true>(lds, g, S, E);
        }
        SEAM(pb + 0);
        if (IN(pb + 1)) {
            OPQ();
            prep_hyena(P_Z, in_[4] + (size_t)l * 3 * 3072, in_[5] + (size_t)l * 3072, P_UT, P_X0T, lds, tid_, bid, G);
            prep_tokens(P_Z, in_, l, ws_, gw_, NGW, lane_);
        }
        SEAM(pb + 1);
        if (IN(pb + 2)) {
            { OPQ(); pg8::Gemm g{P_CQ, (const bf16*)(P_WL + WT_QB), TT, QC, 1536}; pg8::StaticOrder S; S.init(TT, QC, G, bid); pg8::EpiBf16<0> E{P_Q, QC, nullptr};
              pg8::gemm_phase<pg8::EpiBf16<0>, pg8::StaticOrder, true, true>(lds, g, S, E); }
            { OPQ(); pg8::Gemm g{P_CKV, (const bf16*)(P_WL + WT_KVB), TT, KVC, 512}; pg8::StaticOrder S; S.init(TT, KVC, G, (bid + (G >> 1)) % G);     pg8::EpiKv E{P_KV, KVC, in_[22] + l * 128, (LAS float*)(lds + KVTAB_OFF)};
              pg8::gemm_phase<pg8::EpiKv, pg8::StaticOrder, true, true>(lds, g, S, E); }
            { OPQ(); const unsigned char* fl = ws_ + WS_FILT + (size_t)l * FILT_LAYER;
              v4u upre[4] = {{0u, 0u, 0u, 0u}, {0u, 0u, 0u, 0u}, {0u, 0u, 0u, 0u}, {0u, 0u, 0u, 0u}}; bool pv = false;
              for (int u = bid; u < 2048; u += G) {
                  const int c = u & 1023; const float skip = in_[15][l * 1024 + c];
                  const int un = u + G; const bf16* nxt = un < 2048 ? P_UT + (size_t)(un & 1023) * TT + (un >= 1024 ? TP : 0) : nullptr; const int nnp = un >= 1024 ? 2 : 4;
                  if (u < 1024) conv_unit<0>(c, (const bf16*)fl + (size_t)c * 4096, P_UT, P_X0T, P_YT, skip, lds, tid_, lane_, wave_, upre, pv, nxt, nnp);
                  else conv_unit<1>(c, (const bf16*)(fl + FILT_S_OFF) + (size_t)c * 16384, P_UT, P_X0T, P_YT, skip, lds, tid_, lane_, wave_, upre, pv, nxt, nnp);
                  pv = nxt != nullptr;
              } }
            { OPQ(); for (int wu = (bid + (G >> 1)) % G; wu < 1152; wu += G) dil_unit(P_Z, P_Z + Z_DQ, ZC, P_DLSE, wu, lds, tid_, lane_, wave_); }
        }
        SEAM(pb + 2);
        if (IN(pb + 3)) { OPQ(); mla_phase(P_Q, P_KV, P_KR, in_[20] + l * 128, in_[21] + l * 64, (const GAS f32x2v*)(ws_ + WS_R64), P_Q, QC, lds, tid_, lane_, wave_, bid, G); }
        SEAM(pb + 3);
        if (IN(pb + 4)) { OPQ(); for (int tb = bid; tb < 384; tb += G) mixnorm_hyena(tb, P_YT, in_[26] + (size_t)l * DM, P_MIX, lds, tid_, lane_, wave_);
            mixnorm_tokens(P_Q, P_Z, P_DLSE, in_[26] + (size_t)l * DM, P_MIX, gw_, NGW, lane_); }
        SEAM(pb + 4);
        if (IN(pb + 5)) {
            OPQ(); pg8::Gemm g{P_MIX, (const bf16*)(P_WL + WT_OUT), TT, DM, DM}; pg8::StaticOrder S; S.init(TT, DM, G, bid);
            { pg8::EpiRes<false, false> E{nullptr, nullptr, 0, P_XB, P_SSQP, nullptr, (LAS float*)(lds + KVTAB_OFF)}; pg8::gemm_phase<pg8::EpiRes<false, false>, pg8::StaticOrder, true, true>(lds, g, S, E); }
        }
        SEAM(pb + 5);
        if (IN(pb + 6)) { OPQ(); rstd_rows(P_SSQP, P_SSQ(2 * l + 1), gt_, NGT); }
        SEAM(pb + 6);
        if (IN(pb + 7)) {
            OPQ(); pg8::Gemm g{P_XB, (const bf16*)(P_WL + WT_UP), TT, DFF, DM}; pg8::StaticOrder S; S.init(TT, DFF, G, bid); pg8::EpiBf16<1> E{P_A2, DFF, P_SSQ(2 * l + 1)};
            pg8::gemm_phase<pg8::EpiBf16<1>, pg8::StaticOrder, true, true>(lds, g, S, E);
        }
        SEAM(pb + 7);
        if (IN(pb + 8)) {
            OPQ(); pg8::Gemm g{P_A2, (const bf16*)(P_WL + WT_DN), TT, DM, DFF}; pg8::StaticOrder S; S.init(TT, DM, G, bid);
            if (l + 1 < NLAYER) { pg8::EpiRes<false, false> E{nullptr, nullptr, 0, P_XB, P_SSQP, nullptr, (LAS float*)(lds + KVTAB_OFF)}; pg8::gemm_phase<pg8::EpiRes<false, false>, pg8::StaticOrder, true, true>(lds, g, S, E); }
            else { pg8::EpiRes<false, true> E{nullptr, nullptr, 0, P_XB, nullptr, out_, (LAS float*)(lds + KVTAB_OFF)}; pg8::gemm_phase<pg8::EpiRes<false, true>, pg8::StaticOrder, true, true>(lds, g, S, E); }
        }
        if (l + 1 < NLAYER) SEAM(pb + 8);
        if (IN(pb + 9) && l + 1 < NLAYER) { OPQ(); rstd_rows(P_SSQP, P_SSQ(2 * l + 2), gt_, NGT); }
        SEAM(pb + 9);
    }
#undef IN
#undef SEAM
}

extern "C" void kernel_launch(void* const* d_in, const int* in_sizes, int n_in, void* d_out, int out_size, void* d_ws, size_t ws_size, hipStream_t stream) {
    static int grid = 0;
    if (grid == 0) {
        if (n_in != 31 || in_sizes[0] != TP * DM || in_sizes[1] != TS * DM || out_size != TT * DM || ws_size < WS_END) {
            fprintf(stderr, "kernel_launch: shape mismatch: n_in %d in0 %d in1 %d out %d ws %zu (need >= %zu); nothing launched\n", n_in, n_in > 0 ? in_sizes[0] : -1, n_in > 1 ? in_sizes[1] : -1, out_size, ws_size, (size_t)WS_END); grid = -1; return; }
        int dev = 0, cus = 0, per_cu = 0;
        if (hipGetDevice(&dev) != hipSuccess || hipDeviceGetAttribute(&cus, hipDeviceAttributeMultiprocessorCount, dev) != hipSuccess) { fprintf(stderr, "kernel_launch: device query failed\n"); grid = -1; return; }
        if (hipFuncSetAttribute((const void*)fwd, hipFuncAttributeMaxDynamicSharedMemorySize, LDS_BYTES) != hipSuccess) { fprintf(stderr, "kernel_launch: hipFuncSetAttribute failed\n"); grid = -1; return; }
        if (hipOccupancyMaxActiveBlocksPerMultiprocessor(&per_cu, (const void*)fwd, NWAVES * 64, LDS_BYTES) != hipSuccess || per_cu < 1) fprintf(stderr, "kernel_launch: occupancy query says %d\n", per_cu);
        (void)hipGetLastError();
        grid = cus;
    }
    if (grid < 0) return;
    if (hipMemsetAsync((char*)d_ws + WS_CTL, 0, CTL_ZERO_BYTES, stream) != hipSuccess) { fprintf(stderr, "kernel_launch: memset failed\n"); return; }
    Args a{};
    for (int i = 0; i < 31; ++i) a.in[i] = (const float*)d_in[i];
    a.out = (float*)d_out; a.ws = (unsigned char*)d_ws;
    if (MK_N_LAUNCHES == 1) { a.ph_lo = 0; a.ph_hi = NPHASES; a.li = 0; hipLaunchKernelGGL(fwd, dim3(grid), dim3(NWAVES * 64), LDS_BYTES, stream, a); }
    else for (int p = 0; p < NPHASES; ++p) { a.ph_lo = p; a.ph_hi = p + 1; a.li = p; hipLaunchKernelGGL(fwd, dim3(grid), dim3(NWAVES * 64), LDS_BYTES, stream, a); }
    const hipError_t le = hipPeekAtLastError();
    if (le != hipSuccess) fprintf(stderr, "kernel_launch: launch failed: %s\n", hipGetErrorName(le));
}
```

```cpp
#include <hip/hip_runtime.h>
#include <cstdio>
#include <cstdint>
#define MK_N_LAUNCHES 1
namespace pg8 {
#define PG8_LAS __attribute__((address_space(3)))
typedef unsigned short bf16_t;
typedef short bf16x8 __attribute__((ext_vector_type(8)));
typedef float f32x4 __attribute__((ext_vector_type(4)));
typedef unsigned u32x4 __attribute__((ext_vector_type(4)));
constexpr int BM = 256, BK = 64, HALF = 128, HTB = HALF * BK * 2  , STAGE_BYTES = 8 * HTB, NXCD = 8, WGM = 8;

__host__ __device__ __forceinline__ int lds_byte(int r, int c) { const int st = (r >> 4) * 2 + (c >> 5), rr = r & 15, cc = c & 31, ob = rr * 64 + cc * 2; return st * 1024 + (ob ^ (((ob >> 9) & 1) << 5)); }
__host__ __device__ __forceinline__ void stage_rc(int b, int& R, int& C) { const int st = b / 1024, sb = b % 1024, swz = sb ^ (((sb >> 9) & 1) << 5); R = (st >> 1) * 16 + swz / 64; C = (st & 1) * 32 + (swz % 64) / 2; }
__host__ __device__ __forceinline__ int perm32(int rho) { const int n = rho >> 4, i = rho & 15; return 8 * (i >> 2) + 4 * n + (i & 3); }

struct Unit { int pm, pn; };
struct Gemm { const bf16_t* A; const bf16_t* Bt; int M, N, K; };

struct StaticOrder {
    int nM, nN, nwg, G, c;
    __host__ __device__ void init(int M, int N, int G_, int c_) { nM = M / BM; nN = N / BM; nwg = nM * nN; G = G_; c = c_; }
    __host__ __device__ bool next(int i, Unit& u) const {
        const long L = (long)i * G + c; if (L >= nwg) return false;
        int wgid = (int)L; { const int q = nwg / NXCD, r = nwg % NXCD, xcd = wgid % NXCD, off = wgid / NXCD; wgid = (xcd < r ? xcd * (q + 1) : r * (q + 1) + (xcd - r) * q) + off; }
        const int nig = WGM * nN, gid = wgid / nig, fm = gid * WGM, gsz = (nM - fm) < WGM ? (nM - fm) : WGM;
        u.pm = fm + ((wgid % nig) % gsz); u.pn = (wgid % nig) / gsz; return true;
    }
    __device__ __forceinline__ void a_ready(const Unit&) const {}
    __device__ __forceinline__ void done(const Unit&) const {}
};

__device__ __forceinline__ unsigned cvt_pk_bf16(float lo, float hi) { unsigned r; asm volatile("v_cvt_pk_bf16_f32 %0, %1, %2" : "=v"(r) : "v"(lo), "v"(hi)); return r; }
typedef float f32x2 __attribute__((ext_vector_type(2)));
#ifndef EPI_NT
#define EPI_NT 0
#endif
template <int ACT  > struct EpiBf16 {
    static constexpr bool PERM = true, AFTER_DRAIN = false;
    bf16_t* O; int ldc; const float* ssq;
    __device__ __forceinline__ void operator()(const f32x4 (&acc)[2][2][4][2], const Unit& u, int wr, int wc, int fr, int fq) const {
        const int row0 = u.pm * BM + wr * 64 + fr, col0 = u.pn * BM + wc * 32 + 8 * fq;
        float rs[2][4];
#pragma unroll
        for (int ai = 0; ai < 2; ++ai)
#pragma unroll
            for (int m = 0; m < 4; ++m) rs[ai][m] = ssq ? ssq[row0 + ai * HALF + m * 16] : 1.0f;
#pragma unroll
        for (int ai = 0; ai < 2; ++ai)
#pragma unroll
            for (int m = 0; m < 4; ++m) { bf16_t* rowp = O + (size_t)(row0 + ai * HALF + m * 16) * ldc + col0;
#pragma unroll
                for (int bj = 0; bj < 2; ++bj) { f32x4 v0 = acc[ai][bj][m][0] * rs[ai][m], v1 = acc[ai][bj][m][1] * rs[ai][m];
                    if (ACT == 1) {
#pragma unroll
                        for (int j = 0; j < 4; ++j) { const float a = fmaxf(v0[j], 0.f), b = fmaxf(v1[j], 0.f); v0[j] = a * a; v1[j] = b * b; } }
                    u32x4 w; w.x = cvt_pk_bf16(v0[0], v0[1]); w.y = cvt_pk_bf16(v0[2], v0[3]); w.z = cvt_pk_bf16(v1[0], v1[1]); w.w = cvt_pk_bf16(v1[2], v1[3]);
                    if (EPI_NT) __builtin_nontemporal_store(w, (u32x4*)(rowp + bj * HALF)); else *(u32x4*)(rowp + bj * HALF) = w; } }
    }
};
template <bool RES32, bool OUT32> struct EpiRes {
    static constexpr bool PERM = false, AFTER_DRAIN = false;
    const float* r0; const float* r1; int pm_split; bf16_t* xb; float* ssq  ; float* out; PG8_LAS float* tab  ;
    __device__ __forceinline__ void operator()(const f32x4 (&acc)[2][2][4][2], const Unit& u, int wr, int wc, int fr, int fq) const {
        typedef unsigned u32x2e __attribute__((ext_vector_type(2)));
        const int row0 = u.pm * BM + wr * 64 + fr, col0 = u.pn * BM + wc * 32 + 4 * fq;
        const float* rb = (u.pm < pm_split) ? r0 : r1;
#pragma unroll
        for (int ai = 0; ai < 2; ++ai)
#pragma unroll
            for (int m = 0; m < 4; ++m) { const size_t off = (size_t)(row0 + ai * HALF + m * 16) * 4096 + col0;
                f32x4 x[2][2];
#pragma unroll
                for (int bj = 0; bj < 2; ++bj)
#pragma unroll
                    for (int n = 0; n < 2; ++n) {
                        if (RES32) x[bj][n] = *(const f32x4*)(rb + off + bj * HALF + n * 16);
                        else { const u32x2e w = *(const u32x2e*)(xb + off + bj * HALF + n * 16); x[bj][n] = (f32x4){__uint_as_float(w.x << 16), __uint_as_float(w.x & 0xffff0000u), __uint_as_float(w.y << 16), __uint_as_float(w.y & 0xffff0000u)}; } }
                float sq = 0.f;
#pragma unroll
                for (int bj = 0; bj < 2; ++bj)
#pragma unroll
                    for (int n = 0; n < 2; ++n) { const f32x4 v = x[bj][n] + acc[ai][bj][m][n];
                        if (OUT32) *(f32x4*)(out + off + bj * HALF + n * 16) = v;
                        else { sq += (v[0] * v[0] + v[1] * v[1]) + (v[2] * v[2] + v[3] * v[3]); u32x2e w; w.x = cvt_pk_bf16(v[0], v[1]); w.y = cvt_pk_bf16(v[2], v[3]); *(u32x2e*)(xb + off + bj * HALF + n * 16) = w; } }
                if (!OUT32) { sq += __shfl_xor(sq, 16); sq += __shfl_xor(sq, 32); if (fq == 0) tab[(ai * HALF + wr * 64 + m * 16 + fr) * 4 + wc] = sq; }
                asm volatile("" ::: "memory"); }
        if (!OUT32) {
            asm volatile("s_waitcnt lgkmcnt(0)" ::: "memory"); __builtin_amdgcn_s_barrier(); asm volatile("" ::: "memory");
            const int t = (wr * 4 + wc) * 64 + fq * 16 + fr;
            if (t < 256) { const f32x4 p = *(const PG8_LAS f32x4*)(tab + t * 4); ssq[(size_t)(u.pm * BM + t) * 16 + u.pn] = (p[0] + p[1]) + (p[2] + p[3]); }
        }
    }
};

struct EpiKv {
    static constexpr bool PERM = true, AFTER_DRAIN = false;
    bf16_t* O; int ldc; const float* gain; PG8_LAS float* tab;
    __device__ __forceinline__ void operator()(const f32x4 (&acc)[2][2][4][2], const Unit& u, int wr, int wc, int fr, int fq) const {
        const int row0 = u.pm * BM + wr * 64 + fr, col0 = u.pn * BM + wc * 32 + 8 * fq;
#pragma unroll
        for (int ai = 0; ai < 2; ++ai)
#pragma unroll
            for (int m = 0; m < 4; ++m) { const f32x4 a = acc[ai][0][m][0], b = acc[ai][0][m][1]; float s = (a[0] * a[0] + a[1] * a[1]) + (a[2] * a[2] + a[3] * a[3]) + (b[0] * b[0] + b[1] * b[1]) + (b[2] * b[2] + b[3] * b[3]);
                s += __shfl_xor(s, 16); s += __shfl_xor(s, 32);
                if (fq == 0) tab[(ai * HALF + wr * 64 + m * 16 + fr) * 4 + wc] = s; }
        asm volatile("s_waitcnt lgkmcnt(0)" ::: "memory"); __builtin_amdgcn_s_barrier(); asm volatile("" ::: "memory");
        const f32x4 g0 = *(const f32x4*)(gain + wc * 32 + 8 * fq), g1 = *(const f32x4*)(gain + wc * 32 + 8 * fq + 4);
#pragma unroll
        for (int ai = 0; ai < 2; ++ai)
#pragma unroll
            for (int m = 0; m < 4; ++m) { bf16_t* rowp = O + (size_t)(row0 + ai * HALF + m * 16) * ldc + col0;
                const f32x4 t = *(const PG8_LAS f32x4*)(tab + (ai * HALF + wr * 64 + m * 16 + fr) * 4); const float rs = 1.0f / sqrtf(((t[0] + t[1]) + (t[2] + t[3])) * (1.0f / 128.0f) + 1e-6f);
                { const f32x4 v0 = acc[ai][0][m][0] * rs * g0, v1 = acc[ai][0][m][1] * rs * g1; u32x4 w; w.x = cvt_pk_bf16(v0[0], v0[1]); w.y = cvt_pk_bf16(v0[2], v0[3]); w.z = cvt_pk_bf16(v1[0], v1[1]); w.w = cvt_pk_bf16(v1[2], v1[3]); *(u32x4*)rowp = w; }
                { const f32x4 v0 = acc[ai][1][m][0], v1 = acc[ai][1][m][1]; u32x4 w; w.x = cvt_pk_bf16(v0[0], v0[1]); w.y = cvt_pk_bf16(v0[2], v0[3]); w.z = cvt_pk_bf16(v1[0], v1[1]); w.w = cvt_pk_bf16(v1[2], v1[3]); *(u32x4*)(rowp + HALF) = w; } }
    }
};

struct EpiInProj {
    static constexpr bool PERM = true, AFTER_DRAIN = false;
    bf16_t* O; int ldc; const float* ssq; const float* gq; const float* gk; const float* rope  ; PG8_LAS float* tab;
    __device__ __forceinline__ void operator()(const f32x4 (&acc)[2][2][4][2], const Unit& u, int wr, int wc, int fr, int fq) const {
        const int row0 = u.pm * BM + wr * 64 + fr, col0 = u.pn * BM + wc * 32 + 8 * fq;
        if (u.pn >= 21 && u.pn < 33) {
#pragma unroll
            for (int ai = 0; ai < 2; ++ai)
#pragma unroll
                for (int m = 0; m < 4; ++m)
#pragma unroll
                    for (int bj = 0; bj < 2; ++bj) { const f32x4 a = acc[ai][bj][m][0], b = acc[ai][bj][m][1]; float s = (a[0] * a[0] + a[1] * a[1]) + (a[2] * a[2] + a[3] * a[3]) + (b[0] * b[0] + b[1] * b[1]) + (b[2] * b[2] + b[3] * b[3]);
                        s += __shfl_xor(s, 16); s += __shfl_xor(s, 32);
                        if (fq == 0) tab[((ai * HALF + wr * 64 + m * 16 + fr) * 2 + bj) * 4 + wc] = s; }
            asm volatile("s_waitcnt lgkmcnt(0)" ::: "memory"); __builtin_amdgcn_s_barrier(); asm volatile("" ::: "memory");
            const float* gg = u.pn < 27 ? gq : gk; const int i0 = 16 * wc + 4 * fq;
            const f32x4 g1 = *(const f32x4*)(gg + i0), g2 = *(const f32x4*)(gg + 64 + i0);
#pragma unroll
            for (int ai = 0; ai < 2; ++ai)
#pragma unroll
                for (int m = 0; m < 4; ++m) { const int row = row0 + ai * HALF + m * 16, pos = row < 16384 ? (row & 2047) : row - 16384; bf16_t* rowp = O + (size_t)row * ldc + col0;
                    const f32x4 cs0 = *(const f32x4*)(rope + (size_t)(pos * 64 + i0) * 2), cs1 = *(const f32x4*)(rope + (size_t)(pos * 64 + i0) * 2 + 4);
#pragma unroll
                    for (int bj = 0; bj < 2; ++bj) { const f32x4 t = *(const PG8_LAS f32x4*)(tab + ((ai * HALF + wr * 64 + m * 16 + fr) * 2 + bj) * 4); const float rs = 1.0f / sqrtf(((t[0] + t[1]) + (t[2] + t[3])) * (1.0f / 128.0f) + 1e-6f);
                        const f32x4 v0 = acc[ai][bj][m][0], v1 = acc[ai][bj][m][1];
                        const float a0 = v0[0] * rs * g1[0], b0 = v0[1] * rs * g2[0], a1 = v0[2] * rs * g1[1], b1 = v0[3] * rs * g2[1], a2 = v1[0] * rs * g1[2], b2 = v1[1] * rs * g2[2], a3 = v1[2] * rs * g1[3], b3 = v1[3] * rs * g2[3];
                        u32x4 w; w.x = cvt_pk_bf16(a0 * cs0[0] - b0 * cs0[1], b0 * cs0[0] + a0 * cs0[1]); w.y = cvt_pk_bf16(a1 * cs0[2] - b1 * cs0[3], b1 * cs0[2] + a1 * cs0[3]);
                        w.z = cvt_pk_bf16(a2 * cs1[0] - b2 * cs1[1], b2 * cs1[0] + a2 * cs1[1]); w.w = cvt_pk_bf16(a3 * cs1[2] - b3 * cs1[3], b3 * cs1[2] + a3 * cs1[3]);
                        *(u32x4*)(rowp + bj * HALF) = w; } }
        } else {
            float rs[2][4];
#pragma unroll
            for (int ai = 0; ai < 2; ++ai)
#pragma unroll
                for (int m = 0; m < 4; ++m) rs[ai][m] = ssq[row0 + ai * HALF + m * 16];
#pragma unroll
            for (int ai = 0; ai < 2; ++ai)
#pragma unroll
                for (int m = 0; m < 4; ++m) { bf16_t* rowp = O + (size_t)(row0 + ai * HALF + m * 16) * ldc + col0;
#pragma unroll
                    for (int bj = 0; bj < 2; ++bj) { const f32x4 v0 = acc[ai][bj][m][0] * rs[ai][m], v1 = acc[ai][bj][m][1] * rs[ai][m];
                        u32x4 w; w.x = cvt_pk_bf16(v0[0], v0[1]); w.y = cvt_pk_bf16(v0[2], v0[3]); w.z = cvt_pk_bf16(v1[0], v1[1]); w.w = cvt_pk_bf16(v1[2], v1[3]);
                        *(u32x4*)(rowp + bj * HALF) = w; } }
        }
    }
};
__device__ __forceinline__ const char* pg8_uni(const char* p) { const unsigned long long v = (unsigned long long)p;
    const unsigned lo = (unsigned)__builtin_amdgcn_readfirstlane((int)(unsigned)v), hi = (unsigned)__builtin_amdgcn_readfirstlane((int)(unsigned)(v >> 32)); return (const char*)(((unsigned long long)hi << 32) | lo); }
template <class Epi, class Sched, bool ALIGN_EPI = false, bool SP2 = false>
__device__ __forceinline__ void gemm_phase(PG8_LAS unsigned char* lds, const Gemm g, const Sched& S, const Epi& E) {
    int tid_o = threadIdx.x; asm volatile("" : "+v"(tid_o));
    const int tid = tid_o & 511, wid = __builtin_amdgcn_readfirstlane(tid >> 6), lane = tid & 63, wr = wid >> 2, wc = wid & 3, fr = lane & 15, fq = lane >> 4;
    const int K = g.K, nt = K / BK;
    unsigned voffA[2], voffB[2];
#pragma unroll
    for (int i = 0; i < 2; ++i) { int R, C; stage_rc(tid * 16 + i * 8192, R, C); const int Rb = Epi::PERM ? ((R & ~31) + perm32(R & 31)) : R;
        voffA[i] = (unsigned)(R * K + C) * 2u; voffB[i] = (unsigned)(Rb * K + C) * 2u; }
    const size_t kstep = (size_t)(BK * 2);
    const size_t hstep = (size_t)HALF * K * 2;
    const size_t tstep = 2 * hstep;
    const unsigned ldsw = (unsigned)wid * 1024u;
    const int aoff = lds_byte(wr * 64 + fr, fq * 8), boff = lds_byte(wc * 32 + fr, fq * 8);
#define PG8_SA(b, h) (((b) * 2 + (h)) * HTB)
#define PG8_SB(b, h) ((4 + (b) * 2 + (h)) * HTB)
#define PG8_STAGE(bufoff, gbase, voff) do { _Pragma("unroll") for (int _i = 0; _i < 2; ++_i) { asm volatile("" : "+v"((voff)[_i])); \
        __builtin_amdgcn_global_load_lds((const unsigned*)(pg8_uni((const char*)(gbase)) + (voff)[_i]), (PG8_LAS unsigned*)(lds + (bufoff) + ldsw + _i * 8192), 16, 0, 0); } } while (0)
#define PG8_LDA(dst, b, h) do { _Pragma("unroll") for (int m = 0; m < 4; ++m) _Pragma("unroll") for (int k = 0; k < 2; ++k) dst[m][k] = *(const PG8_LAS bf16x8*)(lds + PG8_SA(b, h) + aoff + m * 2048 + k * 1024); } while (0)
#define PG8_LDB(dst, b, h) do { _Pragma("unroll") for (int n = 0; n < 2; ++n) _Pragma("unroll") for (int k = 0; k < 2; ++k) dst[n][k] = *(const PG8_LAS bf16x8*)(lds + PG8_SB(b, h) + boff + n * 2048 + k * 1024); } while (0)
#define PG8_MMA(ai, bj, At, Bt) do { __builtin_amdgcn_s_setprio(1); _Pragma("unroll") for (int m = 0; m < 4; ++m) _Pragma("unroll") for (int n = 0; n < 2; ++n) _Pragma("unroll") for (int k = 0; k < 2; ++k) \
        acc[ai][bj][m][n] = __builtin_amdgcn_mfma_f32_16x16x32_bf16(Bt[n][k], At[m][k], acc[ai][bj][m][n], 0, 0, 0); __builtin_amdgcn_s_setprio(0); } while (0)
#define PG8_WAIT_V(n) asm volatile("s_waitcnt vmcnt(" #n ")" ::: "memory")
#define PG8_WAIT_L(n) asm volatile("s_waitcnt lgkmcnt(" #n ")" ::: "memory")
#define PG8_BAR __builtin_amdgcn_s_barrier()
#define PG8_SCHED __builtin_amdgcn_sched_barrier(0)
    Unit cur, nxt; int ui = 0;
    if (!S.next(0, cur)) return;
    f32x4 acc[2][2][4][2];
#pragma unroll
    for (int a = 0; a < 2; ++a)
#pragma unroll
        for (int b = 0; b < 2; ++b)
#pragma unroll
            for (int m = 0; m < 4; ++m)
#pragma unroll
                for (int n = 0; n < 2; ++n) acc[a][b][m][n] = (f32x4){0.f, 0.f, 0.f, 0.f};
    bf16x8 At[4][2], B0[2][2], B1[2][2];
    const char* cA = (const char*)g.A + (size_t)cur.pm * tstep; const char* cB = (const char*)g.Bt + (size_t)cur.pn * tstep;
    S.a_ready(cur);
    if constexpr (SP2) {
        PG8_STAGE(PG8_SB(0, 0), cB, voffB); PG8_STAGE(PG8_SB(0, 1), cB + hstep, voffB); PG8_STAGE(PG8_SA(0, 0), cA, voffA); PG8_STAGE(PG8_SA(0, 1), cA + hstep, voffA);
        if (wr == 1) PG8_BAR;
        PG8_WAIT_V(2); PG8_BAR;
        PG8_STAGE(PG8_SB(1, 0), cB + kstep, voffB); PG8_STAGE(PG8_SA(1, 0), cA + kstep, voffA); PG8_STAGE(PG8_SB(1, 1), cB + hstep + kstep, voffB);
        PG8_WAIT_V(6); PG8_BAR;
    } else {
        PG8_STAGE(PG8_SB(0, 0), cB, voffB); PG8_STAGE(PG8_SA(0, 0), cA, voffA); PG8_STAGE(PG8_SB(0, 1), cB + hstep, voffB); PG8_STAGE(PG8_SA(0, 1), cA + hstep, voffA);
        if (wr == 1) PG8_BAR;
        PG8_WAIT_V(4); PG8_BAR;
        PG8_STAGE(PG8_SB(1, 0), cB + kstep, voffB); PG8_STAGE(PG8_SA(1, 0), cA + kstep, voffA); PG8_STAGE(PG8_SB(1, 1), cB + hstep + kstep, voffB);
        PG8_WAIT_V(6); PG8_BAR;
    }
    for (;;) {
        const bool has_next = S.next(ui + 1, nxt);
        const char* nA = has_next ? (const char*)g.A + (size_t)nxt.pm * tstep : cA; const char* nB = has_next ? (const char*)g.Bt + (size_t)nxt.pn * tstep : cB;
        for (int t = 0; t < nt; t += 2) {
            const bool last = (t == nt - 2);
            const char* a1 = cA + (size_t)(t + 1) * kstep;
            const char* a2 = last ? nA : cA + (size_t)(t + 2) * kstep; const char* b2 = last ? nB : cB + (size_t)(t + 2) * kstep;
            const char* a3 = a2 + kstep; const char* b3 = b2 + kstep;
            if (last && has_next) S.a_ready(nxt);
            if constexpr (SP2) {
            PG8_LDB(B0, 0, 0); PG8_LDB(B1, 0, 1); PG8_SCHED; PG8_LDA(At, 0, 0); PG8_STAGE(PG8_SA(1, 1), a1 + hstep, voffA);
            PG8_WAIT_V(8); PG8_WAIT_L(0); PG8_BAR; PG8_MMA(0, 0, At, B0); PG8_MMA(0, 1, At, B1); PG8_BAR; PG8_SCHED;
            PG8_LDA(At, 0, 1); PG8_STAGE(PG8_SB(0, 0), b2, voffB); PG8_STAGE(PG8_SB(0, 1), b2 + hstep, voffB); PG8_STAGE(PG8_SA(0, 0), a2, voffA);
            PG8_WAIT_V(8); PG8_WAIT_L(0); PG8_BAR; PG8_MMA(1, 0, At, B0); PG8_MMA(1, 1, At, B1); PG8_BAR; PG8_SCHED;
            PG8_LDB(B0, 1, 0); PG8_LDB(B1, 1, 1); PG8_SCHED; PG8_LDA(At, 1, 0); PG8_STAGE(PG8_SA(0, 1), a2 + hstep, voffA);
            PG8_WAIT_V(8); PG8_WAIT_L(0); PG8_BAR; PG8_MMA(0, 0, At, B0); PG8_MMA(0, 1, At, B1); PG8_BAR; PG8_SCHED;
            PG8_LDA(At, 1, 1); PG8_STAGE(PG8_SB(1, 0), b3, voffB); PG8_STAGE(PG8_SB(1, 1), b3 + hstep, voffB); PG8_STAGE(PG8_SA(1, 0), a3, voffA);
            PG8_WAIT_V(8); PG8_WAIT_L(0); PG8_BAR; PG8_MMA(1, 0, At, B0); PG8_MMA(1, 1, At, B1); PG8_BAR; PG8_SCHED;
            } else {
            PG8_LDB(B0, 0, 0); PG8_SCHED; PG8_LDA(At, 0, 0); PG8_STAGE(PG8_SA(1, 1), a1 + hstep, voffA);
            PG8_WAIT_L(8); PG8_BAR; PG8_WAIT_L(0); PG8_MMA(0, 0, At, B0); PG8_BAR; PG8_SCHED;
            PG8_LDB(B1, 0, 1); PG8_STAGE(PG8_SB(0, 0), b2, voffB);
            PG8_BAR; PG8_WAIT_L(0); PG8_MMA(0, 1, At, B1); PG8_BAR;
            PG8_LDA(At, 0, 1); PG8_STAGE(PG8_SA(0, 0), a2, voffA);
            PG8_BAR; PG8_WAIT_L(0); PG8_MMA(1, 0, At, B0); PG8_BAR; PG8_SCHED;
            PG8_STAGE(PG8_SB(0, 1), b2 + hstep, voffB);
            PG8_WAIT_V(6); PG8_BAR; PG8_MMA(1, 1, At, B1); PG8_BAR;
            PG8_LDB(B0, 1, 0); PG8_SCHED; PG8_LDA(At, 1, 0); PG8_STAGE(PG8_SA(0, 1), a2 + hstep, voffA);
            PG8_WAIT_L(8); PG8_BAR; PG8_WAIT_L(0); PG8_MMA(0, 0, At, B0); PG8_BAR; PG8_SCHED;
            PG8_LDB(B1, 1, 1); PG8_STAGE(PG8_SB(1, 0), b3, voffB);
            PG8_BAR; PG8_WAIT_L(0); PG8_MMA(0, 1, At, B1); PG8_BAR;
            PG8_LDA(At, 1, 1); PG8_STAGE(PG8_SA(1, 0), a3, voffA);
            PG8_BAR; PG8_WAIT_L(0); PG8_MMA(1, 0, At, B0); PG8_BAR; PG8_SCHED;
            PG8_STAGE(PG8_SB(1, 1), b3 + hstep, voffB);
            PG8_WAIT_V(6); PG8_BAR; PG8_MMA(1, 1, At, B1); PG8_BAR;
            }
        }
        if constexpr (ALIGN_EPI) { if (wr == 0) PG8_BAR; }
        if constexpr (!Epi::AFTER_DRAIN) { E(acc, cur, wr, wc, fr, fq); S.done(cur); }
        if (!has_next) break;
#pragma unroll
        for (int a = 0; a < 2; ++a)
#pragma unroll
            for (int b = 0; b < 2; ++b)
#pragma unroll
                for (int m = 0; m < 4; ++m)
#pragma unroll
                    for (int n = 0; n < 2; ++n) acc[a][b][m][n] = (f32x4){0.f, 0.f, 0.f, 0.f};
        cur = nxt; cA = nA; cB = nB; ++ui;
        if constexpr (ALIGN_EPI) { if (wr == 1) PG8_BAR; }
    }
    PG8_WAIT_V(0);
    if constexpr (!ALIGN_EPI) { if (wr == 0) PG8_BAR; }
    PG8_BAR;
    if constexpr (Epi::AFTER_DRAIN) { E.fused(acc, cur, wr, wc, fr, fq, lds, wid, lane); S.done(cur); }
#undef PG8_SA
#undef PG8_SB
#undef PG8_STAGE
#undef PG8_LDA
#undef PG8_LDB
#undef PG8_MMA
#undef PG8_WAIT_V
#undef PG8_WAIT_L
#undef PG8_BAR
#undef PG8_SCHED
}
}
#define GAS __attribute__((address_space(1)))
#define LAS __attribute__((address_space(3)))
typedef unsigned short bf16;
typedef unsigned v4u __attribute__((ext_vector_type(4)));
typedef float f32x4 __attribute__((ext_vector_type(4)));
typedef short bf16x8 __attribute__((ext_vector_type(8)));
typedef GAS unsigned gu32;
typedef GAS unsigned long long gu64;
#define RLX_AGENT __ATOMIC_RELAXED, __HIP_MEMORY_SCOPE_AGENT
#define LDS_WAIT() asm volatile("s_waitcnt lgkmcnt(0)" ::: "memory")
#define VM_WAIT() asm volatile("s_waitcnt vmcnt(0)" ::: "memory")
__device__ __forceinline__ unsigned long long rt() { return __builtin_amdgcn_s_memrealtime(); }
__device__ __forceinline__ unsigned f2bf(float f) { unsigned u = __builtin_bit_cast(unsigned, f); return (u + 0x7fffu + ((u >> 16) & 1u)) >> 16; }
typedef float f32x2_t __attribute__((ext_vector_type(2)));
typedef __bf16 bf16x2_t __attribute__((ext_vector_type(2)));
__device__ __forceinline__ unsigned pk2(float lo, float hi) { f32x2_t v = {lo, hi}; bf16x2_t b = __builtin_convertvector(v, bf16x2_t); return __builtin_bit_cast(unsigned, b); }
#define XB_TMO      128
#define XB_XCNT(j)  (256  + 64 * (j))
#define XB_XSUB(j)  (1280 + 64 * (j))
#define XB_XGEN(j)  (2304 + 64 * (j))
#define XB_TOP      3328
#define XB_TOPGEN   3392
#define XCD_BAR_WORDS 3456
#define XB_SPIN_CAP (1u << 18)

__device__ __forceinline__ unsigned xb_ld(unsigned* p)              { return __hip_atomic_load(p, __ATOMIC_RELAXED, __HIP_MEMORY_SCOPE_AGENT); }
__device__ __forceinline__ unsigned xb_add(unsigned* p, unsigned v) { return __hip_atomic_fetch_add(p, v, __ATOMIC_RELAXED, __HIP_MEMORY_SCOPE_AGENT); }
__device__ __forceinline__ unsigned xb_xcc_id() { return (unsigned)__builtin_amdgcn_s_getreg((3 << 11) | 20) & 0xFu; }
#define XB_SPIN(cond, bar) do { unsigned _sp = 0; while (cond) { __builtin_amdgcn_s_sleep(1); \
    if ((++_sp & 255u) == 0u) { if (xb_ld(&(bar)[XB_TMO])) break; if (_sp > XB_SPIN_CAP) { atomicAdd(&(bar)[XB_TMO], 1u); break; } } } } while (0)

struct XcdBarrier {
    unsigned* bar; unsigned x;
    volatile LAS unsigned* st;
};

__device__ __forceinline__ XcdBarrier xcd_barrier_post(unsigned* bar, volatile LAS unsigned* st) {
    XcdBarrier b; b.bar = bar; b.x = xb_xcc_id(); b.st = st;
    if (threadIdx.x == 0) (void)xb_add(&bar[XB_XCNT(b.x)], 1u);
    return b;
}
__device__ __forceinline__ void xcd_barrier_complete(unsigned* bar, unsigned x, unsigned& nloc, unsigned& nx) {
    const unsigned G = gridDim.x * gridDim.y * gridDim.z;
    unsigned sum, cnt, mine, sp = 0u;
    for (;;) {
        sum = 0u; cnt = 0u; mine = 0u;
#pragma unroll
        for (unsigned j = 0; j < 16; ++j) { const unsigned c = xb_ld(&bar[XB_XCNT(j)]); sum += c; cnt += (c > 0u) ? 1u : 0u; mine = (j == x) ? c : mine; }
        if (sum == G) break;
        __builtin_amdgcn_s_sleep(1);
        if ((++sp & 255u) == 0u) { if (xb_ld(&bar[XB_TMO])) break; if (sp > XB_SPIN_CAP) { atomicAdd(&bar[XB_TMO], 1u); break; } }
    }
    nloc = mine > 0u ? mine : 1u; nx = cnt > 0u ? cnt : 1u;
}

__device__ __forceinline__ void xcd_barrier(const XcdBarrier& b) {
    asm volatile("s_waitcnt vmcnt(0)" ::: "memory");
    __syncthreads();
    if (threadIdx.x == 0) {
        unsigned* bar = b.bar;
        __builtin_amdgcn_s_waitcnt(0);
        unsigned nloc = b.st[0], nx = b.st[1];
        if (nloc == 0u) { xcd_barrier_complete(bar, b.x, nloc, nx); b.st[0] = nloc; b.st[1] = nx; }
        const unsigned old = xb_add(&bar[XB_XSUB(b.x)], 1u);
        const unsigned gen = old / nloc;
        if (old + 1u == (gen + 1u) * nloc) {
            __builtin_amdgcn_fence(__ATOMIC_RELEASE, "agent");
            asm volatile("s_waitcnt vmcnt(0)" ::: "memory");
            const unsigned og = xb_add(&bar[XB_TOP], 1u);
            const unsigned tg = og / nx;
            if (og + 1u == (tg + 1u) * nx) xb_add(&bar[XB_TOPGEN], 1u);
            else XB_SPIN(xb_ld(&bar[XB_TOPGEN]) == tg, bar);
            __builtin_amdgcn_fence(__ATOMIC_ACQUIRE, "agent");
            xb_add(&bar[XB_XGEN(b.x)], 1u);
            asm volatile("s_waitcnt vmcnt(0)" ::: "memory");
        } else {
            XB_SPIN(xb_ld(&bar[XB_XGEN(b.x)]) == gen, bar);
            __builtin_amdgcn_fence(__ATOMIC_ACQUIRE, "agent");
            asm volatile("s_waitcnt vmcnt(0)" ::: "memory");
        }
    }
    __syncthreads();
}
constexpr int NWAVES = 8;
constexpr int DM = 4096, TP = 16384, TS = 8192, TT = 24576, NLAYER = 2;
constexpr int INC = 9792, ZC = 9984;
constexpr int Z_CQ = 3072, Z_CKV = 4608, Z_KR = 5120, Z_DQ = 5376, Z_DK = 6912, Z_DV = 8448;
constexpr int QC = 2304, KVC = 3072, DFF = 16384;
constexpr float EPS = 1e-6f;
constexpr int NPH_LAYER = 10, NPHASES = 1 + NLAYER * NPH_LAYER;

constexpr size_t MiB = 1u << 20;
constexpr size_t WS_CTL = 0, CTL_ZERO_BYTES = 1 * MiB;
constexpr size_t WS_R64 = 1 * MiB, WS_R128 = 3 * MiB;
constexpr size_t WS_FILT = 7 * MiB, FILT_LAYER = 40 * MiB, FILT_S_OFF = 8 * MiB;
constexpr size_t WS_WT = 87 * MiB;
constexpr size_t WT_IN = 0, WT_OUT = 78 * MiB, WT_UP = 110 * MiB, WT_DN = 238 * MiB, WT_QB = 366 * MiB, WT_KVB = WT_QB + 7077888, WT_LAYER = WT_KVB + 3 * MiB;
constexpr size_t WS_H = WS_WT + 2 * WT_LAYER;
constexpr size_t WS_A2 = WS_H + 192 * MiB;
constexpr size_t WS_Z = WS_A2, WS_Q = WS_Z + 468 * MiB, WS_KV = WS_Q + 108 * MiB, WS_UT = WS_KV + 144 * MiB;
constexpr size_t WS_CQ = WS_A2 + 768 * MiB, WS_CKV = WS_CQ + 72 * MiB, WS_KR = WS_CKV + 24 * MiB, WS_X0T = WS_KR + 3 * MiB, WS_YT = WS_X0T + 48 * MiB, WS_DLSE = WS_YT + 48 * MiB;
constexpr size_t WS_SSQP = WS_DLSE + 2 * MiB;
constexpr size_t WS_END = WS_SSQP + 2 * MiB;
constexpr size_t WS_XB = WS_H;
constexpr size_t WS_MIX = WS_KV;
constexpr size_t WS_SSQ = 128 * 1024;
static_assert(WS_MIX + (size_t)TT * DM * 2 == WS_A2 + 768 * MiB && WS_SSQ + 4 * (size_t)TT * 4 <= CTL_ZERO_BYTES, "MIXED overlay / ssq arrays");
static_assert(WS_END <= 2048 * MiB, "workspace map fits 2 GiB");

constexpr int CW_TMO = 0, CW_BAR = 4096;
constexpr int RING_BYTES = 131072, LDSCTL_OFF = RING_BYTES, MISC_OFF = LDSCTL_OFF + 320, WSCR_OFF = RING_BYTES + 1024, PTAB_OFF = RING_BYTES + 2048, KVTAB_OFF = RING_BYTES + 4096  , LDS_BYTES = 147456;

typedef unsigned short bf16;
typedef unsigned v4u __attribute__((ext_vector_type(4)));
typedef unsigned v2u __attribute__((ext_vector_type(2)));
typedef float f32x4 __attribute__((ext_vector_type(4)));
typedef float f32x2v __attribute__((ext_vector_type(2)));
typedef float f32x16 __attribute__((ext_vector_type(16)));
typedef short bf16x8 __attribute__((ext_vector_type(8)));
typedef short s16x4 __attribute__((ext_vector_type(4)));
#define SBAR() __builtin_amdgcn_sched_barrier(0)
struct InTab { const float* const (&t)[31]; __device__ __forceinline__ const float* operator[](int k) const { return t[k]; } };

__device__ __forceinline__ float bf2f(unsigned v) { return __uint_as_float(v << 16); }
__device__ __forceinline__ float bflo(unsigned w) { return __uint_as_float(w << 16); }
__device__ __forceinline__ float bfhi(unsigned w) { return __uint_as_float(w & 0xffff0000u); }
__device__ __forceinline__ int crow_(int r, int hi) { return (r & 3) + 8 * (r >> 2) + 4 * hi; }
__device__ __forceinline__ float wave_sum(float v) {
#pragma unroll
    for (int o = 1; o < 64; o <<= 1) v += __shfl_xor(v, o);
    return v;
}
__device__ __forceinline__ void unpack8(const v4u w, float (&f)[8]) { f[0] = bflo(w.x); f[1] = bfhi(w.x); f[2] = bflo(w.y); f[3] = bfhi(w.y); f[4] = bflo(w.z); f[5] = bfhi(w.z); f[6] = bflo(w.w); f[7] = bfhi(w.w); }
__device__ __forceinline__ v4u pack8(const float (&f)[8]) { v4u w; w.x = pk2(f[0], f[1]); w.y = pk2(f[2], f[3]); w.z = pk2(f[4], f[5]); w.w = pk2(f[6], f[7]); return w; }
__device__ __forceinline__ int seq_pos(int m) { return m < TP ? (m & 2047) : (m - TP); }
__device__ __forceinline__ int seq_len(int m) { return m < TP ? 2048 : 8192; }

__device__ __forceinline__ void transpose_item(const float* W, int ldw, bf16* WT, int K, int k0, int nsrc, int ndst, int dstr  , const float* gk  , LAS float* scr, int lane) {
    float tv[32];
#pragma unroll
    for (int i = 0; i < 32; ++i) tv[i] = W[(size_t)(k0 + 2 * i + (lane >> 5)) * ldw + nsrc + (lane & 31)];
    if (gk) {
#pragma unroll
        for (int i = 0; i < 32; ++i) tv[i] *= gk[k0 + 2 * i + (lane >> 5)]; }
#pragma unroll
    for (int i = 0; i < 32; ++i) scr[(2 * i + (lane >> 5)) * 33 + (lane & 31)] = tv[i];
    LDS_WAIT(); asm volatile("" ::: "memory");
    const int c = lane & 7;
#pragma unroll
    for (int j = 0; j < 4; ++j) { const int n = (lane >> 3) + 8 * j; const LAS float* s = scr + (8 * c) * 33 + n;
        v4u o; o.x = pk2(s[0 * 33], s[1 * 33]); o.y = pk2(s[2 * 33], s[3 * 33]); o.z = pk2(s[4 * 33], s[5 * 33]); o.w = pk2(s[6 * 33], s[7 * 33]);
        *(GAS v4u*)(WT + (size_t)(ndst + n * dstr) * K + k0 + 8 * c) = o; }
    LDS_WAIT(); asm volatile("" ::: "memory");
}
constexpr int I_IN = 64 * 306, I_OUT = 64 * 128, I_UP = 64 * 512, I_DN = 256 * 128, I_QB = 24 * 72, I_KVB = 8 * 96, I_LAYER = I_IN + I_OUT + I_UP + I_DN + I_QB + I_KVB;
__device__ __forceinline__ void p0_weights(const InTab in, unsigned char* ws, LAS float* scr, int gw, int NGW, int lane) {
    for (int it = gw; it < NLAYER * I_LAYER; it += NGW) {
        const int l = it / I_LAYER; int r = it % I_LAYER; unsigned char* wl = ws + WS_WT + (size_t)l * WT_LAYER;
        if (r < I_IN) { const int kb = r / 306, nb = r % 306, n0 = 32 * nb; int nd = n0, ds = 1;
            if (n0 >= 8256) nd = n0 + 192;
            else if (n0 >= 5184) { const int nl = n0 - 5184, d0 = nl & 127; nd = Z_DQ + (nl & ~127) + (d0 < 64 ? 2 * d0 : 2 * (d0 - 64) + 1); ds = 2; }
            transpose_item(in[3] + (size_t)l * DM * INC, INC, (bf16*)(wl + WT_IN), DM, 64 * kb, n0, nd, ds, in[2] + l * DM, scr, lane); continue; } r -= I_IN;
        if (r < I_OUT) { const int kb = r / 128, nb = r % 128; transpose_item(in[27] + (size_t)l * DM * DM, DM, (bf16*)(wl + WT_OUT), DM, 64 * kb, 32 * nb, 32 * nb, 1, nullptr, scr, lane); continue; } r -= I_OUT;
        if (r < I_UP) { const int kb = r / 512, nb = r % 512; transpose_item(in[29] + (size_t)l * DM * DFF, DFF, (bf16*)(wl + WT_UP), DM, 64 * kb, 32 * nb, 32 * nb, 1, in[28] + l * DM, scr, lane); continue; } r -= I_UP;
        if (r < I_DN) { const int kb = r / 128, nb = r % 128; transpose_item(in[30] + (size_t)l * DFF * DM, DM, (bf16*)(wl + WT_DN), DFF, 64 * kb, 32 * nb, 32 * nb, 1, nullptr, scr, lane); continue; } r -= I_DN;
        if (r < I_QB) { const int kb = r / 72, nb = r % 72, n0 = 32 * nb, h = n0 / 192, j = n0 % 192;
            transpose_item(in[17] + (size_t)l * 1536 * QC, QC, (bf16*)(wl + WT_QB), 1536, 64 * kb, n0, j < 128 ? h * 128 + j : 1536 + h * 64 + (j - 128), 1, nullptr, scr, lane); continue; } r -= I_QB;
        { const int kb = r / 96, nb = r % 96; transpose_item(in[19] + (size_t)l * 512 * KVC, KVC, (bf16*)(wl + WT_KVB), 512, 64 * kb, 32 * nb, 32 * nb, 1, nullptr, scr, lane); }
    }
}
__device__ __forceinline__ void p0_misc(unsigned char* ws, int gt, int NGT) {
    for (int i = gt; i < NLAYER * 98304; i += NGT) { const int l = i / 98304, r = i % 98304; *(GAS v4u*)(ws + WS_WT + (size_t)l * WT_LAYER + WT_IN + (size_t)5184 * DM * 2 + (size_t)r * 16) = (v4u){0u, 0u, 0u, 0u}; }
    for (int i = gt; i < 8192 * 96; i += NGT) { const int pos = i / 96, j = i % 96; float sv, cv;
        if (j < 32) { const float inv = 1.0f / powf(10000.0f, (float)(2 * j) / 64.0f); sincosf((float)pos * inv, &sv, &cv); ((GAS f32x2v*)(ws + WS_R64))[pos * 32 + j] = (f32x2v){cv, sv}; }
        else { const int jj = j - 32; const float inv = 1.0f / powf(10000.0f, (float)(2 * jj) / 128.0f); sincosf((float)pos * inv, &sv, &cv); ((GAS f32x2v*)(ws + WS_R128))[pos * 64 + jj] = (f32x2v){cv, sv}; } }
}
constexpr int FI_W1 = 0, FI_W2 = 33 * 64 * 4, FI_W3 = FI_W2 + 16384, FI_B = FI_W3 + 16384  , FI_H0 = FI_B + 1024, FI_H1 = FI_H0 + 16384, FI_H3 = FI_H1 + 16384;
__device__ __forceinline__ void filter_item(const InTab in, unsigned char* ws, int layer, int trunk, int pblk, LAS unsigned char* lds, int tid, int lane, int wave) {
    const int L = trunk ? 8192 : 2048, p0 = pblk * 64, p = p0 + lane;
    bf16* Rg = (bf16*)(ws + WS_FILT + (size_t)layer * FILT_LAYER + (trunk ? FILT_S_OFF : 0));
    const float* w4 = in[12] + (size_t)layer * 64 * 2048; const float* b4 = in[13] + layer * 2048;
    __syncthreads();
    { const float* w1 = in[6] + layer * 33 * 64; const float* w2 = in[8] + layer * 4096; const float* w3 = in[10] + layer * 4096;
      for (int i = tid; i < 33 * 64; i += 512) ((LAS float*)(lds + FI_W1))[i] = w1[i];
      for (int i = tid; i < 4096; i += 512) { ((LAS float*)(lds + FI_W2))[i] = w2[i]; ((LAS float*)(lds + FI_W3))[i] = w3[i]; }
      if (tid < 64) { ((LAS float*)(lds + FI_B))[tid] = in[7][layer * 64 + tid]; ((LAS float*)(lds + FI_B))[64 + tid] = in[9][layer * 64 + tid];
                      ((LAS float*)(lds + FI_B))[128 + tid] = in[11][layer * 64 + tid]; ((LAS float*)(lds + FI_B))[192 + tid] = in[14][layer * 64 + tid]; } }
    const float tp = (float)p / (float)(L - 1), wang = 6.283185307179586f * (float)p / (float)L;
    if (wave == 0) ((LAS float*)(lds + FI_H1))[lane] = tp;
#pragma unroll 1
    for (int jj = 0; jj < 2; ++jj) { const int j = 2 * wave + jj; const float f = 1e-4f + (float)j * ((15.0f - 1e-4f) / 15.0f); float sv, cv; sincosf(f * wang, &sv, &cv);
        ((LAS float*)(lds + FI_H1))[(1 + j) * 64 + lane] = cv; ((LAS float*)(lds + FI_H1))[(17 + j) * 64 + lane] = -sv; }
    __syncthreads();
    const LAS float* Bv = (const LAS float*)(lds + FI_B);
    float hv[64];
#pragma unroll
    for (int k = 0; k < 33; ++k) hv[k] = ((const LAS float*)(lds + FI_H1))[k * 64 + lane];
#pragma unroll 1
    for (int u = 0; u < 8; ++u) { const int k = 8 * wave + u; const LAS float* wc = (const LAS float*)(lds + FI_W1) + k; float a = Bv[k];
#pragma unroll
        for (int j = 0; j < 33; ++j) a += hv[j] * wc[j * 64];
        ((LAS float*)(lds + FI_H0))[k * 64 + lane] = sinf(Bv[192 + k] * a); }
    __syncthreads();
#pragma unroll
    for (int k = 0; k < 64; ++k) hv[k] = ((const LAS float*)(lds + FI_H0))[k * 64 + lane];
#pragma unroll 1
    for (int u = 0; u < 8; ++u) { const int k = 8 * wave + u; const LAS float* wc = (const LAS float*)(lds + FI_W2) + k; float a = Bv[64 + k];
#pragma unroll
        for (int j = 0; j < 64; ++j) a += hv[j] * wc[j * 64];
        ((LAS float*)(lds + FI_H1))[k * 64 + lane] = sinf(Bv[192 + k] * a); }
    __syncthreads();
#pragma unroll
    for (int k = 0; k < 64; ++k) hv[k] = ((const LAS float*)(lds + FI_H1))[k * 64 + lane];
#pragma unroll 1
    for (int u = 0; u < 8; ++u) { const int k = 8 * wave + u; const LAS float* wc = (const LAS float*)(lds + FI_W3) + k; float a = Bv[128 + k];
#pragma unroll
        for (int j = 0; j < 64; ++j) a += hv[j] * wc[j * 64];
        ((LAS bf16*)(lds + FI_H3))[lane * 72 + k] = (bf16)f2bf(sinf(Bv[192 + k] * a)); }
    __syncthreads();
    const int r32 = lane & 31, hi = lane >> 5;
    float tq[2]; int pq[2];
#pragma unroll
    for (int pb = 0; pb < 2; ++pb) { pq[pb] = p0 + pb * 32 + r32; tq[pb] = -1.4426950408889634f * (float)pq[pb] / (float)(L - 1); }
#pragma unroll 1
    for (int cbk = 0; cbk < 8; ++cbk) {
        const int c0 = 256 * wave + 32 * cbk;
        f32x16 acc[2];
#pragma unroll
        for (int pb = 0; pb < 2; ++pb) acc[pb] = (f32x16){0.f, 0.f, 0.f, 0.f, 0.f, 0.f, 0.f, 0.f, 0.f, 0.f, 0.f, 0.f, 0.f, 0.f, 0.f, 0.f};
#pragma unroll 1
        for (int ks = 0; ks < 4; ++ks) {
            const float* wk = w4 + (size_t)(ks * 16 + hi * 8) * 2048 + c0 + r32; float wv[8];
#pragma unroll
            for (int j = 0; j < 8; ++j) wv[j] = wk[j * 2048];
            const bf16x8 b0 = *(const LAS bf16x8*)(lds + FI_H3 + r32 * 144 + (ks * 16 + hi * 8) * 2), b1 = *(const LAS bf16x8*)(lds + FI_H3 + (32 + r32) * 144 + (ks * 16 + hi * 8) * 2);
            v4u aw; aw.x = pk2(wv[0], wv[1]); aw.y = pk2(wv[2], wv[3]); aw.z = pk2(wv[4], wv[5]); aw.w = pk2(wv[6], wv[7]);
            const bf16x8 af = __builtin_bit_cast(bf16x8, aw);
            acc[0] = __builtin_amdgcn_mfma_f32_32x32x16_bf16(af, b0, acc[0], 0, 0, 0); acc[1] = __builtin_amdgcn_mfma_f32_32x32x16_bf16(af, b1, acc[1], 0, 0, 0);
        }
        const bool fwd = wave < 4;
        unsigned nidx[2]; bool zr[2];
#pragma unroll
        for (int pb = 0; pb < 2; ++pb) { zr[pb] = !fwd && pq[pb] == 0; nidx[pb] = fwd ? (unsigned)(L - pq[pb]) : (zr[pb] ? 0u : (unsigned)(L + pq[pb])); }
#pragma unroll
        for (int r = 0; r < 16; ++r) { const unsigned col = (unsigned)(c0 + crow_(r, hi)), ch = col & 1023u;
            const float delta = fabsf(-3.0701134573253944f + (float)ch * ((-15.350567286626972f + 3.0701134573253944f) / 1023.0f)), bb = b4[col];
#pragma unroll
            for (int pb = 0; pb < 2; ++pb) { const float v = (acc[pb][r] + bb) * __builtin_amdgcn_exp2f(tq[pb] * delta);
                Rg[ch * (unsigned)(2 * L) + nidx[pb]] = zr[pb] ? (bf16)0 : (bf16)f2bf(v); }
            if ((r & 3) == 3) asm volatile("" ::: "memory"); }
    }
    __syncthreads();
}
__device__ __forceinline__ void cvt_rows(const float* x0, const float* x1, bf16* XB, float* ssq, int gw, int NGW, int lane) {
    for (int m = gw; m < TT; m += NGW) {
        const GAS f32x4* xr = (const GAS f32x4*)((m < TP ? x0 : x1) + (size_t)m * DM) + lane;
        f32x4 v[16]; float s = 0.f;
#pragma unroll
        for (int j = 0; j < 16; ++j) { v[j] = xr[64 * j]; s += (v[j].x * v[j].x + v[j].y * v[j].y) + (v[j].z * v[j].z + v[j].w * v[j].w); }
        s = wave_sum(s); if (lane == 0) ssq[m] = 1.0f / sqrtf(s * (1.0f / DM) + EPS);
        GAS v2u* o8 = (GAS v2u*)(XB + (size_t)m * DM) + lane;
#pragma unroll
        for (int j = 0; j < 16; ++j) { v2u w; w.x = pk2(v[j].x, v[j].y); w.y = pk2(v[j].z, v[j].w); o8[64 * j] = w; }
    }
}

__device__ __forceinline__ void rstd_rows(const float* ssqp, float* rstd, int gt, int NGT) {
    for (int m = gt; m < TT; m += NGT) { const GAS f32x4* p = (const GAS f32x4*)(ssqp + (size_t)m * 16); const f32x4 a = p[0], b = p[1], c = p[2], d = p[3];
        const float s = (((a.x + a.y) + (a.z + a.w)) + ((b.x + b.y) + (b.z + b.w))) + (((c.x + c.y) + (c.z + c.w)) + ((d.x + d.y) + (d.z + d.w)));
        rstd[m] = 1.0f / sqrtf(s * (1.0f / DM) + EPS); }
}
__device__ __forceinline__ void prep_hyena(const bf16* Z, const float* cw, const float* cb, bf16* UT, bf16* X0T, LAS unsigned char* lds, int tid, int bid, int G) {
    for (int tile = bid; tile < 384 * 8; tile += G) {
        const int tb = tile >> 3, cbk = tile & 7, row = tid >> 3, c8 = (tid & 7) * 8, m = tb * 64 + row;
        const int pos = seq_pos(m), L = seq_len(m); const bool hasm = pos > 0, hasp = pos < L - 1;
        v4u zw[2][3][3];
#pragma unroll
        for (int hc = 0; hc < 2; ++hc)
#pragma unroll
            for (int gI = 0; gI < 3; ++gI) { const bf16* zp = Z + (size_t)m * ZC + gI * 1024 + cbk * 128 + hc * 64 + c8;
                zw[hc][gI][1] = *(const GAS v4u*)zp; zw[hc][gI][0] = hasm ? *(const GAS v4u*)(zp - ZC) : (v4u){0u, 0u, 0u, 0u}; zw[hc][gI][2] = hasp ? *(const GAS v4u*)(zp + ZC) : (v4u){0u, 0u, 0u, 0u}; }
        __syncthreads();
#pragma unroll
        for (int hc = 0; hc < 2; ++hc) {
            const int c0 = cbk * 128 + hc * 64 + c8; float xc[3][8];
#pragma unroll
            for (int gI = 0; gI < 3; ++gI) { float a[8], b[8], c[8]; unpack8(zw[hc][gI][0], a); unpack8(zw[hc][gI][1], b); unpack8(zw[hc][gI][2], c); const float* wp = cw + gI * 1024 + c0;
#pragma unroll
                for (int e = 0; e < 8; ++e) xc[gI][e] = a[e] * wp[e] + b[e] * wp[3072 + e] + c[e] * wp[6144 + e] + cb[gI * 1024 + c0 + e]; }
            LAS bf16* TU = (LAS bf16*)(lds + hc * (2 * 64 * 132)); LAS bf16* TX = TU + 64 * 66;
#pragma unroll
            for (int e = 0; e < 8; ++e) { TU[(c8 + e) * 66 + row] = (bf16)f2bf(xc[1][e] * xc[2][e]); TX[(c8 + e) * 66 + row] = (bf16)f2bf(xc[0][e]); }
        }
        __syncthreads();
#pragma unroll
        for (int hc = 0; hc < 2; ++hc) { const int c = tid >> 3, t8 = (tid & 7) * 8; const LAS bf16* TU = (const LAS bf16*)(lds + hc * (2 * 64 * 132)); const LAS bf16* TX = TU + 64 * 66;
            const LAS unsigned* su = (const LAS unsigned*)(TU + c * 66 + t8); const LAS unsigned* sx = (const LAS unsigned*)(TX + c * 66 + t8);
            const v4u wu = {su[0], su[1], su[2], su[3]}, wx = {sx[0], sx[1], sx[2], sx[3]};
            const size_t o = (size_t)(cbk * 128 + hc * 64 + c) * TT + tb * 64 + t8; *(GAS v4u*)(UT + o) = wu; *(GAS v4u*)(X0T + o) = wx; }
    }
}
__device__ __forceinline__ void prep_tokens(const bf16* Z, const InTab in, int l, unsigned char* ws, int gw, int NGW, int lane) {
    bf16* CQ = (bf16*)(ws + WS_CQ); bf16* CKV = (bf16*)(ws + WS_CKV); bf16* KR = (bf16*)(ws + WS_KR);
    const GAS f32x2v* R64 = (const GAS f32x2v*)(ws + WS_R64); const GAS f32x2v* R128 = (const GAS f32x2v*)(ws + WS_R128);
    const float* gq = in[16] + l * 1536; const float* gkv = in[18] + l * 512; const float* gkr = in[23] + l * 64; const float* gdq = in[24] + l * 128; const float* gdk = in[25] + l * 128;
    for (int m = gw; m < TT; m += NGW) {
        const int pos = seq_pos(m); const bf16* zr = Z + (size_t)m * ZC;
        v4u cqw[3], ckw;
#pragma unroll
        for (int j = 0; j < 3; ++j) cqw[j] = *(const GAS v4u*)(zr + Z_CQ + lane * 8 + 512 * j);
        ckw = *(const GAS v4u*)(zr + Z_CKV + lane * 8); const unsigned krw = zr[Z_KR + lane];
        {
            float x[3][8]; float s = 0.f;
#pragma unroll
            for (int j = 0; j < 3; ++j) { unpack8(cqw[j], x[j]);
#pragma unroll
                for (int e = 0; e < 8; ++e) s += x[j][e] * x[j][e]; }
            const float rs = 1.0f / sqrtf(wave_sum(s) * (1.0f / 1536.0f) + EPS);
#pragma unroll
            for (int j = 0; j < 3; ++j) { const int c = lane * 8 + 512 * j; float y[8];
#pragma unroll
                for (int e = 0; e < 8; ++e) y[e] = x[j][e] * rs * gq[c + e];
                *(GAS v4u*)(CQ + (size_t)m * 1536 + c) = pack8(y); }
        }
        {
            float x[8], y[8]; float s = 0.f; unpack8(ckw, x);
#pragma unroll
            for (int e = 0; e < 8; ++e) s += x[e] * x[e];
            const float rs = 1.0f / sqrtf(wave_sum(s) * (1.0f / 512.0f) + EPS);
#pragma unroll
            for (int e = 0; e < 8; ++e) y[e] = x[e] * rs * gkv[lane * 8 + e];
            *(GAS v4u*)(CKV + (size_t)m * 512 + lane * 8) = pack8(y);
        }
        {
            const float x = bf2f(krw); const float rs = 1.0f / sqrtf(wave_sum(x * x) * (1.0f / 64.0f) + EPS);
            const float y = x * rs * gkr[lane], pr = __shfl_xor(y, 32); const f32x2v cs = R64[pos * 32 + (lane & 31)];
            KR[(size_t)m * 64 + lane] = (bf16)f2bf(lane < 32 ? y * cs.x - pr * cs.y : y * cs.x + pr * cs.y);
        }
    }
}
constexpr int CV_BS = 144;
template <int TRUNK>
__device__ __forceinline__ void conv_unit(int c, const bf16* Rg, const bf16* UT, const bf16* X0T, bf16* YT, float skip, LAS unsigned char* lds, int tid, int lane, int wave,
                                          v4u (&upre)[4], bool pre_valid, const bf16* next_urow, int next_np) {
    constexpr int L = TRUNK ? 8192 : 2048, NB = L / 64, NBAT = TRUNK ? 1 : 8, PADB = TRUNK ? 32 : 8, NBLK = NB + 2 * PADB, UBS = NBLK * CV_BS + (TRUNK ? 0 : 128);
    constexpr int NR = 2  , ENR = TRUNK ? 1 : 2  , TOK0 = TRUNK ? TP : 0, DC0 = TRUNK ? -128 : -32, DC1 = TRUNK ? 128 : 32;
    constexpr int ND = TRUNK ? 32 : 8, NPC = (64 * ND + 64) / 8  , NPR = NPC + 1  , CV_CS = NPC * 16 + 16, CV_RAW = TRUNK ? 28672 : 57344, CV_RSZ = (NPR * 16 + 255) & ~255, CV_FC = CV_RAW + 2 * CV_RSZ;
    static_assert(NBAT * UBS <= CV_RAW && CV_FC + 16 * CV_CS <= RING_BYTES && (CV_CS / 16) % 16 == 9 && NPR <= 512 && DC0 == -4 * ND && DC1 == 4 * ND, "conv LDS map");
    const bf16* urow = UT + (size_t)c * TT + TOK0;
    __syncthreads();
    for (int i = tid; i < NBAT * 2 * PADB * 8; i += 512) { const int b = i / (2 * PADB * 8), r = i % (2 * PADB * 8), pb = r >> 3, o8 = r & 7, blk = pb < PADB ? pb : pb + NB;
        *(LAS v4u*)(lds + b * UBS + blk * CV_BS + o8 * 16) = (v4u){0u, 0u, 0u, 0u}; }
    static_assert(NBAT * L / 8 % 512 == 0 && NBAT * L / 8 / 512 <= 4, "u pieces per thread");
#pragma unroll
    for (int k = 0; k < NBAT * L / 8 / 512; ++k) { const int ci = tid + 512 * k, b = ci / (L / 8), r = ci % (L / 8), blk = r >> 3, o8 = r & 7;
        const v4u uv = pre_valid ? upre[k] : *(const GAS v4u*)(urow + (size_t)ci * 8);
        *(LAS v4u*)(lds + b * UBS + (blk + PADB) * CV_BS + o8 * 16) = uv; }
    if (next_urow) {
#pragma unroll
        for (int k = 0; k < 4; ++k) if (k < next_np) upre[k] = *(const GAS v4u*)(next_urow + (size_t)(tid + 512 * k) * 8); }
    const int n = lane & 31, h = lane >> 5;
    int batch, t1, dlo, dhi, R0;
    const int g = wave & 3;
    if (TRUNK == 0) { const int bh = wave >> 2; batch = 4 * bh + (n >> 3); t1 = 8 * g + (n & 7); dlo = 8 * g - 31; dhi = 8 * g + 7; R0 = 0; }
    else { batch = 0; t1 = 32 * g + n; dlo = 32 * g - 127; dhi = 32 * g + 31; R0 = wave >> 2; }
    const int sl = (8 - (n & 7)) & 7;
    const int abase0 = CV_FC + sl * CV_CS + 2 * (64 * ND - n + 8 * h - sl);
    const int bbase0 = batch * UBS + (t1 + PADB) * CV_BS + 16 * h;
    f32x16 acc[NR];
#pragma unroll
    for (int r = 0; r < NR; ++r) acc[r] = (f32x16){0.f, 0.f, 0.f, 0.f, 0.f, 0.f, 0.f, 0.f, 0.f, 0.f, 0.f, 0.f, 0.f, 0.f, 0.f, 0.f};
    v2u xg[ENR][4];
    { const size_t tokb_ = (size_t)c * TT + TOK0 + batch * 2048 + 64 * t1;
#pragma unroll
      for (int r = 0; r < ENR; ++r)
#pragma unroll
          for (int kq = 0; kq < 4; ++kq) xg[r][kq] = *(const GAS v2u*)(X0T + tokb_ + 32 * (R0 + r) + 8 * kq + 4 * h); }
    v4u rawv[2] = {{0u, 0u, 0u, 0u}, {0u, 0u, 0u, 0u}};
#pragma unroll
    for (int k = 0; k < 2; ++k) { const int ch = k == 0 ? 0 : 5, nn = L - 64 * (DC0 + ND * ch + ND) + 8 * tid; if (tid < NPR && nn + 8 <= 2 * L) rawv[k] = *(const GAS v4u*)(Rg + nn); }
#pragma unroll 1
    for (int j = 0; j < 5; ++j) {
        if (j < 4) {
            __syncthreads();
            if (tid < NPR) { *(LAS v4u*)(lds + CV_RAW + 16 * tid) = rawv[0]; *(LAS v4u*)(lds + CV_RAW + CV_RSZ + 16 * tid) = rawv[1]; }
#pragma unroll
            for (int k = 0; k < 2; ++k) { const int ch = k == 0 ? j + 1 : (j + 1 < 3 ? 6 + j : 4), nn = L - 64 * (DC0 + ND * ch + ND) + 8 * tid; rawv[k] = (v4u){0u, 0u, 0u, 0u};
                if (j + 1 < 4 && tid < NPR && nn + 8 <= 2 * L) rawv[k] = *(const GAS v4u*)(Rg + nn); }
            __syncthreads();
#define CV_D(k) ((k) == 0 ? lo.x : (k) == 1 ? lo.y : (k) == 2 ? lo.z : (k) == 3 ? lo.w : (k) == 4 ? hi.x : (k) == 5 ? hi.y : (k) == 6 ? hi.z : hi.w)
#define CV_EMIT(s) do { v4u w; if ((s) & 1) { w.x = __builtin_amdgcn_alignbyte(CV_D((s) / 2 + 1), CV_D((s) / 2), 2); w.y = __builtin_amdgcn_alignbyte(CV_D((s) / 2 + 2), CV_D((s) / 2 + 1), 2); \
            w.z = __builtin_amdgcn_alignbyte(CV_D((s) / 2 + 3), CV_D((s) / 2 + 2), 2); w.w = __builtin_amdgcn_alignbyte(CV_D((s) / 2 + 4), CV_D((s) / 2 + 3), 2); } \
        else { w.x = CV_D((s) / 2); w.y = CV_D((s) / 2 + 1); w.z = CV_D((s) / 2 + 2); w.w = CV_D((s) / 2 + 3); } *(LAS v4u*)(dst + (s) * CV_CS) = w; } while (0)
            for (int idx = tid; idx < 4 * NPC; idx += 512) { const int q = idx / NPC, i = idx - q * NPC, win = q >> 1, hh = q & 1;
                const LAS unsigned char* rp = lds + CV_RAW + win * CV_RSZ + 16 * i; const v4u lo = *(const LAS v4u*)rp, hi = *(const LAS v4u*)(rp + 16); LAS unsigned char* dst = lds + CV_FC + win * (8 * CV_CS) + 16 * i;
                if (hh == 0) { CV_EMIT(0); CV_EMIT(1); CV_EMIT(2); CV_EMIT(3); } else { CV_EMIT(4); CV_EMIT(5); CV_EMIT(6); CV_EMIT(7); } }
#undef CV_EMIT
#undef CV_D
            __syncthreads();
        }
        const bool lower = j < 3 ? (g <= j) : (j == 3 ? g < 2 : g >= 2);
        const int ch = lower ? (j < 4 ? j : 3) : (j < 3 ? 5 + j : 4), dc = DC0 + ND * ch, abw = abase0 + (lower ? 0 : 8 * CV_CS);
        constexpr int DSTEP = TRUNK ? 2 : 1;
        int ddlo = dlo - dc > 0 ? dlo - dc : 0; const int ddhi = dhi - dc < ND - 1 ? dhi - dc : ND - 1;
        if (TRUNK) ddlo += ((dc + ddlo) ^ R0) & 1;
        if (ddlo <= ddhi) {
            bf16x8 fb[4], fa[4][NR];
            { const int ab = abw - 128 * ddlo, bb = bbase0 - (dc + ddlo) * CV_BS;
#pragma unroll
              for (int kb = 0; kb < 4; ++kb) { fb[kb] = *(const LAS bf16x8*)(lds + bb + 32 * kb);
#pragma unroll
                  for (int r = 0; r < NR; ++r) fa[kb][r] = *(const LAS bf16x8*)(lds + ab - 64 * r + 32 * kb); } }
#pragma unroll 2
            for (int dd = ddlo; dd <= ddhi; dd += DSTEP) {
                const int dn = dd + DSTEP <= ddhi ? dd + DSTEP : dd; const int ab = abw - 128 * dn, bb = bbase0 - (dc + dn) * CV_BS;
                bf16x8 nb[4], na[4][NR];
#pragma unroll
                for (int kb = 0; kb < 4; ++kb) { nb[kb] = *(const LAS bf16x8*)(lds + bb + 32 * kb);
#pragma unroll
                    for (int r = 0; r < NR; ++r) na[kb][r] = *(const LAS bf16x8*)(lds + ab - 64 * r + 32 * kb); }
#pragma unroll
                for (int kb = 0; kb < 4; ++kb)
#pragma unroll
                    for (int r = 0; r < NR; ++r) acc[r] = __builtin_amdgcn_mfma_f32_32x32x16_bf16(fa[kb][r], fb[kb], acc[r], 0, 0, 0);
#pragma unroll
                for (int kb = 0; kb < 4; ++kb) { fb[kb] = nb[kb];
#pragma unroll
                    for (int r = 0; r < NR; ++r) fa[kb][r] = na[kb][r]; }
            }
        }
    }
    if (TRUNK) {
        __syncthreads();
        LAS f32x4* xb = (LAS f32x4*)(lds + CV_FC);
#pragma unroll
        for (int q = 0; q < 4; ++q) { f32x4 v;
#pragma unroll
            for (int e = 0; e < 4; ++e) v[e] = R0 ? acc[0][4 * q + e] : acc[1][4 * q + e];
            xb[wave * 256 + q * 64 + lane] = v; }
        __syncthreads();
#pragma unroll
        for (int q = 0; q < 4; ++q) { const f32x4 v = xb[(wave ^ 4) * 256 + q * 64 + lane];
#pragma unroll
            for (int e = 0; e < 4; ++e) acc[0][4 * q + e] = (R0 ? acc[1][4 * q + e] : acc[0][4 * q + e]) + v[e]; }
    }
    const size_t tokb = (size_t)c * TT + TOK0 + batch * 2048 + 64 * t1;
#pragma unroll
    for (int r = 0; r < ENR; ++r)
#pragma unroll
        for (int kq = 0; kq < 4; ++kq) { const int t0 = 32 * (R0 + r) + 8 * kq + 4 * h;
            const v2u uu = *(const LAS v2u*)(lds + batch * UBS + (t1 + PADB) * CV_BS + 2 * t0); const v2u xx = xg[r][kq];
            const float y0 = bflo(xx.x) * (acc[r][4 * kq + 0] + bflo(uu.x) * skip), y1 = bfhi(xx.x) * (acc[r][4 * kq + 1] + bfhi(uu.x) * skip);
            const float y2 = bflo(xx.y) * (acc[r][4 * kq + 2] + bflo(uu.y) * skip), y3 = bfhi(xx.y) * (acc[r][4 * kq + 3] + bfhi(uu.y) * skip);
            v2u o; o.x = pk2(y0, y1); o.y = pk2(y2, y3); *(GAS v2u*)(YT + tokb + t0) = o; }
}
__device__ __forceinline__ int crow(int r, int hi) { return (r & 3) + 8 * (r >> 2) + 4 * hi; }
__device__ __forceinline__ unsigned cvtpk(float lo, float hi) { unsigned r; asm volatile("v_cvt_pk_bf16_f32 %0, %1, %2" : "=v"(r) : "v"(lo), "v"(hi)); return r; }
__device__ __forceinline__ void glds16(const void* g, LAS unsigned char* l) { __builtin_amdgcn_global_load_lds((const unsigned*)g, (LAS unsigned*)l, 16, 0, 0); }
__device__ __forceinline__ int v_st(int k, int c) { const int kk = (k & ~0xC) | ((k & 4) << 1) | ((k & 8) >> 1); return ((kk >> 3) * 4 + (c >> 5)) * 512 + ((kk & 7) * 32 + (c & 31)) * 2; }
__device__ __forceinline__ int v_rd_base(int lane) { return ((lane & 3) << 3) | (((lane >> 2) & 3) << 6) | (((lane >> 4) & 1) << 5) | (((lane >> 5) & 1) << 8); }
constexpr int v_rd_off(int d0, int ks, int half) { return d0 * 512 + ks * 4096 + half * 2048; }
__device__ __forceinline__ void v_inv(int P, int& k, int& c) { const int sub = P >> 9, w = (P & 511) >> 1, kk = ((sub >> 2) << 3) | (w >> 5); c = ((sub & 3) << 5) | (w & 31); k = (kk & ~0xC) | ((kk & 4) << 1) | ((kk & 8) >> 1); }
template <int OFF> __device__ __forceinline__ s16x4 tr_read(int vb) { s16x4 r; asm volatile("ds_read_b64_tr_b16 %0, %1 offset:%2" : "=&v"(r) : "v"(vb), "i"(OFF) : "memory"); return r; }
template <int D0> __device__ __forceinline__ void pv_one(f32x16& od, int vb, bf16x8 pa0, bf16x8 pa1, bf16x8 pa2, bf16x8 pa3) {
    const s16x4 l0 = tr_read<v_rd_off(D0, 0, 0)>(vb), h0 = tr_read<v_rd_off(D0, 0, 1)>(vb), l1 = tr_read<v_rd_off(D0, 1, 0)>(vb), h1 = tr_read<v_rd_off(D0, 1, 1)>(vb);
    const s16x4 l2 = tr_read<v_rd_off(D0, 2, 0)>(vb), h2 = tr_read<v_rd_off(D0, 2, 1)>(vb), l3 = tr_read<v_rd_off(D0, 3, 0)>(vb), h3 = tr_read<v_rd_off(D0, 3, 1)>(vb);
    asm volatile("s_waitcnt lgkmcnt(0)" ::: "memory"); SBAR();
#define PKV(Lx, Hx) (bf16x8){Lx[0], Lx[1], Lx[2], Lx[3], Hx[0], Hx[1], Hx[2], Hx[3]}
    od = __builtin_amdgcn_mfma_f32_32x32x16_bf16(pa0, PKV(l0, h0), od, 0, 0, 0);
    od = __builtin_amdgcn_mfma_f32_32x32x16_bf16(pa1, PKV(l1, h1), od, 0, 0, 0);
    od = __builtin_amdgcn_mfma_f32_32x32x16_bf16(pa2, PKV(l2, h2), od, 0, 0, 0);
    od = __builtin_amdgcn_mfma_f32_32x32x16_bf16(pa3, PKV(l3, h3), od, 0, 0, 0);
#undef PKV
}
__device__ __forceinline__ void softmax_p(f32x16& p0, f32x16& p1, float& m_reg, float& l_reg, f32x16 (&o)[4], bf16x8& pa0, bf16x8& pa1, bf16x8& pa2, bf16x8& pa3, LAS float* al, float C, int r32, int hi) {
    float pmax = p0[0];
#pragma unroll
    for (int r = 1; r < 16; ++r) pmax = fmaxf(pmax, p0[r]);
#pragma unroll
    for (int r = 0; r < 16; ++r) pmax = fmaxf(pmax, p1[r]);
    { auto rr = __builtin_amdgcn_permlane32_swap(__float_as_uint(pmax), __float_as_uint(pmax), false, false); pmax = fmaxf(__uint_as_float(rr[0]), __uint_as_float(rr[1])); }
    float mn = m_reg, alpha = 1.f; const bool resc = !__all((pmax - m_reg) * C <= 8.0f * 1.4426950408889634f);
    if (resc) { mn = fmaxf(m_reg, pmax); alpha = __builtin_amdgcn_exp2f((m_reg - mn) * C); m_reg = mn; }
    const float mnC = -mn * C;
    float ps = 0.f;
#pragma unroll
    for (int r = 0; r < 16; ++r) { p0[r] = __builtin_amdgcn_exp2f(fmaf(p0[r], C, mnC)); ps += p0[r]; }
#pragma unroll
    for (int r = 0; r < 16; ++r) { p1[r] = __builtin_amdgcn_exp2f(fmaf(p1[r], C, mnC)); ps += p1[r]; }
    { auto rr = __builtin_amdgcn_permlane32_swap(__float_as_uint(ps), __float_as_uint(ps), false, false); ps = __uint_as_float(rr[0]) + __uint_as_float(rr[1]); }
    l_reg = l_reg * alpha + ps;
    if (resc) { if (hi == 0) al[r32] = alpha; asm volatile("s_waitcnt lgkmcnt(0)" ::: "memory");
#pragma unroll
        for (int d = 0; d < 4; ++d)
#pragma unroll
            for (int r = 0; r < 16; ++r) o[d][r] *= al[crow(r, hi)];
    }
#define PK4(P, BASE, OUT) do { unsigned a0 = cvtpk(P[BASE + 0], P[BASE + 1]), a1 = cvtpk(P[BASE + 2], P[BASE + 3]);   \
    unsigned b0 = cvtpk(P[BASE + 4], P[BASE + 5]), b1 = cvtpk(P[BASE + 6], P[BASE + 7]);                              \
    auto r0 = __builtin_amdgcn_permlane32_swap(a0, b0, false, false); auto r1 = __builtin_amdgcn_permlane32_swap(a1, b1, false, false); \
    v4u w = {r0[0], r1[0], r0[1], r1[1]}; OUT = __builtin_bit_cast(bf16x8, w); } while (0)
    PK4(p0, 0, pa0); PK4(p0, 8, pa1); PK4(p1, 0, pa2); PK4(p1, 8, pa3);
#undef PK4
}
struct VF8 { s16x4 l0, h0, l1, h1, l2, h2, l3, h3; };
template <int D0> __device__ __forceinline__ void vf8_read(VF8& f, int vb) {
    f.l0 = tr_read<v_rd_off(D0, 0, 0)>(vb); f.h0 = tr_read<v_rd_off(D0, 0, 1)>(vb); f.l1 = tr_read<v_rd_off(D0, 1, 0)>(vb); f.h1 = tr_read<v_rd_off(D0, 1, 1)>(vb);
    f.l2 = tr_read<v_rd_off(D0, 2, 0)>(vb); f.h2 = tr_read<v_rd_off(D0, 2, 1)>(vb); f.l3 = tr_read<v_rd_off(D0, 3, 0)>(vb); f.h3 = tr_read<v_rd_off(D0, 3, 1)>(vb); }
__device__ __forceinline__ void vf8_mma(f32x16& od, const VF8& f, bf16x8 pa0, bf16x8 pa1, bf16x8 pa2, bf16x8 pa3) {
#define PKV(Lx, Hx) (bf16x8){Lx[0], Lx[1], Lx[2], Lx[3], Hx[0], Hx[1], Hx[2], Hx[3]}
    od = __builtin_amdgcn_mfma_f32_32x32x16_bf16(pa0, PKV(f.l0, f.h0), od, 0, 0, 0);
    od = __builtin_amdgcn_mfma_f32_32x32x16_bf16(pa1, PKV(f.l1, f.h1), od, 0, 0, 0);
    od = __builtin_amdgcn_mfma_f32_32x32x16_bf16(pa2, PKV(f.l2, f.h2), od, 0, 0, 0);
    od = __builtin_amdgcn_mfma_f32_32x32x16_bf16(pa3, PKV(f.l3, f.h3), od, 0, 0, 0);
#undef PKV
}
__device__ __forceinline__ void pv_all(f32x16 (&o)[4], int vb, bf16x8 pa0, bf16x8 pa1, bf16x8 pa2, bf16x8 pa3) {
    VF8 fa, fb;
    SBAR(); __builtin_amdgcn_s_setprio(1);
    vf8_read<0>(fa, vb); asm volatile("s_waitcnt lgkmcnt(0)" ::: "memory"); SBAR();
    vf8_read<1>(fb, vb); vf8_mma(o[0], fa, pa0, pa1, pa2, pa3); asm volatile("s_waitcnt lgkmcnt(0)" ::: "memory"); SBAR();
    vf8_read<2>(fa, vb); vf8_mma(o[1], fb, pa0, pa1, pa2, pa3); asm volatile("s_waitcnt lgkmcnt(0)" ::: "memory"); SBAR();
    vf8_read<3>(fb, vb); vf8_mma(o[2], fa, pa0, pa1, pa2, pa3); asm volatile("s_waitcnt lgkmcnt(0)" ::: "memory"); SBAR();
    vf8_mma(o[3], fb, pa0, pa1, pa2, pa3);
    __builtin_amdgcn_s_setprio(0);
}
__device__ __forceinline__ void softmax_pv(f32x16& p0, f32x16& p1, float& m_reg, float& l_reg, f32x16 (&o)[4], int vb, LAS float* al, float C, int r32, int hi) {
    bf16x8 pa0, pa1, pa2, pa3; softmax_p(p0, p1, m_reg, l_reg, o, pa0, pa1, pa2, pa3, al, C, r32, hi); pv_all(o, vb, pa0, pa1, pa2, pa3);
}
#define ATTN_STORE_O(ROWPTR_EXPR) do { if (hi == 0) al[r32] = l_reg; asm volatile("s_waitcnt lgkmcnt(0)" ::: "memory"); \
    _Pragma("unroll") for (int r = 0; r < 16; ++r) { const int qi = crow(r, hi); const float rl = __builtin_amdgcn_rcpf(al[qi]); bf16* op = (ROWPTR_EXPR); \
        _Pragma("unroll") for (int d0 = 0; d0 < 4; ++d0) op[d0 * 32 + r32] = (bf16)f2bf(o[d0][r] * rl); } } while (0)

constexpr int MLA_KB = 32768, MLA_VB = 16384, MLA_BUF = MLA_KB + MLA_VB;
__device__ __forceinline__ void mla_stage(const bf16* KV, const bf16* KR, int krow0, int head, LAS unsigned char* buf, int tid, int wave) {
#pragma unroll
    for (int i = 0; i < 4; ++i) { const int P = i * 512 + tid, row = P >> 5, c = (P & 31) ^ (row & 15);
        const bf16* src = c < 16 ? KV + (size_t)(krow0 + row) * KVC + head * 256 + c * 8 : KR + (size_t)(krow0 + row) * 64 + (c < 24 ? (c - 16) * 8 : 0);
        glds16(src, buf + (i * 512 + wave * 64) * 16); }
#pragma unroll
    for (int i = 0; i < 2; ++i) { const int P = (i * 512 + tid) * 16; int k, c; v_inv(P, k, c);
        glds16(KV + (size_t)(krow0 + k) * KVC + head * 256 + 128 + c, buf + MLA_KB + (i * 512 + wave * 64) * 16); }
}
struct MlaSrc { unsigned o[6]; unsigned kvm; };
__device__ __forceinline__ void mla_src_init(MlaSrc& s, const bf16* KV, const bf16* KR, int krow0, int head, int tid) {
    const unsigned dkr = (unsigned)((const char*)KR - (const char*)KV);
    s.kvm = 0u;
#pragma unroll
    for (int i = 0; i < 4; ++i) { const int P = i * 512 + tid, row = P >> 5, c = (P & 31) ^ (row & 15);
        s.o[i] = c < 16 ? (unsigned)(((krow0 + row) * KVC + head * 256 + c * 8) * 2) : dkr + (unsigned)(((krow0 + row) * 64 + (c < 24 ? (c - 16) * 8 : 0)) * 2); s.kvm |= (c < 16 ? 1u : 0u) << i; }
#pragma unroll
    for (int i = 0; i < 2; ++i) { const int P = (i * 512 + tid) * 16; int k, c; v_inv(P, k, c); s.o[4 + i] = (unsigned)(((krow0 + k) * KVC + head * 256 + 128 + c) * 2); }
}
__device__ __forceinline__ void mla_stage_adv(MlaSrc& s, const bf16* KV, LAS unsigned char* buf, int wave) {
#pragma unroll
    for (int i = 0; i < 4; ++i) { glds16((const char*)KV + s.o[i], buf + (i * 512 + wave * 64) * 16); s.o[i] += ((s.kvm >> i) & 1u) ? 64u * KVC * 2u : 64u * 64u * 2u; }
#pragma unroll
    for (int i = 0; i < 2; ++i) { glds16((const char*)KV + s.o[4 + i], buf + MLA_KB + (i * 512 + wave * 64) * 16); s.o[4 + i] += 64u * KVC * 2u; }
}
__device__ __forceinline__ void mla_unit(const bf16* Q, const bf16* KV, const bf16* KR, const float* gqn, const float* gqr, const GAS f32x2v* R64, bf16* O, int opitch, int row0  , int L, int head, int qb, LAS unsigned char* lds, int tid, int lane, int wave) {
    const int r32 = lane & 31, hi = lane >> 5; constexpr float C = 0.07216878364870322f * 1.4426950408889634f;
    LAS float* al = (LAS float*)(lds + WSCR_OFF + wave * 128);
    const int qrow = row0 + qb * 256 + wave * 32 + r32;
    __syncthreads();
    MlaSrc src; mla_src_init(src, KV, KR, row0, head, tid);
    mla_stage_adv(src, KV, lds, wave);
    bf16x8 qr[12];
    {   const bf16* qn_p = Q + (size_t)qrow * QC + head * 128 + hi * 8; const bf16* qr_p = Q + (size_t)qrow * QC + 1536 + head * 64 + hi * 8;
        float sn = 0.f, sr = 0.f;
#pragma unroll
        for (int d0 = 0; d0 < 12; ++d0) { float x[8]; unpack8(*(const GAS v4u*)(d0 < 8 ? qn_p + d0 * 16 : qr_p + (d0 - 8) * 16), x); float s = 0.f;
#pragma unroll
            for (int e = 0; e < 8; ++e) s += x[e] * x[e];
            if (d0 < 8) sn += s; else sr += s; }
        sn += __shfl_xor(sn, 32); sr += __shfl_xor(sr, 32);
        const float rn = 1.0f / sqrtf(sn * (1.0f / 128.0f) + EPS), rr = 1.0f / sqrtf(sr * (1.0f / 64.0f) + EPS);
#pragma unroll
        for (int d0 = 0; d0 < 8; ++d0) { float x[8], y[8]; unpack8(*(const GAS v4u*)(qn_p + d0 * 16), x); const GAS f32x4* gp = (const GAS f32x4*)(gqn + d0 * 16 + hi * 8); const f32x4 g0 = gp[0], g1 = gp[1];
            y[0] = x[0] * rn * g0.x; y[1] = x[1] * rn * g0.y; y[2] = x[2] * rn * g0.z; y[3] = x[3] * rn * g0.w; y[4] = x[4] * rn * g1.x; y[5] = x[5] * rn * g1.y; y[6] = x[6] * rn * g1.z; y[7] = x[7] * rn * g1.w;
            qr[d0] = __builtin_bit_cast(bf16x8, pack8(y)); asm volatile("" ::: "memory"); }
        const int pos = qb * 256 + wave * 32 + r32;
#pragma unroll
        for (int d0 = 0; d0 < 2; ++d0) {
            float x1[8], x2[8], y1[8], y2[8]; unpack8(*(const GAS v4u*)(qr_p + d0 * 16), x1); unpack8(*(const GAS v4u*)(qr_p + (d0 + 2) * 16), x2); const int i0 = d0 * 16 + hi * 8;
            const GAS f32x4* ct = (const GAS f32x4*)(R64 + pos * 32 + i0); const f32x4 c01 = ct[0], c23 = ct[1], c45 = ct[2], c67 = ct[3];
            const float cs[16] = {c01.x, c01.y, c01.z, c01.w, c23.x, c23.y, c23.z, c23.w, c45.x, c45.y, c45.z, c45.w, c67.x, c67.y, c67.z, c67.w};
#pragma unroll
            for (int e = 0; e < 8; ++e) { const float a = x1[e] * rr * gqr[i0 + e], b = x2[e] * rr * gqr[32 + i0 + e]; y1[e] = a * cs[2 * e] - b * cs[2 * e + 1]; y2[e] = b * cs[2 * e] + a * cs[2 * e + 1]; }
            qr[8 + d0] = __builtin_bit_cast(bf16x8, pack8(y1)); qr[10 + d0] = __builtin_bit_cast(bf16x8, pack8(y2)); asm volatile("" ::: "memory"); }
    }
    float m_reg = -1e30f, l_reg = 0.f; f32x16 o[4];
#pragma unroll
    for (int d = 0; d < 4; ++d) o[d] = (f32x16){0.f, 0.f, 0.f, 0.f, 0.f, 0.f, 0.f, 0.f, 0.f, 0.f, 0.f, 0.f, 0.f, 0.f, 0.f, 0.f};
    const int NT = L / 64;
#pragma unroll 1
    for (int j = 0; j < NT; ++j) {
        LAS unsigned char* cur = lds + (j & 1) * MLA_BUF;
        asm volatile("s_waitcnt vmcnt(0)" ::: "memory"); __syncthreads();
        if (j + 1 < NT) mla_stage_adv(src, KV, lds + ((j + 1) & 1) * MLA_BUF, wave);
        f32x16 p0 = (f32x16){0.f, 0.f, 0.f, 0.f, 0.f, 0.f, 0.f, 0.f, 0.f, 0.f, 0.f, 0.f, 0.f, 0.f, 0.f, 0.f}, p1 = p0;
        __builtin_amdgcn_s_setprio(1);
#pragma unroll
        for (int d0 = 0; d0 < 12; ++d0) { const int c = 2 * d0 + hi;
            const bf16x8 b0 = *(const LAS bf16x8*)(cur + r32 * 512 + ((c ^ (r32 & 15)) << 4));
            const bf16x8 b1 = *(const LAS bf16x8*)(cur + (32 + r32) * 512 + ((c ^ (r32 & 15)) << 4));
            p0 = __builtin_amdgcn_mfma_f32_32x32x16_bf16(b0, qr[d0], p0, 0, 0, 0);
            p1 = __builtin_amdgcn_mfma_f32_32x32x16_bf16(b1, qr[d0], p1, 0, 0, 0); }
        __builtin_amdgcn_s_setprio(0);
        softmax_pv(p0, p1, m_reg, l_reg, o, (int)(unsigned)(uintptr_t)(cur + MLA_KB) + v_rd_base(lane), al, C, r32, hi);
    }
    ATTN_STORE_O(O + (size_t)(row0 + qb * 256 + wave * 32 + qi) * opitch + head * 128);
}
__device__ __forceinline__ void mla_phase(const bf16* Q, const bf16* KV, const bf16* KR, const float* gqn, const float* gqr, const GAS f32x2v* R64, bf16* O, int opitch, LAS unsigned char* lds, int tid, int lane, int wave, int bid, int G) {
    const bool bal = (G == 256); const int x = bid & 7, li = bid >> 3;
    const int nS = bal ? (li < 16 ? 2 : 1) : (bid < 384 ? (384 - bid + G - 1) / G : 0), nP = bal ? (li < 16 ? 1 : 5) : (bid < 768 ? (768 - bid + G - 1) / G : 0);
#pragma unroll 1
    for (int i = 0; i < nS + nP; ++i) {
        int row0, L, head, qb;
        if (i < nS) { const int u = bal ? 48 * x + (li < 16 ? 2 * li + i : 16 + li) : bid + i * G; row0 = TP; L = 8192; head = u / 32; qb = u % 32; }
        else { const int k = i - nS, u = bal ? 96 * x + (li < 16 ? li : 16 + 5 * (li - 16) + k) : bid + k * G; row0 = (u / 96) * 2048; L = 2048; head = (u % 96) / 8; qb = u % 8; }
        mla_unit(Q, KV, KR, gqn, gqr, R64, O, opitch, row0, L, head, qb, lds, tid, lane, wave);
    }
}
__device__ __forceinline__ void dil_unit(const bf16* Z, bf16* O, int opitch, float* DLSE, int wu, LAS unsigned char* lds, int tid, int lane, int wave) {
    const int r32 = lane & 31, hi = lane >> 5, sub = wave >> 1, tl = tid & 127; constexpr float C = 0.08838834764831845f * 1.4426950408889634f;
    const int hd = wu % 12, quad = wu / 12, gb = quad * 4 + sub, grp = hd >> 2, dil = grp == 0 ? 1 : (grp == 1 ? 4 : 16);
    const int row0 = gb < 256 ? (gb >> 5) * 2048 : TP, L = gb < 256 ? 2048 : 8192, bi = gb < 256 ? (gb & 31) : gb - 256;
    const int res = bi % dil, blk = bi / dil, nblk = L / 64 / dil;
    LAS unsigned char* kb = lds + sub * 32768; LAS unsigned char* vbuf = kb + 16384;
    LAS float* al = (LAS float*)(lds + WSCR_OFF + wave * 128);
    const int qi_l = 32 * (wave & 1) + r32; const size_t qrow = (size_t)(row0 + (blk * 64 + qi_l) * dil + res);
    bf16x8 qr[8];
#pragma unroll
    for (int d0 = 0; d0 < 8; ++d0) qr[d0] = *(const GAS bf16x8*)(Z + qrow * ZC + Z_DQ + hd * 128 + d0 * 16 + hi * 8);
    float m_reg = -1e30f, l_reg = 0.f; f32x16 o[4];
#pragma unroll
    for (int d = 0; d < 4; ++d) o[d] = (f32x16){0.f, 0.f, 0.f, 0.f, 0.f, 0.f, 0.f, 0.f, 0.f, 0.f, 0.f, 0.f, 0.f, 0.f, 0.f, 0.f};
    unsigned ko0, vo0;
    { const int P = tl * 16, row = P >> 8, cb = (P & 255) ^ ((row & 7) << 4); int k, c; v_inv(P, k, c);
      ko0 = (unsigned)(((row0 + row * dil + res) * ZC + Z_DK + hd * 128) * 2 + cb); vo0 = (unsigned)(((row0 + k * dil + res) * ZC + Z_DV + hd * 128 + c) * 2); }
    const size_t rstride = (size_t)(ZC * 2) * dil;
#pragma unroll 1
    for (int ti = 0; ti < 3; ++ti) {
        const int dt = ti == 0 ? 0 : (ti == 1 ? -1 : 1); const int kblk = blk + dt; const bool tvalid = kblk >= 0 && kblk < nblk; const int kbc = tvalid ? kblk : blk;
        __syncthreads();
        { const char* zt = pg8::pg8_uni((const char*)Z + (size_t)(kbc * 64) * rstride);
#pragma unroll
          for (int i = 0; i < 8; ++i) glds16(zt + (size_t)(8 * i) * rstride + ko0, kb + (i * 128 + (wave & 1) * 64) * 16);
#pragma unroll
          for (int i = 0; i < 8; ++i) glds16(zt + (size_t)(16 * (i >> 1) + 4 * (i & 1)) * rstride + vo0, vbuf + (i * 128 + (wave & 1) * 64) * 16); }
        asm volatile("s_waitcnt vmcnt(0)" ::: "memory"); __syncthreads();
        f32x16 p0 = (f32x16){0.f, 0.f, 0.f, 0.f, 0.f, 0.f, 0.f, 0.f, 0.f, 0.f, 0.f, 0.f, 0.f, 0.f, 0.f, 0.f}, p1 = p0;
#pragma unroll
        for (int d0 = 0; d0 < 8; ++d0) { const int cb = d0 * 32 + hi * 16;
            const bf16x8 b0 = *(const LAS bf16x8*)(kb + r32 * 256 + (cb ^ ((r32 & 7) << 4)));
            const bf16x8 b1 = *(const LAS bf16x8*)(kb + (32 + r32) * 256 + (cb ^ ((r32 & 7) << 4)));
            p0 = __builtin_amdgcn_mfma_f32_32x32x16_bf16(b0, qr[d0], p0, 0, 0, 0);
            p1 = __builtin_amdgcn_mfma_f32_32x32x16_bf16(b1, qr[d0], p1, 0, 0, 0); }
        if (ti != 0) {
#pragma unroll
            for (int r = 0; r < 16; ++r) { const int k0 = crow(r, hi), k1 = 32 + k0;
                const bool v0 = tvalid && (dt < 0 ? k0 >= qi_l : k0 <= qi_l), v1 = tvalid && (dt < 0 ? k1 >= qi_l : k1 <= qi_l);
                p0[r] = v0 ? p0[r] : -1e30f; p1[r] = v1 ? p1[r] : -1e30f; }
        }
        softmax_pv(p0, p1, m_reg, l_reg, o, (int)(unsigned)(uintptr_t)vbuf + v_rd_base(lane), al, C, r32, hi);
    }
    if (hi == 0) DLSE[(qrow) * 12 + hd] = m_reg * 0.08838834764831845f + logf(l_reg);
    __syncthreads();
    ATTN_STORE_O(O + (size_t)(row0 + (blk * 64 + 32 * (wave & 1) + qi) * dil + res) * opitch + hd * 128);
}
__device__ __forceinline__ void mixnorm_hyena(int tb, const bf16* YT, const float* gout, bf16* MX, LAS unsigned char* lds, int tid, int lane, int wave) {
    LAS float* ssq = (LAS float*)(lds);
    LAS float* rstd = (LAS float*)(lds + 2048);
    LAS bf16* tile = (LAS bf16*)(lds + 4096);
    const int c = tid >> 3, t8 = (tid & 7) * 8, m0 = tb * 64;
    v4u xw[16];
#pragma unroll
    for (int ck = 0; ck < 16; ++ck) xw[ck] = *(const GAS v4u*)(YT + (size_t)(ck * 64 + c) * TT + m0 + t8);
    __syncthreads();
    float ps[8];
#pragma unroll
    for (int e = 0; e < 8; ++e) ps[e] = 0.f;
#pragma unroll
    for (int ck = 0; ck < 16; ++ck) { float x[8]; unpack8(xw[ck], x);
#pragma unroll
        for (int e = 0; e < 8; ++e) ps[e] += x[e] * x[e]; }
#pragma unroll
    for (int e = 0; e < 8; ++e) { ps[e] += __shfl_xor(ps[e], 8); ps[e] += __shfl_xor(ps[e], 16); ps[e] += __shfl_xor(ps[e], 32); }
    if (lane < 8) {
#pragma unroll
        for (int e = 0; e < 8; ++e) ssq[wave * 64 + lane * 8 + e] = ps[e]; }
    __syncthreads();
    if (tid < 64) { float s = 0.f;
#pragma unroll
        for (int w = 0; w < 8; ++w) s += ssq[w * 64 + tid];
        rstd[tid] = 1.0f / sqrtf(s * (1.0f / 1024.0f) + EPS); }
    __syncthreads();
    float rt[8];
#pragma unroll
    for (int e = 0; e < 8; ++e) rt[e] = rstd[t8 + e];
#pragma unroll
    for (int half = 0; half < 2; ++half) {
#pragma unroll
        for (int k = 0; k < 8; ++k) { const int ck = half * 8 + k; float x[8]; unpack8(xw[ck], x); const float gg = gout[ck * 64 + c];
#pragma unroll
            for (int e = 0; e < 8; ++e) tile[k * (64 * 66) + c * 66 + t8 + e] = (bf16)f2bf(x[e] * rt[e] * gg); }
        __syncthreads();
        { const int t = tid >> 3, c8 = (tid & 7) * 8;
#pragma unroll
          for (int k = 0; k < 8; ++k) { const LAS bf16* tk = tile + k * (64 * 66); v4u w;
              w.x = (unsigned)tk[(c8 + 0) * 66 + t] | ((unsigned)tk[(c8 + 1) * 66 + t] << 16); w.y = (unsigned)tk[(c8 + 2) * 66 + t] | ((unsigned)tk[(c8 + 3) * 66 + t] << 16);
              w.z = (unsigned)tk[(c8 + 4) * 66 + t] | ((unsigned)tk[(c8 + 5) * 66 + t] << 16); w.w = (unsigned)tk[(c8 + 6) * 66 + t] | ((unsigned)tk[(c8 + 7) * 66 + t] << 16);
              *(GAS v4u*)(MX + (size_t)(m0 + t) * DM + (half * 8 + k) * 64 + c8) = w; } }
        __syncthreads();
    }
}
__device__ __forceinline__ void mixnorm_tokens(const bf16* Q, const bf16* Z, const float* DLSE, const float* gout, bf16* MX, int gw, int NGW, int lane) {
    for (int m = gw; m < TT; m += NGW) {
        v4u qw[3], zw[3];
#pragma unroll
        for (int j = 0; j < 3; ++j) { qw[j] = *(const GAS v4u*)(Q + (size_t)m * QC + lane * 8 + 512 * j); zw[j] = *(const GAS v4u*)(Z + (size_t)m * ZC + Z_DQ + lane * 8 + 512 * j); }
        {   float x[3][8]; float s = 0.f;
#pragma unroll
            for (int j = 0; j < 3; ++j) { unpack8(qw[j], x[j]);
#pragma unroll
                for (int e = 0; e < 8; ++e) s += x[j][e] * x[j][e]; }
            const float rs = 1.0f / sqrtf(wave_sum(s) * (1.0f / 1536.0f) + EPS);
#pragma unroll
            for (int j = 0; j < 3; ++j) { const int cc = lane * 8 + 512 * j; float y[8];
#pragma unroll
                for (int e = 0; e < 8; ++e) y[e] = x[j][e] * rs * gout[1024 + cc + e];
                *(GAS v4u*)(MX + (size_t)m * DM + 1024 + cc) = pack8(y); }
        }
        {   float x[3][8]; float s = 0.f;
#pragma unroll
            for (int j = 0; j < 3; ++j) { const int cc = lane * 8 + 512 * j, hd = cc >> 7, slot = hd & 3;
                const float l0 = DLSE[(size_t)m * 12 + slot], l1 = DLSE[(size_t)m * 12 + 4 + slot], l2 = DLSE[(size_t)m * 12 + 8 + slot], lm = fmaxf(l0, fmaxf(l1, l2));
                const float e0 = expf(l0 - lm), e1 = expf(l1 - lm), e2 = expf(l2 - lm), mine = (hd >> 2) == 0 ? e0 : ((hd >> 2) == 1 ? e1 : e2), alpha = mine / (e0 + e1 + e2);
                unpack8(zw[j], x[j]);
#pragma unroll
                for (int e = 0; e < 8; ++e) { x[j][e] *= alpha; s += x[j][e] * x[j][e]; } }
            const float rs = 1.0f / sqrtf(wave_sum(s) * (1.0f / 1536.0f) + EPS);
#pragma unroll
            for (int j = 0; j < 3; ++j) { const int cc = lane * 8 + 512 * j; float y[8];
#pragma unroll
                for (int e = 0; e < 8; ++e) y[e] = x[j][e] * rs * gout[2560 + cc + e];
                *(GAS v4u*)(MX + (size_t)m * DM + 2560 + cc) = pack8(y); }
        }
    }
}
#ifndef MK_N_LAUNCHES
#define MK_N_LAUNCHES 1
#endif
struct Args { const float* in[31]; float* out; unsigned char* ws; int ph_lo, ph_hi, li, pad; };
__global__ void __launch_bounds__(NWAVES * 64, 2) fwd(Args args) {
    extern __shared__ __attribute__((aligned(16))) unsigned char lds_raw[];
    LAS unsigned char* lds = (LAS unsigned char*)lds_raw;
    const int tid = threadIdx.x, wave = __builtin_amdgcn_readfirstlane(tid >> 6), G = gridDim.x, bid = blockIdx.x;
    const int NGW = G * NWAVES, NGT = G * NWAVES * 64;
    for (int u = tid; u < (PTAB_OFF - LDSCTL_OFF) / 4; u += NWAVES * 64) ((LAS unsigned*)(lds + LDSCTL_OFF))[u] = 0u;
    __syncthreads();
    const int lo = args.ph_lo, hi = args.ph_hi;
    XcdBarrier bar; bar.bar = (unsigned*)(args.ws + WS_CTL) + CW_BAR; bar.x = 0; bar.st = nullptr;
    if (hi - lo > 1) bar = xcd_barrier_post((unsigned*)(args.ws + WS_CTL) + CW_BAR, (volatile LAS unsigned*)(lds + MISC_OFF) + 8);
#define IN(k) (lo <= (k) && (k) < hi)
#define SEAM(k) do { if (IN(k) && IN((k) + 1)) xcd_barrier(bar); } while (0)
#define OPQ() int tid_ = tid, wave_ = wave; asm volatile("" : "+v"(tid_), "+s"(wave_)); tid_ &= 511; wave_ &= 7; const InTab in_{args.in}; unsigned char* const ws_ = args.ws; float* const out_ = args.out; (void)ws_; (void)out_; \
    const int lane_ = tid_ & 63, gw_ = bid * NWAVES + wave_, gt_ = bid * (NWAVES * 64) + tid_; (void)lane_; (void)gw_; (void)gt_
#define P_MIX ((bf16*)(ws_ + WS_MIX))
#define P_Z ((bf16*)(ws_ + WS_Z))
#define P_Q ((bf16*)(ws_ + WS_Q))
#define P_KV ((bf16*)(ws_ + WS_KV))
#define P_UT ((bf16*)(ws_ + WS_UT))
#define P_A2 ((bf16*)(ws_ + WS_A2))
#define P_CQ ((bf16*)(ws_ + WS_CQ))
#define P_CKV ((bf16*)(ws_ + WS_CKV))
#define P_KR ((bf16*)(ws_ + WS_KR))
#define P_X0T ((bf16*)(ws_ + WS_X0T))
#define P_YT ((bf16*)(ws_ + WS_YT))
#define P_DLSE ((float*)(ws_ + WS_DLSE))
#define P_XP (in_[0])
#define P_XS (in_[1] - (size_t)TP * DM)
#define P_WL (ws_ + WS_WT + (size_t)l * WT_LAYER)
#define P_XB ((bf16*)(ws_ + WS_XB))
#define P_SSQ(i) ((float*)(ws_ + WS_SSQ) + (size_t)(i) * TT)
#define P_SSQP ((float*)(ws_ + WS_SSQP))

    if (IN(0)) {
        OPQ();
        for (int it = bid; it < NLAYER * 160; it += G) { const int layer = it / 160, r = it % 160; filter_item(in_, ws_, layer, r >= 32 ? 1 : 0, r >= 32 ? r - 32 : r, lds, tid_, lane_, wave_); }
        p0_weights(in_, ws_, (LAS float*)(lds + wave_ * 16384), gw_, NGW, lane_);
        p0_misc(ws_, gt_, NGT);
        cvt_rows(P_XP, P_XS, P_XB, P_SSQ(0), gw_, NGW, lane_);
    }
    SEAM(0);
#pragma unroll 1
    for (int l = 0; l < NLAYER; ++l) {
        const int pb = 1 + l * NPH_LAYER;
        if (IN(pb + 0)) {
            OPQ(); pg8::Gemm g{P_XB, (const bf16*)(P_WL + WT_IN), TT, ZC, DM}; pg8::StaticOrder S; S.init(TT, ZC, G, bid);
            pg8::EpiInProj E{P_Z, ZC, P_SSQ(2 * l), in_[24] + l * 128, in_[25] + l * 128, (const float*)(ws_ + WS_R128), (LAS float*)(lds + KVTAB_OFF)};
            pg8::gemm_phase<pg8::EpiInProj, pg8::StaticOrder, true, true>(lds, g, S, E);
        }
        SEAM(pb + 0);
        if (IN(pb + 1)) {
            OPQ();
            prep_hyena(P_Z, in_[4] + (size_t)l * 3 * 3072, in_[5] + (size_t)l * 3072, P_UT, P_X0T, lds, tid_, bid, G);
            prep_tokens(P_Z, in_, l, ws_, gw_, NGW, lane_);
        }
        SEAM(pb + 1);
        if (IN(pb + 2)) {
            { OPQ(); pg8::Gemm g{P_CQ, (const bf16*)(P_WL + WT_QB), TT, QC, 1536}; pg8::StaticOrder S; S.init(TT, QC, G, bid); pg8::EpiBf16<0> E{P_Q, QC, nullptr};
              pg8::gemm_phase<pg8::EpiBf16<0>, pg8::StaticOrder, true, true>(lds, g, S, E); }
            { OPQ(); pg8::Gemm g{P_CKV, (const bf16*)(P_WL + WT_KVB), TT, KVC, 512}; pg8::StaticOrder S; S.init(TT, KVC, G, (bid + (G >> 1)) % G);     pg8::EpiKv E{P_KV, KVC, in_[22] + l * 128, (LAS float*)(lds + KVTAB_OFF)};
              pg8::gemm_phase<pg8::EpiKv, pg8::StaticOrder, true, true>(lds, g, S, E); }
            { OPQ(); const unsigned char* fl = ws_ + WS_FILT + (size_t)l * FILT_LAYER;
              v4u upre[4] = {{0u, 0u, 0u, 0u}, {0u, 0u, 0u, 0u}, {0u, 0u, 0u, 0u}, {0u, 0u, 0u, 0u}}; bool pv = false;
              for (int u = bid; u < 2048; u += G) {
                  const int c = u & 1023; const float skip = in_[15][l * 1024 + c];
                  const int un = u + G; const bf16* nxt = un < 2048 ? P_UT + (size_t)(un & 1023) * TT + (un >= 1024 ? TP : 0) : nullptr; const int nnp = un >= 1024 ? 2 : 4;
                  if (u < 1024) conv_unit<0>(c, (const bf16*)fl + (size_t)c * 4096, P_UT, P_X0T, P_YT, skip, lds, tid_, lane_, wave_, upre, pv, nxt, nnp);
                  else conv_unit<1>(c, (const bf16*)(fl + FILT_S_OFF) + (size_t)c * 16384, P_UT, P_X0T, P_YT, skip, lds, tid_, lane_, wave_, upre, pv, nxt, nnp);
                  pv = nxt != nullptr;
              } }
            { OPQ(); for (int wu = (bid + (G >> 1)) % G; wu < 1152; wu += G) dil_unit(P_Z, P_Z + Z_DQ, ZC, P_DLSE, wu, lds, tid_, lane_, wave_); }
        }
        SEAM(pb + 2);
        if (IN(pb + 3)) { OPQ(); mla_phase(P_Q, P_KV, P_KR, in_[20] + l * 128, in_[21] + l * 64, (const GAS f32x2v*)(ws_ + WS_R64), P_Q, QC, lds, tid_, lane_, wave_, bid, G); }
        SEAM(pb + 3);
        if (IN(pb + 4)) { OPQ(); for (int tb = bid; tb < 384; tb += G) mixnorm_hyena(tb, P_YT, in_[26] + (size_t)l * DM, P_MIX, lds, tid_, lane_, wave_);
            mixnorm_tokens(P_Q, P_Z, P_DLSE, in_[26] + (size_t)l * DM, P_MIX, gw_, NGW, lane_); }
        SEAM(pb + 4);
        if (IN(pb + 5)) {
            OPQ(); pg8::Gemm g{P_MIX, (const bf16*)(P_WL + WT_OUT), TT, DM, DM}; pg8::StaticOrder S; S.init(TT, DM, G, bid);
            { pg8::EpiRes<false, false> E{nullptr, nullptr, 0, P_XB, P_SSQP, nullptr, (LAS float*)(lds + KVTAB_OFF)}; pg8::gemm_phase<pg8::EpiRes<false, false>, pg8::StaticOrder, true, true>(lds, g, S, E); }
        }
        SEAM(pb + 5);
        if (IN(pb + 6)) { OPQ(); rstd_rows(P_SSQP, P_SSQ(2 * l + 1), gt_, NGT); }
        SEAM(pb + 6);
        if (IN(pb + 7)) {
            OPQ(); pg8::Gemm g{P_XB, (const bf16*)(P_WL + WT_UP), TT, DFF, DM}; pg8::StaticOrder S; S.init(TT, DFF, G, bid); pg8::EpiBf16<1> E{P_A2, DFF, P_SSQ(2 * l + 1)};
            pg8::gemm_phase<pg8::EpiBf16<1>, pg8::StaticOrder, true, true>(lds, g, S, E);
        }
        SEAM(pb + 7);
        if (IN(pb + 8)) {
            OPQ(); pg8::Gemm g{P_A2, (const bf16*)(P_WL + WT_DN), TT, DM, DFF}; pg8::StaticOrder S; S.init(TT, DM, G, bid);
            if (l + 1 < NLAYER) { pg8::EpiRes<false, false> E{nullptr, nullptr, 0, P_XB, P_SSQP, nullptr, (LAS float*)(lds + KVTAB_OFF)}; pg8::gemm_phase<pg8::EpiRes<false, false>, pg8::StaticOrder, true, true>(lds, g, S, E); }
            else { pg8::EpiRes<false, true> E{nullptr, nullptr, 0, P_XB, nullptr, out_, (LAS float*)(lds + KVTAB_OFF)}; pg8::gemm_phase<pg8::EpiRes<false, true>, pg8::StaticOrder, true, true>(lds, g, S, E); }
        }
        if (l + 1 < NLAYER) SEAM(pb + 8);
        if (IN(pb + 9) && l + 1 < NLAYER) { OPQ(); rstd_rows(P_SSQP, P_SSQ(2 * l + 2), gt_, NGT); }
        SEAM(pb + 9);
    }
#undef IN
#undef SEAM
}

extern "C" void kernel_launch(void* const* d_in, const int* in_sizes, int n_in, void* d_out, int out_size, void* d_ws, size_t ws_size, hipStream_t stream) {
    static int grid = 0;
    if (grid == 0) {
        if (n_in != 31 || in_sizes[0] != TP * DM || in_sizes[1] != TS * DM || out_size != TT * DM || ws_size < WS_END) {
            fprintf(stderr, "kernel_launch: shape mismatch: n_in %d in0 %d in1 %d out %d ws %zu (need >= %zu); nothing launched\n", n_in, n_in > 0 ? in_sizes[0] : -1, n_in > 1 ? in_sizes[1] : -1, out_size, ws_size, (size_t)WS_END); grid = -1; return; }
        int dev = 0, cus = 0, per_cu = 0;
        if (hipGetDevice(&dev) != hipSuccess || hipDeviceGetAttribute(&cus, hipDeviceAttributeMultiprocessorCount, dev) != hipSuccess) { fprintf(stderr, "kernel_launch: device query failed\n"); grid = -1; return; }
        if (hipFuncSetAttribute((const void*)fwd, hipFuncAttributeMaxDynamicSharedMemorySize, LDS_BYTES) != hipSuccess) { fprintf(stderr, "kernel_launch: hipFuncSetAttribute failed\n"); grid = -1; return; }
        if (hipOccupancyMaxActiveBlocksPerMultiprocessor(&per_cu, (const void*)fwd, NWAVES * 64, LDS_BYTES) != hipSuccess || per_cu < 1) fprintf(stderr, "kernel_launch: occupancy query says %d\n", per_cu);
        (void)hipGetLastError();
        grid = cus;
    }
    if (grid < 0) return;
    if (hipMemsetAsync((char*)d_ws + WS_CTL, 0, CTL_ZERO_BYTES, stream) != hipSuccess) { fprintf(stderr, "kernel_launch: memset failed\n"); return; }
    Args a{};
    for (int i = 0; i < 31; ++i) a.in[i] = (const float*)d_in[i];
    a.out = (float*)d_out; a.ws = (unsigned char*)d_ws;
    if (MK_N_LAUNCHES == 1) { a.ph_lo = 0; a.ph_hi = NPHASES; a.li = 0; hipLaunchKernelGGL(fwd, dim3(grid), dim3(NWAVES * 64), LDS_BYTES, stream, a); }
    else for (int p = 0; p < NPHASES; ++p) { a.ph_lo = p; a.ph_hi = p + 1; a.li = p; hipLaunchKernelGGL(fwd, dim3(grid), dim3(NWAVES * 64), LDS_BYTES, stream, a); }
    const hipError_t le = hipPeekAtLastError();
    if (le != hipSuccess) fprintf(stderr, "kernel_launch: launch failed: %s\n", hipGetErrorName(le));
}
```
